# Optimizing an MI355X kernel written in HIP

```python
import math
import jax, jax.numpy as jnp
from jax import lax
import numpy as np

D_MODEL = 2048
BATCH = 8
SEQ = 2048
DEPTH = 1

MEM_LEN = 256
RMS_EPS = 1e-6
CONV_WIDTH = D_MODEL // 2
CONV_K = 3
N_MLA_HEADS = 8
QK_NOPE = 128
QK_ROPE = 64
V_HEAD = 128
Q_LORA = 512
KV_LORA = 256
ATTN_WIDTH = N_MLA_HEADS * V_HEAD
ROPE_THETA = 10000.0
Q_BLOCK = 128
MASK_VALUE = -1e30
IN_COLS = 3 * CONV_WIDTH + Q_LORA + KV_LORA + QK_ROPE
N_X_HEADS = 4
X_HEAD_DIM = D_MODEL // N_X_HEADS
N_GROUPS = 8
EXPERTS_PER_GROUP = 8
N_EXPERTS = N_GROUPS * EXPERTS_PER_GROUP
TOP_K = 2
D_EXPERT = 512
MOE_BLOCK = 256

kernel_name = "hymba_conv_mla_hier_moe"


def rmsnorm(x, g):
    xf = x.astype(jnp.float32)
    y = xf * lax.rsqrt(jnp.mean(xf * xf, axis=-1, keepdims=True) + RMS_EPS) * g.astype(jnp.float32)
    return y.astype(x.dtype)


def rope_tables(positions, dtype):
    inv_freq = 1.0 / (ROPE_THETA ** (jnp.arange(0, QK_ROPE, 2, dtype=jnp.float32) / QK_ROPE))
    ang = positions.astype(jnp.float32)[..., None] * inv_freq
    return jnp.cos(ang).astype(dtype), jnp.sin(ang).astype(dtype)


def apply_rope(x, cos, sin):
    x1, x2 = jnp.split(x, 2, axis=-1)
    return jnp.concatenate([x1 * cos - x2 * sin, x2 * cos + x1 * sin], axis=-1)


def short_conv_branch(b_gate, c_gate, h, w_conv):
    u = c_gate * h
    conv = lax.conv_general_dilated(
        u, w_conv[:, None, :].astype(u.dtype), window_strides=(1,),
        padding=[(CONV_K - 1, 0)], dimension_numbers=("NWC", "WIO", "NWC"),
        feature_group_count=CONV_WIDTH)
    return b_gate * conv


def causal_mla_attention(q_nope, q_rope, k_nope, k_rope, v):
    B, H, T, _ = q_nope.shape
    n_blk = T // Q_BLOCK
    scale = 1.0 / math.sqrt(QK_NOPE + QK_ROPE)
    kpos = jnp.arange(T)

    def one_block(i):
        s0 = i * Q_BLOCK
        qn = lax.dynamic_slice_in_dim(q_nope, s0, Q_BLOCK, axis=2)
        qr = lax.dynamic_slice_in_dim(q_rope, s0, Q_BLOCK, axis=2)
        s = (jnp.einsum("bhqd,bhkd->bhqk", qn, k_nope)
             + jnp.einsum("bhqr,bkr->bhqk", qr, k_rope)).astype(jnp.float32) * scale
        qpos = s0 + jnp.arange(Q_BLOCK)
        s = jnp.where(kpos[None, :] <= qpos[:, None], s, MASK_VALUE)
        p = jax.nn.softmax(s, axis=-1).astype(v.dtype)
        return jnp.einsum("bhqk,bhkd->bhqd", p, v)

    out = lax.map(one_block, jnp.arange(n_blk))
    return out.transpose(1, 0, 3, 2, 4).reshape(B, T, H * V_HEAD)


def mla_branch(c_q, c_kv, k_rope_raw, positions, g_q_a, w_q_up, g_kv_a, w_kv_up):
    B, T, _ = c_q.shape
    q = (rmsnorm(c_q, g_q_a) @ w_q_up).reshape(B, T, N_MLA_HEADS, QK_NOPE + QK_ROPE)
    q_nope, q_rope = q[..., :QK_NOPE], q[..., QK_NOPE:]
    kv = (rmsnorm(c_kv, g_kv_a) @ w_kv_up).reshape(B, T, N_MLA_HEADS, QK_NOPE + V_HEAD)
    k_nope, v = kv[..., :QK_NOPE], kv[..., QK_NOPE:]
    cos, sin = rope_tables(positions, c_q.dtype)
    q_rope = apply_rope(q_rope, cos[:, :, None, :], sin[:, :, None, :])
    k_rope = apply_rope(k_rope_raw, cos, sin)
    tr = lambda a: a.transpose(0, 2, 1, 3)
    return causal_mla_attention(tr(q_nope), tr(q_rope), tr(k_nope), k_rope, tr(v))


def memory_cross_attention(h, m, w_xq, w_xk, w_xv, w_xo):
    B, T, _ = h.shape
    q = (h @ w_xq).reshape(B, T, N_X_HEADS, X_HEAD_DIM)
    k = (m @ w_xk).reshape(B, m.shape[1], N_X_HEADS, X_HEAD_DIM)
    v = (m @ w_xv).reshape(B, m.shape[1], N_X_HEADS, X_HEAD_DIM)
    s = jnp.einsum("bqhd,bkhd->bhqk", q, k).astype(jnp.float32) * (1.0 / math.sqrt(X_HEAD_DIM))
    p = jax.nn.softmax(s, axis=-1).astype(v.dtype)
    o = jnp.einsum("bhqk,bkhd->bqhd", p, v).reshape(B, T, D_MODEL)
    return o @ w_xo


def hierarchical_moe(h, w_group, b_group, w_router, b_router, w_gate, w_up, w_down):
    B, T, D = h.shape
    n_tok = B * T
    xt = h.reshape(n_tok, D)
    xf = xt.astype(jnp.float32)
    g_logits = xf @ w_group.astype(jnp.float32) + b_group.astype(jnp.float32)
    g_prob = jax.nn.softmax(g_logits, axis=-1)
    g_p, g_idx = lax.top_k(g_prob, 1)
    e_logits = (xf @ w_router.astype(jnp.float32) + b_router.astype(jnp.float32)
                ).reshape(n_tok, N_GROUPS, EXPERTS_PER_GROUP)
    e_logits = jnp.take_along_axis(e_logits, g_idx[:, :, None], axis=1)[:, 0]
    e_prob = jax.nn.softmax(e_logits, axis=-1)
    t_p, t_i = lax.top_k(e_prob, TOP_K)
    t_p = t_p / jnp.sum(t_p, axis=-1, keepdims=True)
    expert_id = g_idx * EXPERTS_PER_GROUP + t_i
    gate_w = g_p * t_p

    n_slot = n_tok * TOP_K
    flat_e = expert_id.reshape(-1)
    flat_tok = jnp.repeat(jnp.arange(n_tok, dtype=jnp.int32), TOP_K)
    flat_w = gate_w.reshape(-1)
    order = jnp.argsort(flat_e, stable=True)
    s_e, s_tok, s_w = flat_e[order], flat_tok[order], flat_w[order]
    counts = jnp.bincount(flat_e, length=N_EXPERTS)
    padded = ((counts + MOE_BLOCK - 1) // MOE_BLOCK) * MOE_BLOCK
    pad_end = jnp.cumsum(padded)
    pad_start = pad_end - padded
    start = jnp.cumsum(counts) - counts
    dest = pad_start[s_e] + (jnp.arange(n_slot) - start[s_e])
    n_blk = (n_slot + MOE_BLOCK - 1) // MOE_BLOCK + N_EXPERTS
    L = n_blk * MOE_BLOCK
    buf_tok = jnp.full((L,), n_tok, dtype=jnp.int32).at[dest].set(s_tok)
    buf_w = jnp.zeros((L,), jnp.float32).at[dest].set(s_w)
    blk_expert = jnp.minimum(
        jnp.searchsorted(pad_end, jnp.arange(n_blk) * MOE_BLOCK, side="right"), N_EXPERTS - 1)
    x_pad = jnp.concatenate([xt, jnp.zeros((1, D), xt.dtype)], axis=0)

    def expert_block(args):
        tok, e = args
        xb = x_pad[tok]
        a = jax.nn.silu(xb @ w_gate[e]) * (xb @ w_up[e])
        return a @ w_down[e]

    y = lax.map(expert_block, (buf_tok.reshape(n_blk, MOE_BLOCK), blk_expert)).reshape(L, D)
    y = y * buf_w[:, None].astype(y.dtype)
    out = jnp.zeros((n_tok, D), xt.dtype).at[buf_tok].add(y, mode="drop")
    return out.reshape(B, T, D)


def setup_inputs(seed: int = 0) -> dict:
    key = jax.random.key(seed)
    ks = iter(jax.random.split(key, 32))
    f32 = jnp.float32
    nrm = lambda shape, fan_in: jax.random.normal(next(ks), shape, f32) * (fan_in ** -0.5)
    gain = lambda shape: 1.0 + 0.02 * jax.random.normal(next(ks), shape, f32)
    bias = lambda shape: 0.01 * jax.random.normal(next(ks), shape, f32)
    return {
        "x": jax.random.normal(next(ks), (BATCH, SEQ, D_MODEL), f32),
        "mem": jax.random.normal(next(ks), (BATCH, MEM_LEN, D_MODEL), f32),
        "positions": jnp.broadcast_to(jnp.arange(SEQ, dtype=jnp.int32), (BATCH, SEQ)),
        "g_mix": gain((DEPTH, D_MODEL)),
        "w_in": nrm((DEPTH, D_MODEL, IN_COLS), D_MODEL),
        "w_conv": nrm((DEPTH, CONV_K, CONV_WIDTH), CONV_K),
        "g_q_a": gain((DEPTH, Q_LORA)),
        "w_q_up": nrm((DEPTH, Q_LORA, N_MLA_HEADS * (QK_NOPE + QK_ROPE)), Q_LORA),
        "g_kv_a": gain((DEPTH, KV_LORA)),
        "w_kv_up": nrm((DEPTH, KV_LORA, N_MLA_HEADS * (QK_NOPE + V_HEAD)), KV_LORA),
        "g_conv_out": gain((DEPTH, CONV_WIDTH)),
        "g_attn_out": gain((DEPTH, ATTN_WIDTH)),
        "w_out": nrm((DEPTH, CONV_WIDTH + ATTN_WIDTH, D_MODEL), CONV_WIDTH + ATTN_WIDTH),
        "g_xattn": gain((DEPTH, D_MODEL)),
        "g_mem": gain((DEPTH, D_MODEL)),
        "w_xq": nrm((DEPTH, D_MODEL, D_MODEL), D_MODEL),
        "w_xk": nrm((DEPTH, D_MODEL, D_MODEL), D_MODEL),
        "w_xv": nrm((DEPTH, D_MODEL, D_MODEL), D_MODEL),
        "w_xo": nrm((DEPTH, D_MODEL, D_MODEL), D_MODEL),
        "g_moe": gain((DEPTH, D_MODEL)),
        "w_group": nrm((DEPTH, D_MODEL, N_GROUPS), D_MODEL),
        "b_group": bias((DEPTH, N_GROUPS)),
        "w_router": nrm((DEPTH, D_MODEL, N_EXPERTS), D_MODEL),
        "b_router": bias((DEPTH, N_EXPERTS)),
        "w_gate": nrm((DEPTH, N_EXPERTS, D_MODEL, D_EXPERT), D_MODEL),
        "w_up": nrm((DEPTH, N_EXPERTS, D_MODEL, D_EXPERT), D_MODEL),
        "w_down": nrm((DEPTH, N_EXPERTS, D_EXPERT, D_MODEL), D_EXPERT),
        "g_final": gain((D_MODEL,)),
    }


def reference(x, mem, positions, g_mix, w_in, w_conv, g_q_a, w_q_up, g_kv_a, w_kv_up,
              g_conv_out, g_attn_out, w_out, g_xattn, g_mem, w_xq, w_xk, w_xv, w_xo,
              g_moe, w_group, b_group, w_router, b_router, w_gate, w_up, w_down, g_final):
    c0 = 0
    c1 = c0 + CONV_WIDTH
    c2 = c1 + CONV_WIDTH
    c3 = c2 + CONV_WIDTH
    c4 = c3 + Q_LORA
    c5 = c4 + KV_LORA
    c6 = c5 + QK_ROPE
    for l in range(DEPTH):
        h = rmsnorm(x, g_mix[l])
        z = h @ w_in[l]
        y_conv = short_conv_branch(z[..., c0:c1], z[..., c1:c2], z[..., c2:c3], w_conv[l])
        y_attn = mla_branch(z[..., c3:c4], z[..., c4:c5], z[..., c5:c6], positions,
                            g_q_a[l], w_q_up[l], g_kv_a[l], w_kv_up[l])
        y = jnp.concatenate([rmsnorm(y_conv, g_conv_out[l]), rmsnorm(y_attn, g_attn_out[l])], axis=-1)
        x = x + y @ w_out[l]
        x = x + memory_cross_attention(rmsnorm(x, g_xattn[l]), rmsnorm(mem, g_mem[l]),
                                       w_xq[l], w_xk[l], w_xv[l], w_xo[l])
        x = x + hierarchical_moe(rmsnorm(x, g_moe[l]), w_group[l], b_group[l], w_router[l],
                                 b_router[l], w_gate[l], w_up[l], w_down[l])
    return rmsnorm(x, g_final)
```

```cpp
#include <hip/hip_runtime.h>
#include <cstdio>
#include <cstdint>

#define LAS __attribute__((address_space(3)))
typedef unsigned short bf16_t;
typedef short bf16x8 __attribute__((ext_vector_type(8)));
typedef float f32x2 __attribute__((ext_vector_type(2)));
typedef float f32x4 __attribute__((ext_vector_type(4)));
typedef float f32x16 __attribute__((ext_vector_type(16)));
typedef unsigned u32x2 __attribute__((ext_vector_type(2)));
typedef unsigned u32x4 __attribute__((ext_vector_type(4)));

#ifndef PH_MASK
#define PH_MASK 0xfebfu
#endif
#ifndef DUP_MASK
#define DUP_MASK 0u
#endif
#ifndef DUP_COUNT
#define DUP_COUNT 1
#endif
#ifndef MOE_FP8
#define MOE_FP8 1
#endif
#ifndef XATT_FP8
#define XATT_FP8 1
#endif
#ifndef N_LAUNCH_SPLIT
#define N_LAUNCH_SPLIT 0
#endif

constexpr int NB = 8, T = 2048, DM = 2048, NTOK = NB * T;
constexpr int MEM = 256, NMEM = NB * MEM;
constexpr int CW = 1024;
constexpr int NH = 8, DN = 128, DR = 64, DV = 128, DQK = DN + DR;
constexpr int QL = 512, KVL = 256;
constexpr int ZC = 4096;
constexpr int C_Q = 3072, C_KV = 3584, C_KR = 3840, IN_COLS = 3904;
constexpr int XH = 4, XD = 512;
constexpr int NG = 8, EPG = 8, NE = 64, DE = 512, NRT = NG + NE;
constexpr int LROWS = (NTOK * 2 / 256 + NE) * 256;
constexpr float EPS = 1e-6f;
constexpr float LOG2E = 1.4426950408889634f;

constexpr size_t MiB = 1u << 20;
constexpr size_t WS_CTL = 0, CTL_BYTES = 1 * MiB;
constexpr size_t CTL_SSQ_X = 64 * 1024, CTL_SSQ_MEM = 128 * 1024, CTL_CNT = 144 * 1024;
constexpr size_t CTL_SSQ_Q = 256 * 1024, CTL_SSQ_KV = 384 * 1024, CTL_SSQ_ATT = 512 * 1024, CTL_SSQ_1 = 640 * 1024, CTL_SSQ_2 = 768 * 1024;
constexpr size_t WS_TAB = 1 * MiB;
constexpr size_t WS_WRT = 5 * MiB;
constexpr size_t WS_TOKI = 6 * MiB;
constexpr size_t TOK_EID = WS_TOKI, TOK_GW = TOK_EID + 128 * 1024, TOK_RANK = TOK_GW + 128 * 1024, TOK_DEST = TOK_RANK + 128 * 1024, TOK_RSTD = TOK_DEST + 128 * 1024;
constexpr size_t ROW_TOK = TOK_RSTD + 64 * 1024, ROW_RS = ROW_TOK + 192 * 1024, ROW_W = ROW_RS + 192 * 1024;
constexpr size_t WS_WIN = 8 * MiB, WS_WQ = 24 * MiB, WS_WKV = 26 * MiB, WS_WOUT = 28 * MiB, WS_WXQ = 36 * MiB, WS_WXK = 44 * MiB, WS_WXV = 52 * MiB, WS_WXO = 60 * MiB;
constexpr size_t WS_WGU = 68 * MiB, WS_WD = 324 * MiB, ARENA = 452 * MiB;
constexpr size_t A_ZB = ARENA, A_X1B = ARENA, A_QX = ARENA + 64 * MiB, A_X2B = ARENA, A_ACT = ARENA + 65 * MiB;
constexpr size_t A_XB = ARENA + 128 * MiB, A_QB = A_XB, A_YCAT = A_XB, A_PBUF = A_XB;
constexpr size_t A_KB = ARENA + 192 * MiB, A_OX = A_KB, A_VT = ARENA + 224 * MiB, A_OATT = ARENA + 256 * MiB;
constexpr size_t A_MEMB = ARENA + 288 * MiB, A_KX = A_MEMB + 8 * MiB, A_VXT = A_MEMB + 16 * MiB, A_KROPE = A_MEMB + 24 * MiB;
constexpr size_t A_X2L = ARENA + 192 * MiB;
constexpr size_t A_SLAB = ARENA + 256 * MiB;
constexpr size_t A_MT = ARENA + 320 * MiB, A_VWT = ARENA + 352 * MiB;
constexpr size_t A_YBUF = ARENA + 256 * MiB;
constexpr size_t WS_END = ARENA + 448 * MiB;
constexpr size_t WS_DUMMY = WS_END;
constexpr size_t WS_NEED = (DUP_MASK != 0u) ? WS_END + 128 * MiB : WS_END;

constexpr int RING_BYTES = 131072;
constexpr int EPI_OFF = RING_BYTES;
constexpr int TAB_OFF = EPI_OFF + 8192;
constexpr int MISC_OFF = TAB_OFF + 1024;
constexpr int LDS_BYTES = 147456;
static_assert(MISC_OFF + 256 <= LDS_BYTES, "LDS map");
constexpr int NWAVES = 8;

__device__ __forceinline__ int lane_id() { return (int)__builtin_amdgcn_mbcnt_hi(~0u, __builtin_amdgcn_mbcnt_lo(~0u, 0u)); }
__device__ __forceinline__ unsigned cvt_pk_bf16(float lo, float hi) { unsigned r; asm volatile("v_cvt_pk_bf16_f32 %0, %1, %2" : "=v"(r) : "v"(lo), "v"(hi)); return r; }
__device__ __forceinline__ float bf_lo(unsigned w) { return __uint_as_float(w << 16); }
__device__ __forceinline__ float bf_hi(unsigned w) { return __uint_as_float(w & 0xffff0000u); }
__device__ __forceinline__ float wave_sum(float v) {
#pragma unroll
    for (int o = 1; o < 64; o <<= 1) v += __shfl_xor(v, o);
    return v;
}
typedef unsigned long long fx64;
__device__ __forceinline__ void fx_add(fx64* p, float q) { atomicAdd(p, (fx64)(q * 4294967296.0f)); }
__device__ __forceinline__ float fx_get(const fx64* p) { return (float)(*p) * 2.3283064365386963e-10f; }
__device__ __forceinline__ unsigned pk4_fp8(float a, float b, float c, float d) { int w = __builtin_amdgcn_cvt_pk_fp8_f32(a, b, 0, false); w = __builtin_amdgcn_cvt_pk_fp8_f32(c, d, w, true); return (unsigned)w; }
constexpr float F8_SX = 64.0f, F8_SW = 64.0f, F8_SD = 32.0f, F8_SACT = 16.0f, F8_SY = 16.0f, F8_SM = 32.0f, F8_SV = 4.0f, F8_SP = 256.0f;
#define LDS_WAIT() asm volatile("s_waitcnt lgkmcnt(0)" ::: "memory")
#define NTL(p) __builtin_nontemporal_load(p)
#define NTS(v, p) __builtin_nontemporal_store(v, p)
#define VM_WAIT() asm volatile("s_waitcnt vmcnt(0)" ::: "memory")

#define XB_TMO      128
#define XB_XCNT(j)  (256  + 64 * (j))
#define XB_XSUB(j)  (1280 + 64 * (j))
#define XB_XGEN(j)  (2304 + 64 * (j))
#define XB_TOP      3328
#define XB_TOPGEN   3392
#define XCD_BAR_WORDS 3456
#define XB_SPIN_CAP (1u << 18)
__device__ __forceinline__ unsigned xb_ld(unsigned* p)              { return __hip_atomic_load(p, __ATOMIC_RELAXED, __HIP_MEMORY_SCOPE_AGENT); }
__device__ __forceinline__ unsigned xb_add(unsigned* p, unsigned v) { return __hip_atomic_fetch_add(p, v, __ATOMIC_RELAXED, __HIP_MEMORY_SCOPE_AGENT); }
__device__ __forceinline__ unsigned xb_xcc_id() { return (unsigned)__builtin_amdgcn_s_getreg((3 << 11) | 20) & 0xFu; }
#define XB_SPIN(cond, bar) do { unsigned _sp = 0; while (cond) { __builtin_amdgcn_s_sleep(1); \
    if ((++_sp & 255u) == 0u) { if (xb_ld(&(bar)[XB_TMO])) break; if (_sp > XB_SPIN_CAP) { atomicAdd(&(bar)[XB_TMO], 1u); break; } } } } while (0)
struct XcdBarrier { unsigned* bar; unsigned x; volatile LAS unsigned* st; int wave; };
#define XB_THREAD0(b) ((b).wave == 0 && lane_id() == 0)
__device__ __forceinline__ XcdBarrier xcd_barrier_post(unsigned* bar, volatile LAS unsigned* st, int wave) {
    XcdBarrier b; b.bar = bar; b.x = xb_xcc_id(); b.st = st; b.wave = wave;
    if (XB_THREAD0(b)) (void)xb_add(&bar[XB_XCNT(b.x)], 1u);
    return b;
}
__device__ __forceinline__ void xcd_barrier_complete(unsigned* bar, unsigned x, unsigned& nloc, unsigned& nx) {
    const unsigned G = gridDim.x * gridDim.y * gridDim.z;
    unsigned sum, cnt, mine, sp = 0u;
    for (;;) {
        sum = 0u; cnt = 0u; mine = 0u;
#pragma unroll
        for (unsigned j = 0; j < 16; ++j) { const unsigned c = xb_ld(&bar[XB_XCNT(j)]); sum += c; cnt += (c > 0u) ? 1u : 0u; mine = (j == x) ? c : mine; }
        if (sum == G) break;
        __builtin_amdgcn_s_sleep(1);
        if ((++sp & 255u) == 0u) { if (xb_ld(&bar[XB_TMO])) break; if (sp > XB_SPIN_CAP) { atomicAdd(&bar[XB_TMO], 1u); break; } }
    }
    nloc = mine > 0u ? mine : 1u; nx = cnt > 0u ? cnt : 1u;
}
__device__ __forceinline__ void xcd_barrier(const XcdBarrier& b) {
    asm volatile("s_waitcnt vmcnt(0)" ::: "memory");
    __syncthreads();
    if (XB_THREAD0(b)) {
        unsigned* bar = b.bar;
        __builtin_amdgcn_s_waitcnt(0);
        unsigned nloc = b.st[0], nx = b.st[1];
        if (nloc == 0u) { xcd_barrier_complete(bar, b.x, nloc, nx); b.st[0] = nloc; b.st[1] = nx; }
        const unsigned old = xb_add(&bar[XB_XSUB(b.x)], 1u);
        const unsigned gen = old / nloc;
        if (old + 1u == (gen + 1u) * nloc) {
            __builtin_amdgcn_fence(__ATOMIC_RELEASE, "agent");
            asm volatile("s_waitcnt vmcnt(0)" ::: "memory");
            const unsigned og = xb_add(&bar[XB_TOP], 1u);
            const unsigned tg = og / nx;
            if (og + 1u == (tg + 1u) * nx) xb_add(&bar[XB_TOPGEN], 1u);
            else XB_SPIN(xb_ld(&bar[XB_TOPGEN]) == tg, bar);
            __builtin_amdgcn_fence(__ATOMIC_ACQUIRE, "agent");
            xb_add(&bar[XB_XGEN(b.x)], 1u);
            asm volatile("s_waitcnt vmcnt(0)" ::: "memory");
        } else {
            XB_SPIN(xb_ld(&bar[XB_XGEN(b.x)]) == gen, bar);
            __builtin_amdgcn_fence(__ATOMIC_ACQUIRE, "agent");
            asm volatile("s_waitcnt vmcnt(0)" ::: "memory");
        }
    }
    __syncthreads();
}

namespace pg8 {
constexpr int BM = 256, BK = 64, HALF = 128, HTB = HALF * BK * 2, STAGE_BYTES = 8 * HTB, NXCD = 8, WGM = 8;
__host__ __device__ __forceinline__ int lds_byte(int r, int c) { return (r >> 3) * 1024 + (r & 7) * 128 + ((((c >> 3) ^ (r & 7)) & 7) << 4) + (c & 7) * 2; }
__host__ __device__ __forceinline__ void stage_rc(int b, int& R, int& C) { const int s = b >> 10, sb = b & 1023, ri = sb >> 7, p = (sb >> 4) & 7; R = s * 8 + ri; C = ((p ^ ri) << 3) + ((sb & 15) >> 1); }
__host__ __device__ __forceinline__ int perm32(int rho) { const int n = rho >> 4, i = rho & 15; return 8 * (i >> 2) + 4 * n + (i & 3); }

struct Unit { const char* A; const char* B; int orow, ocol, aux; };

template <class Epi, class Sched, bool GATHER, int ES = 2>
__device__ __forceinline__ void gemm_phase(LAS unsigned char* lds, const int wave_id, const int K, const int lda, const int ldb, const Sched& S, const Epi& E) {
    int lane_ = lane_id(); asm volatile("" : "+v"(lane_));
    const int wid = wave_id, lane = lane_, tid = wid * 64 + lane, wr = wid >> 2, wc = wid & 3, fr = lane & 15, fq = lane >> 4;
    const int nt = (K * ES) / (BK * 2);
    unsigned voffA, voffB; int Rr[2], Cb[2];
    { int R, C; stage_rc(tid * 16, R, C); const int Rb = Epi::PERM ? ((R & ~31) + perm32(R & 31)) : R;
      voffA = (unsigned)(R * lda * ES + C * 2); voffB = (unsigned)(Rb * ldb * ES + C * 2); Rr[0] = R; Rr[1] = R + 64; Cb[0] = C * 2; Cb[1] = C * 2; }
    const size_t pstepA = (size_t)64 * lda * ES, pstepB = (size_t)64 * ldb * ES;
    const size_t kstep = (size_t)(BK * 2);
    const size_t hstepA = GATHER ? 0 : (size_t)HALF * lda * ES, hstepB = (size_t)HALF * ldb * ES;
    const unsigned ldsw = (unsigned)wid * 1024u;
    const int aoff0 = lds_byte(wr * 64 + fr, fq * 8), boff0 = lds_byte(wc * 32 + fr, fq * 8);
    unsigned oc[2][2], on[2][2], ox[2][2];
#define PG8_SA(b, h) (((b) * 2 + (h)) * HTB)
#define PG8_SB(b, h) ((4 + (b) * 2 + (h)) * HTB)
#define PG8_STAGE(bufoff, gbase, voff) do { _Pragma("unroll") for (int _i = 0; _i < 2; ++_i) \
        __builtin_amdgcn_global_load_lds((const unsigned*)((const char*)(gbase) + (voff)[_i]), (LAS unsigned*)(lds + (bufoff) + ldsw + _i * 8192), 16, 0, 0); } while (0)
#define PG8_STAGE1(bufoff, gbase, voff, pstep) do { _Pragma("unroll") for (int _i = 0; _i < 2; ++_i) \
        __builtin_amdgcn_global_load_lds((const unsigned*)((const char*)(gbase) + _i * (pstep) + (voff)), (LAS unsigned*)(lds + (bufoff) + ldsw + _i * 8192), 16, 0, 0); } while (0)
#define PG8_STAGE_A(bufoff, gbase, h, SET) do { if constexpr (GATHER) { PG8_STAGE(bufoff, gbase, SET[h]); } else { PG8_STAGE1(bufoff, (gbase) + (h) * hstepA, voffA, pstepA); } } while (0)
#define PG8_LDA(dst, b, h) do { int aoff1 = aoff0 ^ 64; asm volatile("" : "+v"(aoff1)); _Pragma("unroll") for (int m = 0; m < 4; ++m) { \
        if constexpr (ES == 2) { _Pragma("unroll") for (int k = 0; k < 2; ++k) dst[m][k] = *(const LAS bf16x8*)(lds + PG8_SA(b, h) + (k ? aoff1 : aoff0) + m * 2048); } \
        else { dst##8[m].lo = *(const LAS i4_t*)(lds + PG8_SA(b, h) + aoff0 + m * 2048); dst##8[m].hi = *(const LAS i4_t*)(lds + PG8_SA(b, h) + aoff1 + m * 2048); } } } while (0)
#define PG8_LDB(dst, b, h) do { int boff1 = boff0 ^ 64; asm volatile("" : "+v"(boff1)); _Pragma("unroll") for (int n = 0; n < 2; ++n) { \
        if constexpr (ES == 2) { _Pragma("unroll") for (int k = 0; k < 2; ++k) dst[n][k] = *(const LAS bf16x8*)(lds + PG8_SB(b, h) + (k ? boff1 : boff0) + n * 2048); } \
        else { dst##8[n].lo = *(const LAS i4_t*)(lds + PG8_SB(b, h) + boff0 + n * 2048); dst##8[n].hi = *(const LAS i4_t*)(lds + PG8_SB(b, h) + boff1 + n * 2048); } } } while (0)
#define PG8_MMA(ai, bj, At, Bt) do { __builtin_amdgcn_s_setprio(1); _Pragma("unroll") for (int m = 0; m < 4; ++m) _Pragma("unroll") for (int n = 0; n < 2; ++n) { \
        if constexpr (ES == 2) { _Pragma("unroll") for (int k = 0; k < 2; ++k) acc[ai][bj][m][n] = __builtin_amdgcn_mfma_f32_16x16x32_bf16(Bt[n][k], At[m][k], acc[ai][bj][m][n], 0, 0, 0); } \
        else asm volatile("v_mfma_scale_f32_16x16x128_f8f6f4 %0, %1, %2, %0, %3, %3 op_sel_hi:[0,0,0]" : "+v"(acc[ai][bj][m][n]) : "v"(Bt##8[n]), "v"(At##8[m]), "v"(mxs));     } \
        __builtin_amdgcn_s_setprio(0); } while (0)
#define PG8_WAIT_V(n) asm volatile("s_waitcnt vmcnt(" #n ")" ::: "memory")
#define PG8_WAIT_L(n) asm volatile("s_waitcnt lgkmcnt(" #n ")" ::: "memory")
#define PG8_BAR __builtin_amdgcn_s_barrier()
#define PG8_SCHED __builtin_amdgcn_sched_barrier(0)
    Unit cur, nxt; int ui = 0;
    if (!S.next(0, cur)) return;
    f32x4 acc[2][2][4][2];
#pragma unroll
    for (int a = 0; a < 2; ++a)
#pragma unroll
        for (int b = 0; b < 2; ++b)
#pragma unroll
            for (int m = 0; m < 4; ++m)
#pragma unroll
                for (int n = 0; n < 2; ++n) acc[a][b][m][n] = (f32x4){0.f, 0.f, 0.f, 0.f};
    typedef int i4_t __attribute__((ext_vector_type(4))); typedef int i8_t __attribute__((ext_vector_type(8)));
    const int mxs = 0x7f7f7f7f;
    bf16x8 At[4][2], B0[2][2], B1[2][2]; i8_t At8[4], B08[2], B18[2];
    const char* cA = cur.A; const char* cB = cur.B;
    if constexpr (GATHER) {
#pragma unroll
        for (int h = 0; h < 2; ++h)
#pragma unroll
            for (int i = 0; i < 2; ++i) oc[h][i] = S.rowoff(cur, h * HALF + Rr[i]) + (unsigned)Cb[i];
        asm volatile("s_waitcnt vmcnt(0)" : "+v"(oc[0][0]), "+v"(oc[0][1]), "+v"(oc[1][0]), "+v"(oc[1][1]) :: "memory");
    }
    PG8_STAGE1(PG8_SB(0, 0), cB, voffB, pstepB); PG8_STAGE1(PG8_SB(0, 1), cB + hstepB, voffB, pstepB); PG8_STAGE_A(PG8_SA(0, 0), cA, 0, oc); PG8_STAGE_A(PG8_SA(0, 1), cA, 1, oc);
    if (wr == 1) PG8_BAR;
    PG8_WAIT_V(2); PG8_BAR;
    PG8_STAGE1(PG8_SB(1, 0), cB + kstep, voffB, pstepB); PG8_STAGE_A(PG8_SA(1, 0), cA + kstep, 0, oc); PG8_STAGE1(PG8_SB(1, 1), cB + hstepB + kstep, voffB, pstepB);
    PG8_WAIT_V(6); PG8_BAR;
    for (;;) {
        const bool has_next = S.next(ui + 1, nxt);
        const char* nA = has_next ? nxt.A : cA; const char* nB = has_next ? nxt.B : cB;
        if constexpr (GATHER) {
            if (has_next) {
#pragma unroll
                for (int h = 0; h < 2; ++h)
#pragma unroll
                    for (int i = 0; i < 2; ++i) on[h][i] = S.rowoff(nxt, h * HALF + Rr[i]) + (unsigned)Cb[i];
                asm volatile("s_waitcnt vmcnt(0)" : "+v"(on[0][0]), "+v"(on[0][1]), "+v"(on[1][0]), "+v"(on[1][1]) :: "memory");
            } else {
#pragma unroll
                for (int h = 0; h < 2; ++h)
#pragma unroll
                    for (int i = 0; i < 2; ++i) on[h][i] = oc[h][i];
            }
        }
#pragma clang loop unroll(disable)
        for (int t = 0; t < nt; t += 2) {
            const bool last = (t == nt - 2);
            const char* a1 = cA + (size_t)(t + 1) * kstep;
            const char* a2 = last ? nA : cA + (size_t)(t + 2) * kstep; const char* b2 = last ? nB : cB + (size_t)(t + 2) * kstep;
            const char* a3 = a2 + kstep; const char* b3 = b2 + kstep;
            if constexpr (GATHER) {
#pragma unroll
                for (int h = 0; h < 2; ++h)
#pragma unroll
                    for (int i = 0; i < 2; ++i) ox[h][i] = last ? on[h][i] : oc[h][i];
            }
            PG8_LDB(B0, 0, 0); PG8_LDB(B1, 0, 1); PG8_SCHED; PG8_LDA(At, 0, 0); PG8_STAGE_A(PG8_SA(1, 1), a1, 1, oc);
            PG8_WAIT_V(8); PG8_WAIT_L(0); PG8_BAR; PG8_MMA(0, 0, At, B0); PG8_MMA(0, 1, At, B1); PG8_BAR; PG8_SCHED;
            PG8_LDA(At, 0, 1); PG8_STAGE1(PG8_SB(0, 0), b2, voffB, pstepB); PG8_STAGE1(PG8_SB(0, 1), b2 + hstepB, voffB, pstepB); PG8_STAGE_A(PG8_SA(0, 0), a2, 0, ox);
            PG8_WAIT_V(8); PG8_WAIT_L(0); PG8_BAR; PG8_MMA(1, 0, At, B0); PG8_MMA(1, 1, At, B1); PG8_BAR; PG8_SCHED;
            PG8_LDB(B0, 1, 0); PG8_LDB(B1, 1, 1); PG8_SCHED; PG8_LDA(At, 1, 0); PG8_STAGE_A(PG8_SA(0, 1), a2, 1, ox);
            PG8_WAIT_V(8); PG8_WAIT_L(0); PG8_BAR; PG8_MMA(0, 0, At, B0); PG8_MMA(0, 1, At, B1); PG8_BAR; PG8_SCHED;
            PG8_LDA(At, 1, 1); PG8_STAGE1(PG8_SB(1, 0), b3, voffB, pstepB); PG8_STAGE1(PG8_SB(1, 1), b3 + hstepB, voffB, pstepB); PG8_STAGE_A(PG8_SA(1, 0), a3, 0, ox);
            PG8_WAIT_V(8); PG8_WAIT_L(0); PG8_BAR; PG8_MMA(1, 0, At, B0); PG8_MMA(1, 1, At, B1); PG8_BAR; PG8_SCHED;
        }
        if (wr == 0) PG8_BAR;
        if constexpr (ES == 1) asm volatile("s_nop 15\n\ts_nop 15" ::: "memory");
        { int fr_e = fr, fq_e = fq; asm volatile("" : "+v"(fr_e), "+v"(fq_e));
          E(acc, cur, wr, wc, fr_e, fq_e); }
        if (!has_next) break;
#pragma unroll
        for (int a = 0; a < 2; ++a)
#pragma unroll
            for (int b = 0; b < 2; ++b)
#pragma unroll
                for (int m = 0; m < 4; ++m)
#pragma unroll
                    for (int n = 0; n < 2; ++n) acc[a][b][m][n] = (f32x4){0.f, 0.f, 0.f, 0.f};
        cur = nxt; cA = nA; cB = nB; ++ui;
        if constexpr (GATHER) {
#pragma unroll
            for (int h = 0; h < 2; ++h)
#pragma unroll
                for (int i = 0; i < 2; ++i) oc[h][i] = on[h][i];
        }
        if (wr == 1) PG8_BAR;
    }
    PG8_WAIT_V(0);
    PG8_BAR;
#undef PG8_SA
#undef PG8_SB
#undef PG8_STAGE
#undef PG8_STAGE1
#undef PG8_STAGE_A
#undef PG8_LDA
#undef PG8_LDB
#undef PG8_MMA
#undef PG8_WAIT_V
#undef PG8_WAIT_L
#undef PG8_BAR
#undef PG8_SCHED
}

struct DenseSched {
    const char* A; const char* B; int lda, ldb, nM, nN, nwg, G, c, first, last, es = 2;
    __device__ void init(const void* A_, const void* B_, int lda_, int ldb_, int M, int N, int G_, int c_, int first_ = 0, int count_ = -1) { A = (const char*)A_; B = (const char*)B_; lda = lda_; ldb = ldb_; nM = M / BM; nN = N / BM; nwg = nM * nN; G = G_; c = c_;
        first = first_; last = (count_ < 0) ? nwg : first_ + count_; }
    __device__ __forceinline__ bool next(int i, Unit& u) const {
        const long L = (long)first + (long)i * G + c; if (L >= last) return false;
        int wgid = (int)L; { const int q = nwg / NXCD, r = nwg % NXCD, xcd = wgid % NXCD, off = wgid / NXCD; wgid = (xcd < r ? xcd * (q + 1) : r * (q + 1) + (xcd - r) * q) + off; }
        const int nig = WGM * nN, gid = wgid / nig, fm = gid * WGM, gsz = (nM - fm) < WGM ? (nM - fm) : WGM;
        const int pm = fm + ((wgid % nig) % gsz), pn = (wgid % nig) / gsz;
        u.A = A + (size_t)pm * BM * lda * es; u.B = B + (size_t)pn * BM * ldb * es; u.orow = pm * BM; u.ocol = pn * BM; u.aux = 0; return true;
    }
    __device__ __forceinline__ unsigned rowoff(const Unit&, int) const { return 0u; }
};
}

template <int MODE> struct EpiBf16 {
    static constexpr bool PERM = true;
    bf16_t* O; int ldc; const float* sv; float inv_dim, mul;
    __device__ __forceinline__ void operator()(const f32x4 (&acc)[2][2][4][2], const pg8::Unit& u, int wr, int wc, int fr, int fq) const {
        const int row0 = u.orow + wr * 64 + fr, col0 = u.ocol + wc * 32 + 8 * fq;
#pragma unroll
        for (int ai = 0; ai < 2; ++ai)
#pragma unroll
            for (int m = 0; m < 4; ++m) { const int row = row0 + ai * 128 + m * 16;
                float s = mul; if (MODE == 1) s = mul / sqrtf(sv[row] * inv_dim + EPS); if (MODE == 2) s = mul * sv[row]; if (MODE == 3) s = mul / sqrtf(fx_get((const fx64*)sv + row) * inv_dim + EPS);
                bf16_t* rowp = O + (size_t)row * ldc + col0;
#pragma unroll
                for (int bj = 0; bj < 2; ++bj) { const f32x4 v0 = acc[ai][bj][m][0] * s, v1 = acc[ai][bj][m][1] * s;
                    u32x4 w; w.x = cvt_pk_bf16(v0[0], v0[1]); w.y = cvt_pk_bf16(v0[2], v0[3]); w.z = cvt_pk_bf16(v1[0], v1[1]); w.w = cvt_pk_bf16(v1[2], v1[3]);
                    *(u32x4*)(rowp + bj * 128) = w; } }
    }
};
struct EpiF8Rms {
    static constexpr bool PERM = true;
    unsigned char* O; int ldc; const float* ssq; float inv_dim, mul;
    __device__ __forceinline__ void operator()(const f32x4 (&acc)[2][2][4][2], const pg8::Unit& u, int wr, int wc, int fr, int fq) const {
        const int row0 = u.orow + wr * 64 + fr, col0 = u.ocol + wc * 32 + 8 * fq;
#pragma unroll
        for (int ai = 0; ai < 2; ++ai)
#pragma unroll
            for (int m = 0; m < 4; ++m) { const int row = row0 + ai * 128 + m * 16; const float s = mul / sqrtf(ssq[row] * inv_dim + EPS); unsigned char* rowp = O + (size_t)row * ldc + col0;
#pragma unroll
                for (int bj = 0; bj < 2; ++bj) { const f32x4 v0 = acc[ai][bj][m][0] * s, v1 = acc[ai][bj][m][1] * s;
                    u32x2 w; w.x = pk4_fp8(v0[0], v0[1], v0[2], v0[3]); w.y = pk4_fp8(v1[0], v1[1], v1[2], v1[3]); *(u32x2*)(rowp + bj * 128) = w; } }
    }
};
struct EpiF8 {
    static constexpr bool PERM = true;
    unsigned char* O; int ldc; float mul;
    __device__ __forceinline__ void operator()(const f32x4 (&acc)[2][2][4][2], const pg8::Unit& u, int wr, int wc, int fr, int fq) const {
        const int row0 = u.orow + wr * 64 + fr, col0 = u.ocol + wc * 32 + 8 * fq;
#pragma unroll
        for (int ai = 0; ai < 2; ++ai)
#pragma unroll
            for (int m = 0; m < 4; ++m) { unsigned char* rowp = O + (size_t)(row0 + ai * 128 + m * 16) * ldc + col0;
#pragma unroll
                for (int bj = 0; bj < 2; ++bj) { const f32x4 v0 = acc[ai][bj][m][0] * mul, v1 = acc[ai][bj][m][1] * mul;
                    u32x2 w; w.x = pk4_fp8(v0[0], v0[1], v0[2], v0[3]); w.y = pk4_fp8(v1[0], v1[1], v1[2], v1[3]); *(u32x2*)(rowp + bj * 128) = w; } }
    }
};
__device__ __forceinline__ void rope8(f32x4& v0, f32x4& v1, const f32x2* cs) {
    const f32x4 c01 = *(const f32x4*)cs, c23 = *(const f32x4*)(cs + 2);
    f32x4 a = v0, b = v1;
    v0[0] = a[0] * c01[0] - a[1] * c01[1]; v0[1] = a[1] * c01[0] + a[0] * c01[1];
    v0[2] = a[2] * c01[2] - a[3] * c01[3]; v0[3] = a[3] * c01[2] + a[2] * c01[3];
    v1[0] = b[0] * c23[0] - b[1] * c23[1]; v1[1] = b[1] * c23[0] + b[0] * c23[1];
    v1[2] = b[2] * c23[2] - b[3] * c23[3]; v1[3] = b[3] * c23[2] + b[2] * c23[3];
}
struct EpiZ {
    static constexpr bool PERM = true;
    bf16_t* zb; bf16_t* krope; const float* ssq_x; fx64* ssq_q; fx64* ssq_kv; const f32x2* tab;
    __device__ __forceinline__ void operator()(const f32x4 (&acc)[2][2][4][2], const pg8::Unit& u, int wr, int wc, int fr, int fq) const {
        const int row0 = u.orow + wr * 64 + fr, col0 = u.ocol + wc * 32 + 8 * fq;
        fx64* ssq = (u.ocol == C_Q || u.ocol == C_Q + 256) ? ssq_q : (u.ocol == C_KV ? ssq_kv : nullptr);
        const bool isrope = (u.ocol == C_KR) && (wc < 2);
#pragma unroll
        for (int ai = 0; ai < 2; ++ai)
#pragma unroll
            for (int m = 0; m < 4; ++m) { const int row = row0 + ai * 128 + m * 16;
                const float s = 1.0f / sqrtf(ssq_x[row] * (1.0f / DM) + EPS);
                bf16_t* rowp = zb + (size_t)row * ZC + col0; float q = 0.f;
#pragma unroll
                for (int bj = 0; bj < 2; ++bj) { f32x4 v0 = acc[ai][bj][m][0] * s, v1 = acc[ai][bj][m][1] * s;
                    q += (v0[0] * v0[0] + v0[1] * v0[1]) + (v0[2] * v0[2] + v0[3] * v0[3]) + (v1[0] * v1[0] + v1[1] * v1[1]) + (v1[2] * v1[2] + v1[3] * v1[3]);
                    u32x4 w; w.x = cvt_pk_bf16(v0[0], v0[1]); w.y = cvt_pk_bf16(v0[2], v0[3]); w.z = cvt_pk_bf16(v1[0], v1[1]); w.w = cvt_pk_bf16(v1[2], v1[3]);
                    *(u32x4*)(rowp + bj * 128) = w;
                    if (bj == 0 && isrope) { const int c = wc * 32 + 8 * fq;
                        rope8(v0, v1, tab + (size_t)row * 32 + (c >> 1));
                        u32x4 w2; w2.x = cvt_pk_bf16(v0[0], v0[1]); w2.y = cvt_pk_bf16(v0[2], v0[3]); w2.z = cvt_pk_bf16(v1[0], v1[1]); w2.w = cvt_pk_bf16(v1[2], v1[3]);
                        *(u32x4*)(krope + (size_t)row * DR + c) = w2; } }
                if (ssq) { q += __shfl_xor(q, 16); q += __shfl_xor(q, 32); if (fq == 0) fx_add(ssq + row, q); } }
    }
};
struct EpiQ {
    static constexpr bool PERM = true;
    bf16_t* qb; const fx64* ssq_q; const f32x2* tab;
    __device__ __forceinline__ void operator()(const f32x4 (&acc)[2][2][4][2], const pg8::Unit& u, int wr, int wc, int fr, int fq) const {
        const int row0 = u.orow + wr * 64 + fr, col0 = u.ocol + wc * 32 + 8 * fq;
        const float qs = LOG2E * 0.07216878364870322f;
#pragma unroll
        for (int ai = 0; ai < 2; ++ai)
#pragma unroll
            for (int m = 0; m < 4; ++m) { const int row = row0 + ai * 128 + m * 16;
                const float s = 1.0f / sqrtf(fx_get(ssq_q + row) * (1.0f / QL) + EPS);
                bf16_t* rowp = qb + (size_t)row * (NH * DQK) + col0;
#pragma unroll
                for (int bj = 0; bj < 2; ++bj) { f32x4 v0 = acc[ai][bj][m][0] * s, v1 = acc[ai][bj][m][1] * s;
                    const int d = (col0 + bj * 128) % DQK;
                    if (d >= DN) rope8(v0, v1, tab + (size_t)row * 32 + ((d - DN) >> 1));
                    v0 = v0 * qs; v1 = v1 * qs;
                    u32x4 w; w.x = cvt_pk_bf16(v0[0], v0[1]); w.y = cvt_pk_bf16(v0[2], v0[3]); w.z = cvt_pk_bf16(v1[0], v1[1]); w.w = cvt_pk_bf16(v1[2], v1[3]);
                    *(u32x4*)(rowp + bj * 128) = w; } }
    }
};
template <bool KPERM> struct EpiColScale {
    static constexpr bool PERM = false;
    bf16_t* O; int ldc; const fx64* ssq; float inv_dim;
    __device__ __forceinline__ void operator()(const f32x4 (&acc)[2][2][4][2], const pg8::Unit& u, int wr, int wc, int fr, int fq) const {
        const int row0 = u.orow + wr * 64 + fr, colb = u.ocol + wc * 32;
        const int fqp = KPERM ? (((fq & 1) << 1) | (fq >> 1)) : fq;
#pragma unroll
        for (int bj = 0; bj < 2; ++bj)
#pragma unroll
            for (int n = 0; n < 2; ++n) { const fx64* qp = ssq + colb + bj * 128 + n * 16 + 4 * fq; f32x4 sc;
#pragma unroll
                for (int e = 0; e < 4; ++e) sc[e] = 1.0f / sqrtf(fx_get(qp + e) * inv_dim + EPS);
#pragma unroll
                for (int ai = 0; ai < 2; ++ai)
#pragma unroll
                    for (int m = 0; m < 4; ++m) { bf16_t* rowp = O + (size_t)(row0 + ai * 128 + m * 16) * ldc + colb + 4 * fqp; const f32x4 v = acc[ai][bj][m][n] * sc;
                        u32x2 w; w.x = cvt_pk_bf16(v[0], v[1]); w.y = cvt_pk_bf16(v[2], v[3]); *(u32x2*)(rowp + bj * 128 + n * 16) = w; } }
    }
};
template <bool FROM_F32> struct EpiResidHL {
    static constexpr bool PERM = true;
    const float* xf; const bf16_t* xih; const bf16_t* xil; bf16_t* xh; bf16_t* xl; fx64* ssq; unsigned char* x8; float amul;
    __device__ __forceinline__ void operator()(const f32x4 (&acc)[2][2][4][2], const pg8::Unit& u, int wr, int wc, int fr, int fq) const {
        const int row0 = u.orow + wr * 64 + fr, col0 = u.ocol + wc * 32 + 8 * fq;
#pragma unroll
        for (int ai = 0; ai < 2; ++ai) {
            f32x4 xv[4][2][2];
#pragma unroll
            for (int m = 0; m < 4; ++m)
#pragma unroll
                for (int bj = 0; bj < 2; ++bj) { const size_t off = (size_t)(row0 + ai * 128 + m * 16) * DM + col0 + bj * 128;
                    if (FROM_F32) { xv[m][bj][0] = NTL((const f32x4*)(xf + off)); xv[m][bj][1] = NTL((const f32x4*)(xf + off + 4)); }
                    else { const u32x4 h = NTL((const u32x4*)(xih + off)), l = NTL((const u32x4*)(xil + off));
                        xv[m][bj][0] = (f32x4){bf_lo(h.x) + bf_lo(l.x), bf_hi(h.x) + bf_hi(l.x), bf_lo(h.y) + bf_lo(l.y), bf_hi(h.y) + bf_hi(l.y)};
                        xv[m][bj][1] = (f32x4){bf_lo(h.z) + bf_lo(l.z), bf_hi(h.z) + bf_hi(l.z), bf_lo(h.w) + bf_lo(l.w), bf_hi(h.w) + bf_hi(l.w)}; } }
#pragma unroll
            for (int m = 0; m < 4; ++m) { const int row = row0 + ai * 128 + m * 16; float q = 0.f;
#pragma unroll
                for (int bj = 0; bj < 2; ++bj) { const size_t off = (size_t)row * DM + col0 + bj * 128;
                    const f32x4 v0 = xv[m][bj][0] + acc[ai][bj][m][0] * amul, v1 = xv[m][bj][1] + acc[ai][bj][m][1] * amul;
                    q += ((v0[0] * v0[0] + v0[1] * v0[1]) + (v0[2] * v0[2] + v0[3] * v0[3])) + ((v1[0] * v1[0] + v1[1] * v1[1]) + (v1[2] * v1[2] + v1[3] * v1[3]));
                    u32x4 h; h.x = cvt_pk_bf16(v0[0], v0[1]); h.y = cvt_pk_bf16(v0[2], v0[3]); h.z = cvt_pk_bf16(v1[0], v1[1]); h.w = cvt_pk_bf16(v1[2], v1[3]); *(u32x4*)(xh + off) = h;
                    u32x4 l; l.x = cvt_pk_bf16(v0[0] - bf_lo(h.x), v0[1] - bf_hi(h.x)); l.y = cvt_pk_bf16(v0[2] - bf_lo(h.y), v0[3] - bf_hi(h.y));
                    l.z = cvt_pk_bf16(v1[0] - bf_lo(h.z), v1[1] - bf_hi(h.z)); l.w = cvt_pk_bf16(v1[2] - bf_lo(h.w), v1[3] - bf_hi(h.w)); *(u32x4*)(xl + off) = l;
                    if (x8) { u32x2 w; w.x = pk4_fp8(v0[0], v0[1], v0[2], v0[3]); w.y = pk4_fp8(v1[0], v1[1], v1[2], v1[3]); *(u32x2*)(x8 + off) = w; } }
                q += __shfl_xor(q, 16); q += __shfl_xor(q, 32); if (fq == 0) fx_add(ssq + row, q); }
        }
    }
};
struct EpiSoftmax {
    static constexpr bool PERM = true;
    bf16_t* P; int ldc; LAS float* tmax; LAS float* tsum; const fx64* ssq; float inv_dim; float smul; unsigned char* P8;
    __device__ __forceinline__ void operator()(f32x4 (&acc)[2][2][4][2], const pg8::Unit& u, int wr, int wc, int fr, int fq) const {
        const int col0 = u.ocol + wc * 32 + 8 * fq;
#pragma unroll
        for (int ai = 0; ai < 2; ++ai)
#pragma unroll
            for (int m = 0; m < 4; ++m) { float v = -3.0e38f; const float rs = smul / sqrtf(fx_get(ssq + u.orow + ai * 128 + wr * 64 + m * 16 + fr) * inv_dim + EPS);
#pragma unroll
                for (int bj = 0; bj < 2; ++bj)
#pragma unroll
                    for (int n = 0; n < 2; ++n) { const f32x4 x = acc[ai][bj][m][n] * rs; acc[ai][bj][m][n] = x; v = fmaxf(fmaxf(fmaxf(v, x[0]), fmaxf(x[1], x[2])), x[3]); }
                v = fmaxf(v, __shfl_xor(v, 16)); v = fmaxf(v, __shfl_xor(v, 32));
                if (fq == 0) tmax[(ai * 128 + wr * 64 + m * 16 + fr) * 4 + wc] = v; }
        LDS_WAIT(); __builtin_amdgcn_s_barrier(); asm volatile("" ::: "memory");
#pragma unroll
        for (int ai = 0; ai < 2; ++ai)
#pragma unroll
            for (int m = 0; m < 4; ++m) { const f32x4 t = *(const LAS f32x4*)(tmax + (ai * 128 + wr * 64 + m * 16 + fr) * 4);
                const float rm = fmaxf(fmaxf(t[0], t[1]), fmaxf(t[2], t[3])); float s = 0.f;
#pragma unroll
                for (int bj = 0; bj < 2; ++bj)
#pragma unroll
                    for (int n = 0; n < 2; ++n) { f32x4 x = acc[ai][bj][m][n] - rm;
#pragma unroll
                        for (int e = 0; e < 4; ++e) x[e] = __builtin_amdgcn_exp2f(x[e]);
                        s += (x[0] + x[1]) + (x[2] + x[3]); acc[ai][bj][m][n] = x; }
                s += __shfl_xor(s, 16); s += __shfl_xor(s, 32);
                if (fq == 0) tsum[(ai * 128 + wr * 64 + m * 16 + fr) * 4 + wc] = s; }
        LDS_WAIT(); __builtin_amdgcn_s_barrier(); asm volatile("" ::: "memory");
#pragma unroll
        for (int ai = 0; ai < 2; ++ai)
#pragma unroll
            for (int m = 0; m < 4; ++m) { const int rl = ai * 128 + wr * 64 + m * 16 + fr; const f32x4 t = *(const LAS f32x4*)(tsum + rl * 4);
                const float inv = 1.0f / ((t[0] + t[1]) + (t[2] + t[3]));
                bf16_t* rowp = P + (size_t)(u.orow + rl) * ldc + col0; unsigned char* rowp8 = P8 + (size_t)(u.orow + rl) * ldc + col0;
#pragma unroll
                for (int bj = 0; bj < 2; ++bj) { const f32x4 v0 = acc[ai][bj][m][0] * inv, v1 = acc[ai][bj][m][1] * inv;
                    if (P8) { const f32x4 a0 = v0 * F8_SP, a1 = v1 * F8_SP; u32x2 w; w.x = pk4_fp8(a0[0], a0[1], a0[2], a0[3]); w.y = pk4_fp8(a1[0], a1[1], a1[2], a1[3]); *(u32x2*)(rowp8 + bj * 128) = w; }
                    else { u32x4 w; w.x = cvt_pk_bf16(v0[0], v0[1]); w.y = cvt_pk_bf16(v0[2], v0[3]); w.z = cvt_pk_bf16(v1[0], v1[1]); w.w = cvt_pk_bf16(v1[2], v1[3]);
                    *(u32x4*)(rowp + bj * 128) = w; } } }
    }
};
struct EpiF8Row {
    static constexpr bool PERM = true;
    unsigned char* O; int ldc; const float* sv; float mul;
    __device__ __forceinline__ void operator()(const f32x4 (&acc)[2][2][4][2], const pg8::Unit& u, int wr, int wc, int fr, int fq) const {
        const int row0 = u.orow + wr * 64 + fr, col0 = u.ocol + wc * 32 + 8 * fq;
#pragma unroll
        for (int ai = 0; ai < 2; ++ai)
#pragma unroll
            for (int m = 0; m < 4; ++m) { const int row = row0 + ai * 128 + m * 16; const float s = sv[row] * mul; unsigned char* rowp = O + (size_t)row * ldc + col0;
#pragma unroll
                for (int bj = 0; bj < 2; ++bj) { const f32x4 v0 = acc[ai][bj][m][0] * s, v1 = acc[ai][bj][m][1] * s;
                    u32x2 w; w.x = pk4_fp8(v0[0], v0[1], v0[2], v0[3]); w.y = pk4_fp8(v1[0], v1[1], v1[2], v1[3]); *(u32x2*)(rowp + bj * 128) = w; } }
    }
};
struct EpiGateUp8 {
    static constexpr bool PERM = true;
    unsigned char* act; const float* row_rs;
    __device__ __forceinline__ void operator()(const f32x4 (&acc)[2][2][4][2], const pg8::Unit& u, int wr, int wc, int fr, int fq) const {
        const int row0 = u.orow + wr * 64 + fr, col0 = u.ocol + wc * 32 + 8 * fq;
#pragma unroll
        for (int ai = 0; ai < 2; ++ai)
#pragma unroll
            for (int m = 0; m < 4; ++m) { const int row = row0 + ai * 128 + m * 16; const float s = row_rs[row] * (1.0f / F8_SW);
                float o[8];
#pragma unroll
                for (int n = 0; n < 2; ++n)
#pragma unroll
                    for (int e = 0; e < 4; ++e) { const float g = acc[ai][0][m][n][e] * s, up = acc[ai][1][m][n][e] * s; o[n * 4 + e] = g / (1.0f + __expf(-g)) * up * F8_SACT; }
                u32x2 w; w.x = pk4_fp8(o[0], o[1], o[2], o[3]); w.y = pk4_fp8(o[4], o[5], o[6], o[7]);
                *(u32x2*)(act + (size_t)row * DE + col0) = w; }
    }
};
struct EpiGateUp {
    static constexpr bool PERM = true;
    bf16_t* act; const float* row_rs;
    __device__ __forceinline__ void operator()(const f32x4 (&acc)[2][2][4][2], const pg8::Unit& u, int wr, int wc, int fr, int fq) const {
        const int row0 = u.orow + wr * 64 + fr, col0 = u.ocol + wc * 32 + 8 * fq;
#pragma unroll
        for (int ai = 0; ai < 2; ++ai)
#pragma unroll
            for (int m = 0; m < 4; ++m) { const int row = row0 + ai * 128 + m * 16; const float s = row_rs[row];
                float o[8];
#pragma unroll
                for (int n = 0; n < 2; ++n)
#pragma unroll
                    for (int e = 0; e < 4; ++e) { const float g = acc[ai][0][m][n][e] * s, up = acc[ai][1][m][n][e] * s; o[n * 4 + e] = g / (1.0f + __expf(-g)) * up; }
                u32x4 w; w.x = cvt_pk_bf16(o[0], o[1]); w.y = cvt_pk_bf16(o[2], o[3]); w.z = cvt_pk_bf16(o[4], o[5]); w.w = cvt_pk_bf16(o[6], o[7]);
                *(u32x4*)(act + (size_t)row * DE + col0) = w; }
    }
};

struct EpiRouter {
    static constexpr bool PERM = false;
    float* slab;
    __device__ __forceinline__ void operator()(const f32x4 (&acc)[2][2][4][2], const pg8::Unit& u, int wr, int wc, int fr, int fq) const {
        if (wc < 3) {
            const int row0 = u.orow + wr * 64 + fr, col0 = wc * 32 + 4 * fq;
#pragma unroll
            for (int ai = 0; ai < 2; ++ai)
#pragma unroll
                for (int m = 0; m < 4; ++m) { float* rowp = slab + ((size_t)u.aux * NTOK + row0 + ai * 128 + m * 16) * 96 + col0;
#pragma unroll
                    for (int n = 0; n < 2; ++n) *(f32x4*)(rowp + n * 16) = acc[ai][0][m][n] + acc[ai][1][m][n]; }
        }
    }
};

struct MtSched {
    const char* kx_; const char* wq; int G, c, es;
    __device__ __forceinline__ bool next(int i, pg8::Unit& u) const { const int L = i * G + c; if (L >= NB * XH * 8) return false;
        const int bh = L >> 3, pn = L & 7, b = bh >> 2, h = bh & 3;
        u.A = kx_ + ((size_t)(b * MEM) * DM + h * XD) * es; u.B = wq + ((size_t)(pn * 256) * DM + h * XD) * es; u.orow = bh * MEM; u.ocol = pn * 256; u.aux = 0; return true; }
    __device__ __forceinline__ unsigned rowoff(const pg8::Unit&, int) const { return 0u; }
};
struct VWtSched {
    const char* wo; const char* vx_; int G, c, es;
    __device__ __forceinline__ bool next(int i, pg8::Unit& u) const { const int L = i * G + c; if (L >= NB * XH * 8) return false;
        const int bh = L >> 3, pm = L & 7, b = bh >> 2, h = bh & 3;
        u.A = wo + ((size_t)(pm * 256) * DM + h * XD) * es; u.B = vx_ + ((size_t)(b * MEM) * DM + h * XD) * es; u.orow = b * DM + pm * 256; u.ocol = h * MEM; u.aux = 0; return true; }
    __device__ __forceinline__ unsigned rowoff(const pg8::Unit&, int) const { return 0u; }
};
struct CrossSSched {
    const char* xa; const char* mt; int G, c, es;
    __device__ __forceinline__ bool next(int i, pg8::Unit& u) const { const int L = i * G + c; if (L >= NB * XH * 8) return false;
        const int b = L >> 5, h = (L >> 3) & 3, qb = L & 7;
        u.A = xa + (size_t)(b * T + qb * 256) * DM * es; u.B = mt + (size_t)((b * XH + h) * MEM) * DM * es; u.orow = b * T + qb * 256; u.ocol = h * MEM; u.aux = 0; return true; }
    __device__ __forceinline__ unsigned rowoff(const pg8::Unit&, int) const { return 0u; }
};
struct CrossOSched {
    const char* pb; const char* vwt; int G, c, es;
    __device__ __forceinline__ bool next(int i, pg8::Unit& u) const { const int L = i * G + c; if (L >= NB * 8 * 8) return false;
        const int b = L >> 6, qb = (L >> 3) & 7, pn = L & 7;
        u.A = pb + (size_t)(b * T + qb * 256) * (XH * MEM) * es; u.B = vwt + (size_t)(b * DM + pn * 256) * (XH * MEM) * es; u.orow = b * T + qb * 256; u.ocol = pn * 256; u.aux = 0; return true; }
    __device__ __forceinline__ unsigned rowoff(const pg8::Unit&, int) const { return 0u; }
};
struct RouterSched {
    const char* xh; const char* xl; const char* wrt; int G, c;
    __device__ __forceinline__ bool next(int i, pg8::Unit& u) const { const int L = i * G + c; if (L >= (NTOK / 256) * 4) return false;
        const int pm = L >> 2, kq = L & 3;
        u.A = (kq < 2 ? xh : xl) + ((size_t)pm * 256 * DM + (kq & 1) * 1024) * 2; u.B = wrt + (size_t)kq * 1024 * 2; u.orow = pm * 256; u.ocol = 0; u.aux = kq; return true; }
    __device__ __forceinline__ unsigned rowoff(const pg8::Unit&, int) const { return 0u; }
};
struct MoeSched {
    const char* A; const char* B; const int* row_tok; const LAS int* blk_e; int nunits, ntl2, G, c; size_t a_blk_stride, b_exp_stride, b_tile_stride; int ocol_step; unsigned rowbytes;
    __device__ __forceinline__ bool next(int i, pg8::Unit& u) const { const int L = i * G + c; if (L >= nunits) return false;
        const int blk = L >> ntl2, nt = L & ((1 << ntl2) - 1), e = blk_e[blk];
        u.A = A + (size_t)blk * a_blk_stride; u.B = B + (size_t)e * b_exp_stride + (size_t)nt * b_tile_stride; u.orow = blk * 256; u.ocol = nt * ocol_step; u.aux = e; return true; }
    __device__ __forceinline__ unsigned rowoff(const pg8::Unit& u, int r) const { return (unsigned)row_tok[u.orow + r] * rowbytes; }
};

struct Args {
    const float* x; const float* mem; const int* pos; const float* g_mix; const float* w_in; const float* w_conv; const float* g_q_a; const float* w_q_up; const float* g_kv_a; const float* w_kv_up;
    const float* g_conv_out; const float* g_attn_out; const float* w_out; const float* g_xattn; const float* g_mem; const float* w_xq; const float* w_xk; const float* w_xv; const float* w_xo;
    const float* g_moe; const float* w_group; const float* b_group; const float* w_router; const float* b_router; const float* w_gate; const float* w_up; const float* w_down; const float* g_final;
    float* out; unsigned char* ws; unsigned mask; unsigned flags;
};

template <int MAP> __device__ __forceinline__ int map_row(int n) {
    if (MAP == 1) { if (n < C_KR) return n; const int r = n - C_KR; return C_KR + (r < 32 ? 2 * r : 2 * (r - 32) + 1); }
    if (MAP == 2) { const int h = n / DQK, d = n % DQK; if (d < DN) return n; const int r = d - DN; return h * DQK + DN + (r < 32 ? 2 * r : 2 * (r - 32) + 1); }
    if (MAP == 3) { const int h = n >> 8, d = n & 255; return d < DN ? h * DN + d : NH * DN + h * DV + (d - DN); }
    if (MAP == 4) { return ((n >> 7) << 8) + (n & 127); }
    if (MAP == 5) { return ((n >> 7) << 8) + 128 + (n & 127); }
    return n;
}
template <int MAP, bool HAS_GAIN>
__device__ __forceinline__ void transpose_item(const float* W, int ldw, const float* gain, const float* gain2, int gsplit, bf16_t* WT, int ldo, LAS float* scr, int k0, int n0, int lane) {
    float gv = 1.0f;
    if (HAS_GAIN) { const float* gp = (k0 < gsplit) ? gain + k0 : gain2 + (k0 - gsplit); gv = gp[lane]; }
    const int kr = lane >> 3, nc = (lane & 7) * 4;
    f32x4 v[8];
#pragma unroll
    for (int i = 0; i < 8; ++i) v[i] = NTL((const f32x4*)(W + (size_t)(k0 + 8 * i + kr) * ldw + n0 + nc));
#pragma unroll
    for (int i = 0; i < 8; ++i) { const int kk = 8 * i + kr; float g = 1.0f;
        if (HAS_GAIN) g = __shfl(gv, kk);
        LAS float* d = scr + kk * 33 + nc; d[0] = v[i][0] * g; d[1] = v[i][1] * g; d[2] = v[i][2] * g; d[3] = v[i][3] * g; }
    LDS_WAIT(); asm volatile("" ::: "memory");
    const int c = lane & 7;
#pragma unroll
    for (int j = 0; j < 4; ++j) { const int n = (lane >> 3) + 8 * j; const LAS float* s = scr + (8 * c) * 33 + n;
        u32x4 o; o.x = cvt_pk_bf16(s[0 * 33], s[1 * 33]); o.y = cvt_pk_bf16(s[2 * 33], s[3 * 33]); o.z = cvt_pk_bf16(s[4 * 33], s[5 * 33]); o.w = cvt_pk_bf16(s[6 * 33], s[7 * 33]);
        *(u32x4*)(WT + (size_t)map_row<MAP>(n0 + n) * ldo + k0 + 8 * c) = o; }
    LDS_WAIT(); asm volatile("" ::: "memory");
}
template <int MAP, bool HAS_GAIN>
__device__ __forceinline__ void transpose_item8(const float* W, int ldw, const float* gain, float scale, unsigned char* WT, int ldo, LAS float* scr, int k0, int n0, int lane) {
    float gv = scale;
    if (HAS_GAIN) gv = gain[k0 + lane] * scale;
    const int kr = lane >> 3, nc = (lane & 7) * 4;
    f32x4 v[8];
#pragma unroll
    for (int i = 0; i < 8; ++i) v[i] = NTL((const f32x4*)(W + (size_t)(k0 + 8 * i + kr) * ldw + n0 + nc));
#pragma unroll
    for (int i = 0; i < 8; ++i) { const int kk = 8 * i + kr; const float g = __shfl(gv, kk);
        LAS float* d = scr + kk * 33 + nc; d[0] = v[i][0] * g; d[1] = v[i][1] * g; d[2] = v[i][2] * g; d[3] = v[i][3] * g; }
    LDS_WAIT(); asm volatile("" ::: "memory");
    const int c = lane & 7;
#pragma unroll
    for (int j = 0; j < 4; ++j) { const int n = (lane >> 3) + 8 * j; const LAS float* s = scr + (8 * c) * 33 + n;
        u32x2 o; o.x = pk4_fp8(s[0 * 33], s[1 * 33], s[2 * 33], s[3 * 33]); o.y = pk4_fp8(s[4 * 33], s[5 * 33], s[6 * 33], s[7 * 33]);
        *(u32x2*)(WT + (size_t)map_row<MAP>(n0 + n) * ldo + k0 + 8 * c) = o; }
    LDS_WAIT(); asm volatile("" ::: "memory");
}

struct XItem { const float* W; const float* gain; unsigned char* WT; int ldw, ldo, k0, n0, gu, upoff; float scale; };
constexpr int XP_PITCH = 528, XP_BUF = 128 * XP_PITCH;
static_assert(2 * XP_BUF <= TAB_OFF, "transposer LDS");
__device__ __forceinline__ void xp_load(f32x4 (&v)[8][4], f32x4 (&g)[8], const XItem& x, int wave, int lane) {
    const int nq = (wave & 1) * 64 + lane, kg = wave >> 1;
    if (x.gain) { const float* gp = x.gain + x.k0 + 4 * kg;
#pragma unroll
        for (int j = 0; j < 8; ++j) g[j] = *(const f32x4*)(gp + 16 * j); }
    else {
#pragma unroll
        for (int j = 0; j < 8; ++j) g[j] = (f32x4){1.f, 1.f, 1.f, 1.f}; }
    const float* p = x.W + (size_t)(x.k0 + 4 * kg) * x.ldw + x.n0 + 4 * nq;
#pragma unroll
    for (int j = 0; j < 8; ++j)
#pragma unroll
        for (int r = 0; r < 4; ++r) v[j][r] = __builtin_nontemporal_load((const f32x4*)(p + (size_t)(16 * j + r) * x.ldw));
}
__device__ __forceinline__ void xp_pack(const f32x4 (&v)[8][4], const f32x4 (&g)[8], const XItem& x, LAS unsigned char* buf, int wave, int lane) {
    const int nq = (wave & 1) * 64 + lane, kg = wave >> 1;
    LAS unsigned char* d = buf + nq * XP_PITCH + kg * 128;
#pragma unroll
    for (int j = 0; j < 8; ++j) {
        const f32x4 gs = g[j] * x.scale;
        u32x4 o;
#pragma unroll
        for (int i = 0; i < 4; ++i) o[i] = pk4_fp8(v[j][0][i] * gs[0], v[j][1][i] * gs[1], v[j][2][i] * gs[2], v[j][3][i] * gs[3]);
        *(LAS u32x4*)(d + j * 16) = o;
    }
}
__device__ __forceinline__ void xp_store(const XItem& x, const LAS unsigned char* buf, int wave, int lane) {
    const int c = lane & 7;
#pragma unroll
    for (int u = 0; u < 2; ++u) {
        const int nq = (wave * 2 + u) * 8 + (lane >> 3);
        const LAS unsigned char* s = buf + nq * XP_PITCH + c * 16;
        u32x4 r[4];
#pragma unroll
        for (int q = 0; q < 4; ++q) r[q] = *(const LAS u32x4*)(s + q * 128);
#pragma unroll
        for (int i = 0; i < 4; ++i) { const int n = x.n0 + 4 * nq + i; const int row = x.gu ? ((n >> 7) << 8) + (n & 127) + x.upoff : n;
            __builtin_nontemporal_store((u32x4){r[0][i], r[1][i], r[2][i], r[3][i]}, (u32x4*)(x.WT + (size_t)row * x.ldo + x.k0 + 16 * c)); }
    }
}
__device__ __forceinline__ void row_to_bf16(const float* xrow, bf16_t* orow, float* ssq_out, int lane) {
    const f32x4* xr = (const f32x4*)xrow + lane; f32x4 v[8]; float s = 0.f;
#pragma unroll
    for (int j = 0; j < 8; ++j) { v[j] = NTL(xr + 64 * j); s += (v[j][0] * v[j][0] + v[j][1] * v[j][1]) + (v[j][2] * v[j][2] + v[j][3] * v[j][3]); }
    s = wave_sum(s);
    u32x2* o8 = (u32x2*)orow + lane;
#pragma unroll
    for (int j = 0; j < 8; ++j) { u32x2 w; w.x = cvt_pk_bf16(v[j][0], v[j][1]); w.y = cvt_pk_bf16(v[j][2], v[j][3]); o8[64 * j] = w; }
    if (lane == 0) *ssq_out = s;
}

__device__ __forceinline__ void row_to_f8(const float* xrow, unsigned char* orow, float* ssq_out, int lane) {
    const f32x4* xr = (const f32x4*)xrow + lane; f32x4 v[8]; float s = 0.f;
#pragma unroll
    for (int j = 0; j < 8; ++j) { v[j] = NTL(xr + 64 * j); s += (v[j][0] * v[j][0] + v[j][1] * v[j][1]) + (v[j][2] * v[j][2] + v[j][3] * v[j][3]); }
    s = wave_sum(s);
    unsigned* o4 = (unsigned*)orow + lane;
#pragma unroll
    for (int j = 0; j < 8; ++j) o4[64 * j] = pk4_fp8(v[j][0], v[j][1], v[j][2], v[j][3]);
    if (lane == 0) *ssq_out = s;
}

constexpr int KROW = 400, VROW = 144;
constexpr int KBUF = 64 * KROW, VBUF = 128 * VROW;
constexpr int ATT_K0 = 0, ATT_V0 = 2 * KBUF;
static_assert(2 * KBUF + 2 * VBUF <= RING_BYTES, "attention LDS");
__device__ __forceinline__ void mla_attn_unit(LAS unsigned char* lds, const int wave_id, const bf16_t* qb, const bf16_t* kb, const bf16_t* kr, const bf16_t* vT, bf16_t* oatt, fx64* ssq_att, int b, int h, int qblk) {
    int lane_ = lane_id(); asm volatile("" : "+v"(lane_));
    const int wid = wave_id, lane = lane_, tid = wid * 64 + lane, r32 = lane & 31, hi = lane >> 5;
    const int q0 = qblk * 256 + wid * 32;
    const size_t tok0 = (size_t)b * T;
    bf16x8 qf[12];
    { const bf16_t* qrow = qb + (tok0 + q0 + r32) * (NH * DQK) + h * DQK + hi * 8;
#pragma unroll
      for (int ks = 0; ks < 12; ++ks) qf[ks] = *(const bf16x8*)(qrow + ks * 16); }
    const int kn_r0 = tid >> 4, kn_c = tid & 15;
    const int kr_r = tid >> 3, kr_c = tid & 7;
    const int v_r0 = tid >> 3, v_c = tid & 7;
    const bf16_t* gkn = kb + (tok0 + kn_r0) * (NH * DN) + h * DN + kn_c * 8;
    const bf16_t* gkr = kr + (tok0 + kr_r) * DR + kr_c * 8;
    const bf16_t* gv = vT + (size_t)(h * DV + v_r0) * NTOK + tok0 + v_c * 8;
    const int lkn = kn_r0 * KROW + kn_c * 16, lkr = kr_r * KROW + 256 + kr_c * 16, lv = v_r0 * VROW + v_c * 16;
    const int ntiles = 4 * (qblk + 1);
    u32x4 sk0, sk1, skr, sv0, sv1;
#define ATT_LOAD(j) do { const size_t ko = (size_t)(j) * 64; sk0 = *(const u32x4*)(gkn + ko * (NH * DN)); sk1 = *(const u32x4*)(gkn + (ko + 32) * (NH * DN)); \
        skr = *(const u32x4*)(gkr + ko * DR); sv0 = *(const u32x4*)(gv + ko); sv1 = *(const u32x4*)(gv + ko + (size_t)64 * NTOK); } while (0)
#define ATT_WRITE(bufi) do { LAS unsigned char* kbp = lds + ATT_K0 + (bufi) * KBUF; LAS unsigned char* vbp = lds + ATT_V0 + (bufi) * VBUF; \
        *(LAS u32x4*)(kbp + lkn) = sk0; *(LAS u32x4*)(kbp + lkn + 32 * KROW) = sk1; *(LAS u32x4*)(kbp + lkr) = skr; \
        *(LAS u32x4*)(vbp + lv) = sv0; *(LAS u32x4*)(vbp + lv + 64 * VROW) = sv1; } while (0)
    f32x16 o[4];
#pragma unroll
    for (int d = 0; d < 4; ++d)
#pragma unroll
        for (int r = 0; r < 16; ++r) o[d][r] = 0.f;
    float m_run = -1.0e30f, l_run = 0.f;
    ATT_LOAD(0); ATT_WRITE(0);
    __syncthreads();
    for (int j = 0; j < ntiles; ++j) {
        const int buf = j & 1;
        if (j + 1 < ntiles) ATT_LOAD(j + 1);
        const int jrel = j - 4 * qblk;
        if (jrel <= (wid >> 1)) {
            const LAS unsigned char* kp = lds + ATT_K0 + buf * KBUF + r32 * KROW + hi * 16;
            const LAS unsigned char* vp = lds + ATT_V0 + buf * VBUF + r32 * VROW + hi * 16;
            f32x16 s0, s1;
#pragma unroll
            for (int r = 0; r < 16; ++r) { s0[r] = 0.f; s1[r] = 0.f; }
#pragma unroll
            for (int ks = 0; ks < 12; ++ks) { const bf16x8 a0 = *(const LAS bf16x8*)(kp + ks * 32), a1 = *(const LAS bf16x8*)(kp + 32 * KROW + ks * 32);
                s0 = __builtin_amdgcn_mfma_f32_32x32x16_bf16(a0, qf[ks], s0, 0, 0, 0);
                s1 = __builtin_amdgcn_mfma_f32_32x32x16_bf16(a1, qf[ks], s1, 0, 0, 0); }
            if (jrel == (wid >> 1)) {
                const int qrel = (wid & 1) * 32 + r32;
#pragma unroll
                for (int r = 0; r < 16; ++r) { const int kk = (r & 3) + 8 * (r >> 2) + 4 * hi;
                    if (kk > qrel) s0[r] = -1.0e30f; if (kk + 32 > qrel) s1[r] = -1.0e30f; }
            }
            float mx = s0[0];
#pragma unroll
            for (int r = 1; r < 16; ++r) mx = fmaxf(mx, s0[r]);
#pragma unroll
            for (int r = 0; r < 16; ++r) mx = fmaxf(mx, s1[r]);
            mx = fmaxf(mx, __shfl_xor(mx, 32));
            const float mn = fmaxf(m_run, mx), alpha = __builtin_amdgcn_exp2f(m_run - mn); m_run = mn;
            float ps = 0.f;
#pragma unroll
            for (int r = 0; r < 16; ++r) { s0[r] = __builtin_amdgcn_exp2f(s0[r] - mn); s1[r] = __builtin_amdgcn_exp2f(s1[r] - mn); ps += s0[r] + s1[r]; }
            l_run = l_run * alpha + ps;
#pragma unroll
            for (int d = 0; d < 4; ++d)
#pragma unroll
                for (int r = 0; r < 16; ++r) o[d][r] *= alpha;
            bf16x8 pf[4];
#pragma unroll
            for (int s = 0; s < 4; ++s) { const int base = (s & 1) * 8; u32x4 w;
                if (s < 2) { w.x = cvt_pk_bf16(s0[base + 0], s0[base + 1]); w.y = cvt_pk_bf16(s0[base + 2], s0[base + 3]); w.z = cvt_pk_bf16(s0[base + 4], s0[base + 5]); w.w = cvt_pk_bf16(s0[base + 6], s0[base + 7]); }
                else       { w.x = cvt_pk_bf16(s1[base + 0], s1[base + 1]); w.y = cvt_pk_bf16(s1[base + 2], s1[base + 3]); w.z = cvt_pk_bf16(s1[base + 4], s1[base + 5]); w.w = cvt_pk_bf16(s1[base + 6], s1[base + 7]); }
                pf[s] = *(bf16x8*)&w; }
#pragma unroll
            for (int d = 0; d < 4; ++d)
#pragma unroll
                for (int s = 0; s < 4; ++s) { const bf16x8 vf = *(const LAS bf16x8*)(vp + d * 32 * VROW + s * 32);
                    o[d] = __builtin_amdgcn_mfma_f32_32x32x16_bf16(vf, pf[s], o[d], 0, 0, 0); }
        }
        if (j + 1 < ntiles) ATT_WRITE(buf ^ 1);
        __syncthreads();
    }
#undef ATT_LOAD
#undef ATT_WRITE
    const float l = l_run + __shfl_xor(l_run, 32), inv = 1.0f / l;
    float q = 0.f;
    bf16_t* orow = oatt + (tok0 + q0 + r32) * (NH * DV) + h * DV + 4 * hi;
#pragma unroll
    for (int d = 0; d < 4; ++d)
#pragma unroll
        for (int g = 0; g < 4; ++g) { const float a0 = o[d][4 * g] * inv, a1 = o[d][4 * g + 1] * inv, a2 = o[d][4 * g + 2] * inv, a3 = o[d][4 * g + 3] * inv;
            q += (a0 * a0 + a1 * a1) + (a2 * a2 + a3 * a3);
            u32x2 w; w.x = cvt_pk_bf16(a0, a1); w.y = cvt_pk_bf16(a2, a3); *(u32x2*)(orow + d * 32 + g * 8) = w; }
    q += __shfl_xor(q, 32);
    if (hi == 0) fx_add(ssq_att + tok0 + q0 + r32, q);
}

#define ssq_x ((float*)(ws + CTL_SSQ_X))
#define ssq_q ((fx64*)(ws + CTL_SSQ_Q))
#define ssq_kv ((fx64*)(ws + CTL_SSQ_KV))
#define ssq_att ((fx64*)(ws + CTL_SSQ_ATT))
#define ssq_1 ((fx64*)(ws + CTL_SSQ_1))
#define ssq_mem ((float*)(ws + CTL_SSQ_MEM))
#define cnt ((int*)(ws + CTL_CNT))
#define tab ((f32x2*)(ws + WS_TAB))
#define Wrt ((bf16_t*)(ws + WS_WRT))
#define ssq_2 ((fx64*)(ws + CTL_SSQ_2))
#define x2l ((bf16_t*)(ws + A_X2L))
#define x1l ((bf16_t*)(ws + A_X2L))
#define rslab ((float*)(ws + A_SLAB))
#define tok_eid ((int*)(ws + TOK_EID))
#define tok_gw ((float*)(ws + TOK_GW))
#define tok_rank ((int*)(ws + TOK_RANK))
#define tok_dest ((int*)(ws + TOK_DEST))
#define tok_rstd ((float*)(ws + TOK_RSTD))
#define row_tok ((int*)(ws + ROW_TOK))
#define row_rs ((float*)(ws + ROW_RS))
#define row_w ((float*)(ws + ROW_W))
#define Win_t ((bf16_t*)(ws + WS_WIN))
#define Wq_t ((bf16_t*)(ws + WS_WQ))
#define Wkv_t ((bf16_t*)(ws + WS_WKV))
#define Wout_t ((bf16_t*)(ws + WS_WOUT))
#define Wxq_n ((bf16_t*)(ws + WS_WXQ))
#define Wxk_t ((bf16_t*)(ws + WS_WXK))
#define Wxv_t ((bf16_t*)(ws + WS_WXV))
#define Wxo_t ((bf16_t*)(ws + WS_WXO))
#define Wgu_t ((bf16_t*)(ws + WS_WGU))
#define Wd_t ((bf16_t*)(ws + WS_WD))
#define zb ((bf16_t*)(ws + A_ZB))
#define x1b ((bf16_t*)(ws + A_X1B))
#define qx ((bf16_t*)(ws + A_QX))
#define x2b ((bf16_t*)(ws + A_X2B))
#define actb ((bf16_t*)(ws + A_ACT))
#define xb ((bf16_t*)(ws + A_XB))
#define qb ((bf16_t*)(ws + A_QB))
#define ycat ((bf16_t*)(ws + A_YCAT))
#define pbuf ((bf16_t*)(ws + A_PBUF))
#define kb ((bf16_t*)(ws + A_KB))
#define ox ((bf16_t*)(ws + A_OX))
#define vT ((bf16_t*)(ws + A_VT))
#define oatt ((bf16_t*)(ws + A_OATT))
#define memb ((bf16_t*)(ws + A_MEMB))
#define kx ((bf16_t*)(ws + A_KX))
#define vx ((bf16_t*)(ws + A_VXT))
#define Mt ((bf16_t*)(ws + A_MT))
#define VWt ((bf16_t*)(ws + A_VWT))
#define krope ((bf16_t*)(ws + A_KROPE))
#define ybuf ((bf16_t*)(ws + A_YBUF))
#define x2f8 ((unsigned char*)(ws + ARENA + 90 * MiB))
#define x1f8 x2f8
#define Mt8 ((unsigned char*)(ws + A_MT))
#define VWt8 ((unsigned char*)(ws + A_VWT))
#define P8b ((unsigned char*)(ws + A_PBUF))
#define act8 ((unsigned char*)(ws + A_ACT))
#define Wgu8 ((unsigned char*)(ws + WS_WGU))
#define Wd8 ((unsigned char*)(ws + WS_WD))
typedef const __attribute__((address_space(4))) Args* KArgs;
#define PHASE_ARGS() KArgs ka = (KArgs)__builtin_amdgcn_kernarg_segment_ptr(); asm volatile("" : "+s"(ka)); unsigned char* ws = ka->ws
#define PHASE_IDS() int lane_ = lane_id(); asm volatile("" : "+v"(lane_)); const int lane = lane_, wave = wave_id, tid = wave * 64 + lane; \
    const int gw = vcu * NWAVES + wave, NGW = G * NWAVES, gt = vcu * (NWAVES * 64) + tid, NGT = G * NWAVES * 64; (void)lane; (void)gw; (void)NGW; (void)gt; (void)NGT
__global__ void __launch_bounds__(NWAVES * 64, 2) hymba_fwd(Args a_unused) {
    extern __shared__ __attribute__((aligned(16))) unsigned char lds_raw[];
    LAS unsigned char* lds = (LAS unsigned char*)lds_raw;
    volatile LAS unsigned* MISC = (volatile LAS unsigned*)(lds + MISC_OFF);
    const int wave_id = __builtin_amdgcn_readfirstlane(threadIdx.x >> 6);
    const int G = gridDim.x, bx = blockIdx.x;
    const int vcu = (G % 8 == 0) ? (bx % 8) * (G / 8) + bx / 8 : bx;
    unsigned mask; XcdBarrier bar;
    { PHASE_ARGS(); mask = ka->mask; bar.bar = (unsigned*)(ws + WS_CTL); bar.x = 0; bar.st = nullptr; bar.wave = 0; }
    for (int u = wave_id * 64 + lane_id(); u < (LDS_BYTES - TAB_OFF) / 4; u += NWAVES * 64) ((LAS unsigned*)(lds + TAB_OFF))[u] = 0u;
    __syncthreads();
    const bool one_launch = (mask & (mask - 1u)) != 0u;
    if (one_launch) bar = xcd_barrier_post(bar.bar, MISC, wave_id);
#ifndef CT_MASK
#define CT_MASK 0xffffu
#endif
#define IN(k) ((((CT_MASK) >> (k)) & 1u) != 0u && ((mask >> (k)) & 1u) != 0u)
#define SEL(real, dummy) ((ka->flags & 2u) ? (dummy) : (real))
#define DUMMYF ((float*)(ws + WS_DUMMY))
#define SEAM(k) do { if (IN(k) && (mask >> ((k) + 1)) != 0u) xcd_barrier(bar); } while (0)

    if (IN(0)) {
        PHASE_ARGS();
        PHASE_IDS();
        LAS float* scr = (LAS float*)(lds + wave * 16384);
        constexpr int I_IN = 32 * (IN_COLS / 32), I_Q = 8 * 48, I_KV = 4 * 64, I_SQ = 32 * 64;
        constexpr int NITEMS = I_IN + I_Q + I_KV + I_SQ;
        for (int it = gw; it < NITEMS; it += NGW) {
            int r = it;
            if (r < I_IN) { const int nb = r % (IN_COLS / 32), kb_ = r / (IN_COLS / 32); transpose_item<1, true>(ka->w_in, IN_COLS, ka->g_mix, ka->g_mix, DM, Win_t, DM, scr, kb_ * 64, nb * 32, lane); continue; } r -= I_IN;
            if (r < I_Q) { const int nb = r % 48, kb_ = r / 48; transpose_item<2, true>(ka->w_q_up, NH * DQK, ka->g_q_a, ka->g_q_a, QL, Wq_t, QL, scr, kb_ * 64, nb * 32, lane); continue; } r -= I_Q;
            if (r < I_KV) { const int nb = r % 64, kb_ = r / 64; transpose_item<3, true>(ka->w_kv_up, NH * (DN + DV), ka->g_kv_a, ka->g_kv_a, KVL, Wkv_t, KVL, scr, kb_ * 64, nb * 32, lane); continue; } r -= I_KV;
            { const int nb = r % 64, kb_ = r / 64; transpose_item<0, true>(ka->w_out, DM, ka->g_conv_out, ka->g_attn_out, CW, Wout_t, DM, scr, kb_ * 64, nb * 32, lane); }
        }
        for (int m = gw; m < NTOK; m += NGW) row_to_bf16(ka->x + (size_t)m * DM, xb + (size_t)m * DM, ssq_x + m, lane);
        for (int m = gw; m < NMEM; m += NGW) row_to_f8(ka->mem + (size_t)m * DM, (unsigned char*)memb + (size_t)m * DM, ssq_mem + m, lane);
        for (int i = gt; i < NTOK * 32; i += NGT) { const int tok = i >> 5, p = i & 31;
            const float inv_freq = 1.0f / powf(10000.0f, (float)(2 * p) / 64.0f), ang = (float)ka->pos[tok] * inv_freq;
            tab[i] = (f32x2){cosf(ang), sinf(ang)}; }
        for (int i = gt; i < DM * DM / 8; i += NGT) { const int cr = i / (DM / 8); const float g = ka->g_xattn[cr]; const f32x4 p0 = NTL((const f32x4*)ka->w_xq + 2 * i) * g, p1 = NTL((const f32x4*)ka->w_xq + 2 * i + 1) * g;
            const f32x4 q0 = p0 * F8_SX, q1 = p1 * F8_SX; u32x2 w; w.x = pk4_fp8(q0[0], q0[1], q0[2], q0[3]); w.y = pk4_fp8(q1[0], q1[1], q1[2], q1[3]); ((u32x2*)Wxq_n)[i] = w; }
        for (int i = gt; i < 256 * DM; i += NGT) { const int n = i / DM, k = i % DM; unsigned a0 = 0u, a1 = 0u;
            const int c = (n < NRT) ? n : ((n >= 128 && n < 128 + NRT) ? n - 128 : -1);
            if (c >= 0) { const float w = ka->g_moe[k] * (c < NG ? ka->w_group[(size_t)k * NG + c] : ka->w_router[(size_t)k * NE + (c - NG)]);
                const unsigned hb = cvt_pk_bf16(w, 0.f) & 0xffffu;
                if (n < 128) { a0 = hb; a1 = hb; } else { a0 = cvt_pk_bf16(w - bf_lo(hb), 0.f) & 0xffffu; } }
            Wrt[(size_t)n * (2 * DM) + k] = (bf16_t)a0; Wrt[(size_t)n * (2 * DM) + DM + k] = (bf16_t)a1; }
        for (int i = gt; i < (ZC - IN_COLS) * DM / 8; i += NGT) ((u32x4*)(Win_t + (size_t)IN_COLS * DM))[i] = (u32x4){0u, 0u, 0u, 0u};
    }
    SEAM(0);

    if (IN(1)) {
        PHASE_ARGS();
        PHASE_IDS();
        auto xp_all = [&]() {
            constexpr int NX = 2048 + 1024 + 192;
            auto xitem = [&](int it) -> XItem { XItem x;
                if (it < 2048) { const int e = it >> 5, up = (it >> 4) & 1, kb_ = it & 15;
                    x.W = (up ? ka->w_up : ka->w_gate) + (size_t)e * DM * DE; x.gain = ka->g_moe; x.WT = Wgu8 + (size_t)e * 1024 * DM; x.ldw = DE; x.ldo = DM; x.k0 = kb_ * 128; x.n0 = 0; x.gu = 1; x.upoff = up * 128; x.scale = F8_SW; }
                else if (it < 3072) { const int r = it - 2048, e = r >> 4, kb_ = (r >> 2) & 3, nb = r & 3;
                    x.W = ka->w_down + (size_t)e * DE * DM; x.gain = nullptr; x.WT = Wd8 + (size_t)e * DM * DE; x.ldw = DM; x.ldo = DE; x.k0 = kb_ * 128; x.n0 = nb * 512; x.gu = 0; x.upoff = 0; x.scale = F8_SD; }
                else { const int r = it - 3072, which = r >> 6, kb_ = (r >> 2) & 15, nb = r & 3;
                    x.W = which == 0 ? ka->w_xk : (which == 1 ? ka->w_xv : ka->w_xo); x.gain = which < 2 ? ka->g_mem : nullptr;
                    x.WT = which == 0 ? (unsigned char*)Wxk_t : (which == 1 ? (unsigned char*)Wxv_t : (unsigned char*)Wxo_t); x.ldw = DM; x.ldo = DM; x.k0 = kb_ * 128; x.n0 = nb * 512; x.gu = 0; x.upoff = 0; x.scale = F8_SX; }
                return x; };
            f32x4 v[8][4], gq[8];
            int it = vcu, b = 0;
            XItem cur = xitem(it < NX ? it : 0);
            if (it < NX) xp_load(v, gq, cur, wave, lane);
            while (it < NX) {
                LAS unsigned char* buf = lds + b * XP_BUF;
                xp_pack(v, gq, cur, buf, wave, lane);
                const int nit = it + G;
                XItem nxt = xitem(nit < NX ? nit : 0);
                if (nit < NX) xp_load(v, gq, nxt, wave, lane);
                __syncthreads();
                xp_store(cur, buf, wave, lane);
                cur = nxt; it = nit; b ^= 1;
            }
            __syncthreads();
        };
        const int slot = (bx >> 3) % 3;
        if (slot == 0) xp_all();
        {
            pg8::DenseSched S; S.init(xb, Win_t, DM, DM, NTOK, ZC, G, bx, 0, (NTOK / 256) * (ZC / 256) / 2);
            EpiZ E{zb, krope, ssq_x, SEL(ssq_q, (fx64*)DUMMYF), SEL(ssq_kv, (fx64*)DUMMYF + NTOK), tab};
            pg8::gemm_phase<EpiZ, pg8::DenseSched, false>(lds, wave_id, DM, DM, DM, S, E);
        }
        if (slot == 1) { __syncthreads(); xp_all(); }
        {
            pg8::DenseSched S; S.init(xb, Win_t, DM, DM, NTOK, ZC, G, bx, (NTOK / 256) * (ZC / 256) / 2, (NTOK / 256) * (ZC / 256) / 2);
            EpiZ E{zb, krope, ssq_x, SEL(ssq_q, (fx64*)DUMMYF), SEL(ssq_kv, (fx64*)DUMMYF + NTOK), tab};
            pg8::gemm_phase<EpiZ, pg8::DenseSched, false>(lds, wave_id, DM, DM, DM, S, E);
        }
        if (slot == 2) { __syncthreads(); xp_all(); }
    }
    SEAM(1);

    if (IN(2)) {
        PHASE_ARGS();
        const bool deal = (G == 256);
        const int grp = deal ? (bx >> 6) : -1, c6 = deal ? (bx & 63) : bx, g6 = deal ? 64 : G, gL = g6, cL = c6;
        if (!deal || grp == 0) { pg8::DenseSched S; S.init(memb, Wxk_t, DM, DM, NMEM, DM, gL, cL); S.es = 1; EpiF8Rms E{(unsigned char*)kx, DM, ssq_mem, 1.0f / DM, 1.0f / F8_SX};
          pg8::gemm_phase<EpiF8Rms, pg8::DenseSched, false, 1>(lds, wave_id, DM, DM, DM, S, E); }
        if (!deal || grp == 1) { pg8::DenseSched S; S.init(memb, Wxv_t, DM, DM, NMEM, DM, gL, cL); S.es = 1; EpiF8Rms E{(unsigned char*)vx, DM, ssq_mem, 1.0f / DM, 1.0f / F8_SX};
          pg8::gemm_phase<EpiF8Rms, pg8::DenseSched, false, 1>(lds, wave_id, DM, DM, DM, S, E); }
        { pg8::DenseSched S; S.init(zb + C_Q, Wq_t, ZC, QL, NTOK, NH * DQK, deal ? 128 : G, deal ? (bx & 127) : bx, 0, deal ? (grp >= 2 ? 384 : 0) : -1); EpiQ E{qb, ssq_q, tab};
          pg8::gemm_phase<EpiQ, pg8::DenseSched, false>(lds, wave_id, QL, ZC, QL, S, E); }
        { const int f = grp == 1 ? 128 : (grp == 2 ? 192 : 0), n = grp == 0 ? 128 : ((grp == 1 || grp == 2) ? 64 : 0);
          pg8::DenseSched S; S.init(zb + C_KV, Wkv_t, ZC, KVL, NTOK, NH * DN, g6, c6, deal ? f : 0, deal ? n : -1); EpiBf16<3> E{kb, NH * DN, (const float*)ssq_kv, 1.0f / KVL, 1.0f};
          pg8::gemm_phase<EpiBf16<3>, pg8::DenseSched, false>(lds, wave_id, KVL, ZC, KVL, S, E); }
        { const int f = grp == 1 ? 64 : (grp == 3 ? 192 : 0), n = grp == 0 ? 64 : (grp == 1 ? 128 : (grp == 3 ? 64 : 0));
          pg8::DenseSched S; S.init(Wkv_t + (size_t)NH * DN * KVL, zb + C_KV, KVL, ZC, NH * DV, NTOK, g6, c6, deal ? f : 0, deal ? n : -1); EpiColScale<true> E{vT, NTOK, ssq_kv, 1.0f / KVL};
          pg8::gemm_phase<EpiColScale<true>, pg8::DenseSched, false>(lds, wave_id, KVL, KVL, ZC, S, E); }
    }
    SEAM(2);

    if (IN(3)) {
        PHASE_ARGS();
        for (int pp = vcu; pp < NB * NH * 4; pp += G) { const int b = pp >> 5, h = (pp >> 2) & 7, ip = pp & 3;
            mla_attn_unit(lds, wave_id, qb, kb, krope, vT, oatt, SEL(ssq_att, (fx64*)DUMMYF), b, h, 7 - ip);
            mla_attn_unit(lds, wave_id, qb, kb, krope, vT, oatt, SEL(ssq_att, (fx64*)DUMMYF), b, h, ip); }
    }
    SEAM(3);

    if (IN(4)) {
        PHASE_ARGS();
        PHASE_IDS();
        float wc0[2][8], wc1[2][8], wc2[2][8];
#pragma unroll
        for (int g = 0; g < 2; ++g)
#pragma unroll
            for (int e = 0; e < 8; ++e) { const int c = g * 512 + lane * 8 + e; wc0[g][e] = ka->w_conv[c]; wc1[g][e] = ka->w_conv[CW + c]; wc2[g][e] = ka->w_conv[2 * CW + c]; }
        for (int ch = gw; ch < NTOK / 8; ch += NGW) {
            const int t0 = ch * 8, tl = t0 & (T - 1);
            float u1[2][8], u2[2][8];
#pragma unroll
            for (int g = 0; g < 2; ++g) { const int c = g * 512 + lane * 8;
                if (tl >= 1) { const u32x4 cg = *(const u32x4*)(zb + (size_t)(t0 - 1) * ZC + CW + c), hg = *(const u32x4*)(zb + (size_t)(t0 - 1) * ZC + 2 * CW + c);
#pragma unroll
                    for (int e = 0; e < 4; ++e) { u1[g][2 * e] = bf_lo(cg[e]) * bf_lo(hg[e]); u1[g][2 * e + 1] = bf_hi(cg[e]) * bf_hi(hg[e]); } }
                else {
#pragma unroll
                    for (int e = 0; e < 8; ++e) u1[g][e] = 0.f; }
                if (tl >= 2) { const u32x4 cg = *(const u32x4*)(zb + (size_t)(t0 - 2) * ZC + CW + c), hg = *(const u32x4*)(zb + (size_t)(t0 - 2) * ZC + 2 * CW + c);
#pragma unroll
                    for (int e = 0; e < 4; ++e) { u2[g][2 * e] = bf_lo(cg[e]) * bf_lo(hg[e]); u2[g][2 * e + 1] = bf_hi(cg[e]) * bf_hi(hg[e]); } }
                else {
#pragma unroll
                    for (int e = 0; e < 8; ++e) u2[g][e] = 0.f; } }
            for (int rp = 0; rp < 8; rp += 2) {
                u32x4 bg[2][2], cg[2][2], hg[2][2];
#pragma unroll
                for (int rr = 0; rr < 2; ++rr)
#pragma unroll
                    for (int g = 0; g < 2; ++g) { const size_t row = (size_t)(t0 + rp + rr); const int c = g * 512 + lane * 8;
                        bg[rr][g] = NTL((const u32x4*)(zb + row * ZC + c)); cg[rr][g] = NTL((const u32x4*)(zb + row * ZC + CW + c)); hg[rr][g] = NTL((const u32x4*)(zb + row * ZC + 2 * CW + c)); }
#pragma unroll
                for (int rr = 0; rr < 2; ++rr) { const size_t row = (size_t)(t0 + rp + rr);
                    float y[2][8]; float q = 0.f;
#pragma unroll
                    for (int g = 0; g < 2; ++g) {
#pragma unroll
                        for (int e = 0; e < 8; ++e) { const float bb = (e & 1) ? bf_hi(bg[rr][g][e >> 1]) : bf_lo(bg[rr][g][e >> 1]), cc = (e & 1) ? bf_hi(cg[rr][g][e >> 1]) : bf_lo(cg[rr][g][e >> 1]), hh = (e & 1) ? bf_hi(hg[rr][g][e >> 1]) : bf_lo(hg[rr][g][e >> 1]);
                            const float u0 = cc * hh, cv = wc0[g][e] * u2[g][e] + wc1[g][e] * u1[g][e] + wc2[g][e] * u0;
                            y[g][e] = bb * cv; q += y[g][e] * y[g][e]; u2[g][e] = u1[g][e]; u1[g][e] = u0; } }
                    q = wave_sum(q);
                    const float rs = 1.0f / sqrtf(q * (1.0f / CW) + EPS);
#pragma unroll
                    for (int g = 0; g < 2; ++g) { const int c = g * 512 + lane * 8;
                        u32x4 w; w.x = cvt_pk_bf16(y[g][0] * rs, y[g][1] * rs); w.y = cvt_pk_bf16(y[g][2] * rs, y[g][3] * rs); w.z = cvt_pk_bf16(y[g][4] * rs, y[g][5] * rs); w.w = cvt_pk_bf16(y[g][6] * rs, y[g][7] * rs);
                        *(u32x4*)(ycat + row * DM + c) = w; } }
            }
        }
        for (int ch = gw; ch < NTOK / 4; ch += NGW) {
            u32x4 og[4][2]; float ra[4];
#pragma unroll
            for (int rr = 0; rr < 4; ++rr) { const size_t row = (size_t)ch * 4 + rr;
#pragma unroll
                for (int g = 0; g < 2; ++g) og[rr][g] = NTL((const u32x4*)(oatt + row * (NH * DV) + g * 512 + lane * 8));
                ra[rr] = 1.0f / sqrtf(fx_get(ssq_att + row) * (1.0f / (NH * DV)) + EPS); }
#pragma unroll
            for (int rr = 0; rr < 4; ++rr) { const size_t row = (size_t)ch * 4 + rr;
#pragma unroll
                for (int g = 0; g < 2; ++g) { u32x4 w2;
#pragma unroll
                    for (int e = 0; e < 4; ++e) w2[e] = cvt_pk_bf16(bf_lo(og[rr][g][e]) * ra[rr], bf_hi(og[rr][g][e]) * ra[rr]);
                    *(u32x4*)(ycat + row * DM + CW + g * 512 + lane * 8) = w2; } }
        }
    }
    SEAM(4);

    if (IN(5)) {
        PHASE_ARGS();
        const bool late = ((bx >> 3) & 1) != 0;
        if (late) {
    #if XATT_FP8
            { MtSched S{(const char*)kx, (const char*)Wxq_n, G, vcu, 1}; EpiF8 E{Mt8, DM, F8_SM * LOG2E * 0.04419417382415922f / F8_SX};
              pg8::gemm_phase<EpiF8, MtSched, false, 1>(lds, wave_id, XD, DM, DM, S, E); }
            { VWtSched S{(const char*)Wxo_t, (const char*)vx, G, vcu, 1}; EpiF8 E{VWt8, XH * MEM, F8_SV / F8_SX};
              pg8::gemm_phase<EpiF8, VWtSched, false, 1>(lds, wave_id, XD, DM, DM, S, E); }
    #else
            { MtSched S{(const char*)kx, (const char*)Wxq_n, G, vcu, 2}; EpiBf16<0> E{Mt, DM, nullptr, 0.f, LOG2E * 0.04419417382415922f};
              pg8::gemm_phase<EpiBf16<0>, MtSched, false>(lds, wave_id, XD, DM, DM, S, E); }
            { VWtSched S{(const char*)Wxo_t, (const char*)vx, G, vcu, 2}; EpiBf16<0> E{VWt, XH * MEM, nullptr, 0.f, 1.0f};
              pg8::gemm_phase<EpiBf16<0>, VWtSched, false>(lds, wave_id, XD, DM, DM, S, E); }
    #endif
        }
        {
            pg8::DenseSched S; S.init(ycat, Wout_t, DM, DM, NTOK, DM, G, bx);
            EpiResidHL<true> E{ka->x, nullptr, nullptr, x1b, x1l, SEL(ssq_1, (fx64*)DUMMYF), XATT_FP8 ? x1f8 : nullptr, 1.0f};
            pg8::gemm_phase<EpiResidHL<true>, pg8::DenseSched, false>(lds, wave_id, DM, DM, DM, S, E);
        }
        if (!late) {
    #if XATT_FP8
            { MtSched S{(const char*)kx, (const char*)Wxq_n, G, vcu, 1}; EpiF8 E{Mt8, DM, F8_SM * LOG2E * 0.04419417382415922f / F8_SX};
              pg8::gemm_phase<EpiF8, MtSched, false, 1>(lds, wave_id, XD, DM, DM, S, E); }
            { VWtSched S{(const char*)Wxo_t, (const char*)vx, G, vcu, 1}; EpiF8 E{VWt8, XH * MEM, F8_SV / F8_SX};
              pg8::gemm_phase<EpiF8, VWtSched, false, 1>(lds, wave_id, XD, DM, DM, S, E); }
    #else
            { MtSched S{(const char*)kx, (const char*)Wxq_n, G, vcu, 2}; EpiBf16<0> E{Mt, DM, nullptr, 0.f, LOG2E * 0.04419417382415922f};
              pg8::gemm_phase<EpiBf16<0>, MtSched, false>(lds, wave_id, XD, DM, DM, S, E); }
            { VWtSched S{(const char*)Wxo_t, (const char*)vx, G, vcu, 2}; EpiBf16<0> E{VWt, XH * MEM, nullptr, 0.f, 1.0f};
              pg8::gemm_phase<EpiBf16<0>, VWtSched, false>(lds, wave_id, XD, DM, DM, S, E); }
    #endif
        }
    }
    SEAM(5);

    if (IN(7)) {
        PHASE_ARGS();
#if XATT_FP8
        CrossSSched S{(const char*)x1f8, (const char*)Mt8, G, vcu, 1};
        EpiSoftmax E{pbuf, XH * MEM, (LAS float*)(lds + EPI_OFF), (LAS float*)(lds + EPI_OFF + 4096), ssq_1, 1.0f / DM, 1.0f / F8_SM, P8b};
        pg8::gemm_phase<EpiSoftmax, CrossSSched, false, 1>(lds, wave_id, DM, DM, DM, S, E);
#else
        CrossSSched S{(const char*)x1b, (const char*)Mt, G, vcu, 2};
        EpiSoftmax E{pbuf, XH * MEM, (LAS float*)(lds + EPI_OFF), (LAS float*)(lds + EPI_OFF + 4096), ssq_1, 1.0f / DM, 1.0f, nullptr};
        pg8::gemm_phase<EpiSoftmax, CrossSSched, false>(lds, wave_id, DM, DM, DM, S, E);
#endif
    }
    SEAM(7);

    if (IN(9)) {
        PHASE_ARGS();
        { PHASE_IDS(); for (int i = gt; i < DM / 8; i += NGT) ((u32x4*)(x2b + (size_t)NTOK * DM))[i] = (u32x4){0u, 0u, 0u, 0u};
          if (MOE_FP8) for (int i = gt; i < DM / 16; i += NGT) ((u32x4*)(x2f8 + (size_t)NTOK * DM))[i] = (u32x4){0u, 0u, 0u, 0u}; }
#if XATT_FP8
        CrossOSched S{(const char*)P8b, (const char*)VWt8, G, vcu, 1};
        EpiResidHL<false> E{nullptr, x1b, x1l, SEL(x2b, (bf16_t*)DUMMYF), SEL(x2l, (bf16_t*)DUMMYF + (size_t)NTOK * DM), SEL(ssq_2, (fx64*)DUMMYF), MOE_FP8 ? x2f8 : nullptr, 1.0f / (F8_SP * F8_SV)};
        pg8::gemm_phase<EpiResidHL<false>, CrossOSched, false, 1>(lds, wave_id, XH * MEM, XH * MEM, XH * MEM, S, E);
#else
        CrossOSched S{(const char*)pbuf, (const char*)VWt, G, vcu, 2};
        EpiResidHL<false> E{nullptr, x1b, x1l, SEL(x2b, (bf16_t*)DUMMYF), SEL(x2l, (bf16_t*)DUMMYF + (size_t)NTOK * DM), SEL(ssq_2, (fx64*)DUMMYF), MOE_FP8 ? x2f8 : nullptr, 1.0f};
        pg8::gemm_phase<EpiResidHL<false>, CrossOSched, false>(lds, wave_id, XH * MEM, XH * MEM, XH * MEM, S, E);
#endif
    }
    SEAM(9);

    if (IN(10)) {
        PHASE_ARGS();
        RouterSched S{(const char*)x2b, (const char*)x2l, (const char*)Wrt, G, bx};
        EpiRouter E{rslab};
        pg8::gemm_phase<EpiRouter, RouterSched, false>(lds, wave_id, 1024, DM, 2 * DM, S, E);
    }
    SEAM(10);

    if (IN(11)) {
        PHASE_ARGS();
        PHASE_IDS();
        for (int i = gt; i < LROWS; i += NGT) { row_tok[i] = NTOK; row_rs[i] = 0.f; row_w[i] = 0.f; }
        for (int tok = gt; tok < NTOK; tok += NGT) {
            const float rstd = 1.0f / sqrtf(fx_get(ssq_2 + tok) * (1.0f / DM) + EPS);
            f32x4 g0 = (f32x4){0.f, 0.f, 0.f, 0.f}, g1 = g0;
#pragma unroll
            for (int kq = 0; kq < 4; ++kq) { const float* p = rslab + ((size_t)kq * NTOK + tok) * 96; g0 += *(const f32x4*)p; g1 += *(const f32x4*)(p + 4); }
            float gl[8] = {g0[0], g0[1], g0[2], g0[3], g1[0], g1[1], g1[2], g1[3]};
#pragma unroll
            for (int j = 0; j < 8; ++j) gl[j] = gl[j] * rstd + ka->b_group[j];
            int gi = 0; float gm = gl[0];
#pragma unroll
            for (int j = 1; j < 8; ++j) if (gl[j] > gm) { gm = gl[j]; gi = j; }
            float gs = 0.f;
#pragma unroll
            for (int j = 0; j < 8; ++j) gs += __expf(gl[j] - gm);
            const float gp = 1.0f / gs;
            f32x4 e0 = (f32x4){0.f, 0.f, 0.f, 0.f}, e1v = e0;
#pragma unroll
            for (int kq = 0; kq < 4; ++kq) { const float* p = rslab + ((size_t)kq * NTOK + tok) * 96 + NG + gi * 8; e0 += *(const f32x4*)p; e1v += *(const f32x4*)(p + 4); }
            const f32x4 b0 = *(const f32x4*)(ka->b_router + gi * 8), b1 = *(const f32x4*)(ka->b_router + gi * 8 + 4);
            float el[8] = {e0[0], e0[1], e0[2], e0[3], e1v[0], e1v[1], e1v[2], e1v[3]};
            const float bl[8] = {b0[0], b0[1], b0[2], b0[3], b1[0], b1[1], b1[2], b1[3]};
#pragma unroll
            for (int j = 0; j < 8; ++j) el[j] = el[j] * rstd + bl[j];
            int i1 = 0; float e1 = el[0];
#pragma unroll
            for (int j = 1; j < 8; ++j) if (el[j] > e1) { e1 = el[j]; i1 = j; }
            int i2 = 0; float e2 = -3.0e38f;
#pragma unroll
            for (int j = 0; j < 8; ++j) if (j != i1 && el[j] > e2) { e2 = el[j]; i2 = j; }
            const float t1 = 1.0f / (1.0f + __expf(e2 - e1)), t2 = 1.0f - t1;
            if (!(ka->flags & 2u)) { const int E1 = gi * 8 + i1, E2 = gi * 8 + i2;
                const int k1 = atomicAdd(cnt + E1, 1), k2 = atomicAdd(cnt + E2, 1);
                tok_eid[2 * tok] = E1; tok_eid[2 * tok + 1] = E2; tok_gw[2 * tok] = gp * t1; tok_gw[2 * tok + 1] = gp * t2; tok_rank[2 * tok] = k1; tok_rank[2 * tok + 1] = k2; tok_rstd[tok] = rstd; }
        }
    }
    SEAM(11);

    LAS int* t_start = (LAS int*)(lds + TAB_OFF); LAS int* t_blk = t_start + 64;
    if (IN(12) || IN(13) || IN(14)) {
        PHASE_ARGS();
        if (wave_id == 0 && lane_id() == 0) { int s = 0; for (int e = 0; e < NE; ++e) { const int c = __hip_atomic_load(cnt + e, __ATOMIC_RELAXED, __HIP_MEMORY_SCOPE_AGENT), nb = (c + 255) >> 8; t_start[e] = s * 256; for (int k = 0; k < nb; ++k) t_blk[s + k] = e; s += nb; }
            MISC[8] = (unsigned)s; }
        __syncthreads();
    }
    const int nblk = (int)MISC[8];

    if (IN(12)) {
        PHASE_ARGS();
        PHASE_IDS();
        for (int s = gt; s < NTOK * 2; s += NGT) { const int tok = s >> 1, e = tok_eid[s], d = t_start[e] + tok_rank[s];
            row_tok[d] = tok; row_rs[d] = tok_rstd[tok]; row_w[d] = tok_gw[s]; tok_dest[s] = d; }
    }
    SEAM(12);

    if (IN(13)) {
        PHASE_ARGS();
#if MOE_FP8
        MoeSched S{(const char*)x2f8, (const char*)Wgu8, row_tok, t_blk, nblk * 4, 2, G, vcu, 0, (size_t)1024 * DM, (size_t)256 * DM, 128, (unsigned)DM};
        EpiGateUp8 E{act8, row_rs};
        pg8::gemm_phase<EpiGateUp8, MoeSched, true, 1>(lds, wave_id, DM, DM, DM, S, E);
#else
        MoeSched S{(const char*)x2b, (const char*)Wgu_t, row_tok, t_blk, nblk * 4, 2, G, vcu, 0, (size_t)1024 * DM * 2, (size_t)256 * DM * 2, 128, (unsigned)(DM * 2)};
        EpiGateUp E{actb, row_rs};
        pg8::gemm_phase<EpiGateUp, MoeSched, true>(lds, wave_id, DM, DM, DM, S, E);
#endif
    }
    SEAM(13);

    if (IN(14)) {
        PHASE_ARGS();
#if MOE_FP8
        MoeSched S{(const char*)act8, (const char*)Wd8, row_tok, t_blk, nblk * 8, 3, G, vcu, (size_t)256 * DE, (size_t)DM * DE, (size_t)256 * DE, 256, 0u};
        EpiF8Row E{(unsigned char*)ybuf, DM, row_w, F8_SY / (F8_SACT * F8_SD)};
        pg8::gemm_phase<EpiF8Row, MoeSched, false, 1>(lds, wave_id, DE, DE, DE, S, E);
#else
        MoeSched S{(const char*)actb, (const char*)Wd_t, row_tok, t_blk, nblk * 8, 3, G, vcu, (size_t)256 * DE * 2, (size_t)DM * DE * 2, (size_t)256 * DE * 2, 256, 0u};
        EpiBf16<2> E{ybuf, DM, row_w, 0.f, 1.0f};
        pg8::gemm_phase<EpiBf16<2>, MoeSched, false>(lds, wave_id, DE, DE, DE, S, E);
#endif
    }
    SEAM(14);

    if (IN(15)) {
        PHASE_ARGS();
        PHASE_IDS();
        for (int m = gw; m < NTOK; m += NGW) {
            f32x4* xr = (f32x4*)(ka->out + (size_t)m * DM) + lane; f32x4 v[8]; float s = 0.f;
            const u32x2* xh_ = (const u32x2*)(x2b + (size_t)m * DM) + lane; const u32x2* xl_ = (const u32x2*)(x2l + (size_t)m * DM) + lane;
            const bool moe = (ka->flags & 1u) != 0u;
            const int d0 = moe ? tok_dest[2 * m] : 0, d1 = moe ? tok_dest[2 * m + 1] : 0;
#if MOE_FP8
            const unsigned* y0 = (const unsigned*)((const unsigned char*)ybuf + (size_t)d0 * DM) + lane; const unsigned* y1 = (const unsigned*)((const unsigned char*)ybuf + (size_t)d1 * DM) + lane;
#else
            const u32x2* y0 = (const u32x2*)(ybuf + (size_t)d0 * DM) + lane; const u32x2* y1 = (const u32x2*)(ybuf + (size_t)d1 * DM) + lane;
#endif
#pragma unroll
            for (int j = 0; j < 8; ++j) { const u32x2 h = NTL(xh_ + 64 * j), l = NTL(xl_ + 64 * j);
                v[j] = (f32x4){bf_lo(h.x) + bf_lo(l.x), bf_hi(h.x) + bf_hi(l.x), bf_lo(h.y) + bf_lo(l.y), bf_hi(h.y) + bf_hi(l.y)};
#if MOE_FP8
                if (moe) { const int p0 = (int)NTL(y0 + 64 * j), p1 = (int)NTL(y1 + 64 * j);
                    const f32x2 a0 = __builtin_amdgcn_cvt_pk_f32_fp8(p0, false), a1 = __builtin_amdgcn_cvt_pk_f32_fp8(p0, true), b0 = __builtin_amdgcn_cvt_pk_f32_fp8(p1, false), b1 = __builtin_amdgcn_cvt_pk_f32_fp8(p1, true);
                    v[j][0] += (a0.x + b0.x) * (1.0f / F8_SY); v[j][1] += (a0.y + b0.y) * (1.0f / F8_SY); v[j][2] += (a1.x + b1.x) * (1.0f / F8_SY); v[j][3] += (a1.y + b1.y) * (1.0f / F8_SY); }
#else
                if (moe) { const u32x2 p0 = y0[64 * j], p1 = y1[64 * j];
                    v[j][0] += bf_lo(p0.x) + bf_lo(p1.x); v[j][1] += bf_hi(p0.x) + bf_hi(p1.x); v[j][2] += bf_lo(p0.y) + bf_lo(p1.y); v[j][3] += bf_hi(p0.y) + bf_hi(p1.y); }
#endif
                s += (v[j][0] * v[j][0] + v[j][1] * v[j][1]) + (v[j][2] * v[j][2] + v[j][3] * v[j][3]); }
            s = wave_sum(s); const float rs = 1.0f / sqrtf(s * (1.0f / DM) + EPS);
            const f32x4* gf = (const f32x4*)ka->g_final + lane;
#pragma unroll
            for (int j = 0; j < 8; ++j) NTS(v[j] * rs * gf[64 * j], xr + 64 * j);
        }
    }
#undef IN
#undef SEAM
}

extern "C" void kernel_launch(void* const* d_in, const int* in_sizes, int n_in, void* d_out, int out_size, void* d_ws, size_t ws_size, hipStream_t stream) {
    static int grid = 0;
    if (grid == 0) {
        if (n_in != 28 || out_size != NTOK * DM || ws_size < WS_NEED) { fprintf(stderr, "kernel_launch: unexpected shapes (n_in %d, out %d, ws %zu < %zu)\n", n_in, out_size, ws_size, (size_t)WS_NEED); grid = -1; return; }
        int dev = 0, cus = 0, per_cu = 0;
        if (hipGetDevice(&dev) != hipSuccess || hipDeviceGetAttribute(&cus, hipDeviceAttributeMultiprocessorCount, dev) != hipSuccess) { grid = -1; return; }
        if (hipFuncSetAttribute((const void*)hymba_fwd, hipFuncAttributeMaxDynamicSharedMemorySize, LDS_BYTES) != hipSuccess) { fprintf(stderr, "kernel_launch: hipFuncSetAttribute failed\n"); grid = -1; return; }
        if (hipOccupancyMaxActiveBlocksPerMultiprocessor(&per_cu, (const void*)hymba_fwd, NWAVES * 64, LDS_BYTES) != hipSuccess || per_cu < 1) { fprintf(stderr, "kernel_launch: occupancy query says %d\n", per_cu); (void)hipGetLastError(); grid = -1; return; }
        grid = cus;
    }
    if (grid < 0) return;
    (void)hipMemsetAsync((char*)d_ws + WS_CTL, 0, CTL_BYTES, stream);
    Args a{};
    a.x = (const float*)d_in[0]; a.mem = (const float*)d_in[1]; a.pos = (const int*)d_in[2]; a.g_mix = (const float*)d_in[3]; a.w_in = (const float*)d_in[4]; a.w_conv = (const float*)d_in[5];
    a.g_q_a = (const float*)d_in[6]; a.w_q_up = (const float*)d_in[7]; a.g_kv_a = (const float*)d_in[8]; a.w_kv_up = (const float*)d_in[9]; a.g_conv_out = (const float*)d_in[10]; a.g_attn_out = (const float*)d_in[11];
    a.w_out = (const float*)d_in[12]; a.g_xattn = (const float*)d_in[13]; a.g_mem = (const float*)d_in[14]; a.w_xq = (const float*)d_in[15]; a.w_xk = (const float*)d_in[16]; a.w_xv = (const float*)d_in[17]; a.w_xo = (const float*)d_in[18];
    a.g_moe = (const float*)d_in[19]; a.w_group = (const float*)d_in[20]; a.b_group = (const float*)d_in[21]; a.w_router = (const float*)d_in[22]; a.b_router = (const float*)d_in[23];
    a.w_gate = (const float*)d_in[24]; a.w_up = (const float*)d_in[25]; a.w_down = (const float*)d_in[26]; a.g_final = (const float*)d_in[27];
    a.out = (float*)d_out; a.ws = (unsigned char*)d_ws;
    a.flags = ((PH_MASK >> 14) & 1u) ? 1u : 0u;
#if N_LAUNCH_SPLIT
    for (int p = 0; p < 16; ++p) { if (!((PH_MASK >> p) & 1u)) continue; a.mask = 1u << p;
        if ((DUP_MASK >> p) & 1u) { a.flags |= 2u; for (int rep_ = 0; rep_ < DUP_COUNT; ++rep_) hipLaunchKernelGGL(hymba_fwd, dim3(grid), dim3(NWAVES * 64), LDS_BYTES, stream, a); a.flags &= ~2u; }
        hipLaunchKernelGGL(hymba_fwd, dim3(grid), dim3(NWAVES * 64), LDS_BYTES, stream, a); }
#else
    a.mask = PH_MASK;
    hipLaunchKernelGGL(hymba_fwd, dim3(grid), dim3(NWAVES * 64), LDS_BYTES, stream, a);
#endif
}
```

```cpp
#include <hip/hip_runtime.h>
#include <cstdio>
#include <cstdint>

#define LAS __attribute__((address_space(3)))
typedef unsigned short bf16_t;
typedef short bf16x8 __attribute__((ext_vector_type(8)));
typedef float f32x2 __attribute__((ext_vector_type(2)));
typedef float f32x4 __attribute__((ext_vector_type(4)));
typedef float f32x16 __attribute__((ext_vector_type(16)));
typedef unsigned u32x2 __attribute__((ext_vector_type(2)));
typedef unsigned u32x4 __attribute__((ext_vector_type(4)));

#ifndef PH_MASK
#define PH_MASK 0xfebfu
#endif
#ifndef DUP_MASK
#define DUP_MASK 0u
#endif
#ifndef DUP_COUNT
#define DUP_COUNT 1
#endif
#ifndef MOE_FP8
#define MOE_FP8 1
#endif
#ifndef XATT_FP8
#define XATT_FP8 1
#endif
#ifndef N_LAUNCH_SPLIT
#define N_LAUNCH_SPLIT 0
#endif

constexpr int NB = 8, T = 2048, DM = 2048, NTOK = NB * T;
constexpr int MEM = 256, NMEM = NB * MEM;
constexpr int CW = 1024;
constexpr int NH = 8, DN = 128, DR = 64, DV = 128, DQK = DN + DR;
constexpr int QL = 512, KVL = 256;
constexpr int ZC = 4096;
constexpr int C_Q = 3072, C_KV = 3584, C_KR = 3840, IN_COLS = 3904;
constexpr int XH = 4, XD = 512;
constexpr int NG = 8, EPG = 8, NE = 64, DE = 512, NRT = NG + NE;
constexpr int LROWS = (NTOK * 2 / 256 + NE) * 256;
constexpr float EPS = 1e-6f;
constexpr float LOG2E = 1.4426950408889634f;

constexpr size_t MiB = 1u << 20;
constexpr size_t WS_CTL = 0, CTL_BYTES = 1 * MiB;
constexpr size_t CTL_SSQ_X = 64 * 1024, CTL_SSQ_MEM = 128 * 1024, CTL_CNT = 144 * 1024;
constexpr size_t CTL_SSQ_Q = 256 * 1024, CTL_SSQ_KV = 384 * 1024, CTL_SSQ_ATT = 512 * 1024, CTL_SSQ_1 = 640 * 1024, CTL_SSQ_2 = 768 * 1024;
constexpr size_t WS_TAB = 1 * MiB;
constexpr size_t WS_WRT = 5 * MiB;
constexpr size_t WS_TOKI = 6 * MiB;
constexpr size_t TOK_EID = WS_TOKI, TOK_GW = TOK_EID + 128 * 1024, TOK_RANK = TOK_GW + 128 * 1024, TOK_DEST = TOK_RANK + 128 * 1024, TOK_RSTD = TOK_DEST + 128 * 1024;
constexpr size_t ROW_TOK = TOK_RSTD + 64 * 1024, ROW_RS = ROW_TOK + 192 * 1024, ROW_W = ROW_RS + 192 * 1024;
constexpr size_t WS_WIN = 8 * MiB, WS_WQ = 24 * MiB, WS_WKV = 26 * MiB, WS_WOUT = 28 * MiB, WS_WXQ = 36 * MiB, WS_WXK = 44 * MiB, WS_WXV = 52 * MiB, WS_WXO = 60 * MiB;
constexpr size_t WS_WGU = 68 * MiB, WS_WD = 324 * MiB, ARENA = 452 * MiB;
constexpr size_t A_ZB = ARENA, A_X1B = ARENA, A_QX = ARENA + 64 * MiB, A_X2B = ARENA, A_ACT = ARENA + 65 * MiB;
constexpr size_t A_XB = ARENA + 128 * MiB, A_QB = A_XB, A_YCAT = ARENA + 384 * MiB, A_PBUF = A_XB;
constexpr size_t A_KB = ARENA + 192 * MiB, A_OX = A_KB, A_VT = ARENA + 224 * MiB, A_OATT = ARENA + 256 * MiB;
constexpr size_t A_MEMB = ARENA + 288 * MiB, A_KX = A_MEMB + 8 * MiB, A_VXT = A_MEMB + 16 * MiB, A_KROPE = A_MEMB + 24 * MiB;
constexpr size_t A_X2L = ARENA + 192 * MiB;
constexpr size_t A_SLAB = ARENA + 256 * MiB;
constexpr size_t A_MT = ARENA + 320 * MiB, A_VWT = ARENA + 352 * MiB;
constexpr size_t A_YBUF = ARENA + 256 * MiB;
constexpr size_t WS_END = ARENA + 448 * MiB;
constexpr size_t WS_DUMMY = WS_END;
constexpr size_t WS_NEED = (DUP_MASK != 0u) ? WS_END + 128 * MiB : WS_END;

constexpr int RING_BYTES = 131072;
constexpr int EPI_OFF = RING_BYTES;
constexpr int TAB_OFF = EPI_OFF + 8192;
constexpr int MISC_OFF = TAB_OFF + 1024;
constexpr int LDS_BYTES = 147456;
static_assert(MISC_OFF + 256 <= LDS_BYTES, "LDS map");
constexpr int NWAVES = 8;

__device__ __forceinline__ int lane_id() { return (int)__builtin_amdgcn_mbcnt_hi(~0u, __builtin_amdgcn_mbcnt_lo(~0u, 0u)); }
__device__ __forceinline__ unsigned cvt_pk_bf16(float lo, float hi) { unsigned r; asm volatile("v_cvt_pk_bf16_f32 %0, %1, %2" : "=v"(r) : "v"(lo), "v"(hi)); return r; }
__device__ __forceinline__ float bf_lo(unsigned w) { return __uint_as_float(w << 16); }
__device__ __forceinline__ float bf_hi(unsigned w) { return __uint_as_float(w & 0xffff0000u); }
__device__ __forceinline__ float wave_sum(float v) {
#pragma unroll
    for (int o = 1; o < 64; o <<= 1) v += __shfl_xor(v, o);
    return v;
}
typedef unsigned long long fx64;
__device__ __forceinline__ void fx_add(fx64* p, float q) { atomicAdd(p, (fx64)(q * 4294967296.0f)); }
__device__ __forceinline__ float fx_get(const fx64* p) { return (float)(*p) * 2.3283064365386963e-10f; }
__device__ __forceinline__ unsigned pk4_fp8(float a, float b, float c, float d) { int w = __builtin_amdgcn_cvt_pk_fp8_f32(a, b, 0, false); w = __builtin_amdgcn_cvt_pk_fp8_f32(c, d, w, true); return (unsigned)w; }
constexpr float F8_SX = 64.0f, F8_SW = 64.0f, F8_SD = 32.0f, F8_SACT = 16.0f, F8_SY = 16.0f, F8_SM = 32.0f, F8_SV = 4.0f, F8_SP = 256.0f;
#define LDS_WAIT() asm volatile("s_waitcnt lgkmcnt(0)" ::: "memory")
#define NTL(p) __builtin_nontemporal_load(p)
#define NTS(v, p) __builtin_nontemporal_store(v, p)
#define VM_WAIT() asm volatile("s_waitcnt vmcnt(0)" ::: "memory")

#define XB_TMO      128
#define XB_XCNT(j)  (256  + 64 * (j))
#define XB_XSUB(j)  (1280 + 64 * (j))
#define XB_XGEN(j)  (2304 + 64 * (j))
#define XB_TOP      3328
#define XB_TOPGEN   3392
#define XCD_BAR_WORDS 3456
#define XB_SPIN_CAP (1u << 18)
__device__ __forceinline__ unsigned xb_ld(unsigned* p)              { return __hip_atomic_load(p, __ATOMIC_RELAXED, __HIP_MEMORY_SCOPE_AGENT); }
__device__ __forceinline__ unsigned xb_add(unsigned* p, unsigned v) { return __hip_atomic_fetch_add(p, v, __ATOMIC_RELAXED, __HIP_MEMORY_SCOPE_AGENT); }
__device__ __forceinline__ unsigned xb_xcc_id() { return (unsigned)__builtin_amdgcn_s_getreg((3 << 11) | 20) & 0xFu; }
#define XB_SPIN(cond, bar) do { unsigned _sp = 0; while (cond) { __builtin_amdgcn_s_sleep(1); \
    if ((++_sp & 255u) == 0u) { if (xb_ld(&(bar)[XB_TMO])) break; if (_sp > XB_SPIN_CAP) { atomicAdd(&(bar)[XB_TMO], 1u); break; } } } } while (0)
struct XcdBarrier { unsigned* bar; unsigned x; volatile LAS unsigned* st; int wave; };
#define XB_THREAD0(b) ((b).wave == 0 && lane_id() == 0)
__device__ __forceinline__ XcdBarrier xcd_barrier_post(unsigned* bar, volatile LAS unsigned* st, int wave) {
    XcdBarrier b; b.bar = bar; b.x = xb_xcc_id(); b.st = st; b.wave = wave;
    if (XB_THREAD0(b)) (void)xb_add(&bar[XB_XCNT(b.x)], 1u);
    return b;
}
__device__ __forceinline__ void xcd_barrier_complete(unsigned* bar, unsigned x, unsigned& nloc, unsigned& nx) {
    const unsigned G = gridDim.x * gridDim.y * gridDim.z;
    unsigned sum, cnt, mine, sp = 0u;
    for (;;) {
        sum = 0u; cnt = 0u; mine = 0u;
#pragma unroll
        for (unsigned j = 0; j < 16; ++j) { const unsigned c = xb_ld(&bar[XB_XCNT(j)]); sum += c; cnt += (c > 0u) ? 1u : 0u; mine = (j == x) ? c : mine; }
        if (sum == G) break;
        __builtin_amdgcn_s_sleep(1);
        if ((++sp & 255u) == 0u) { if (xb_ld(&bar[XB_TMO])) break; if (sp > XB_SPIN_CAP) { atomicAdd(&bar[XB_TMO], 1u); break; } }
    }
    nloc = mine > 0u ? mine : 1u; nx = cnt > 0u ? cnt : 1u;
}
__device__ __forceinline__ void xcd_barrier(const XcdBarrier& b) {
    asm volatile("s_waitcnt vmcnt(0)" ::: "memory");
    __syncthreads();
    if (XB_THREAD0(b)) {
        unsigned* bar = b.bar;
        __builtin_amdgcn_s_waitcnt(0);
        unsigned nloc = b.st[0], nx = b.st[1];
        if (nloc == 0u) { xcd_barrier_complete(bar, b.x, nloc, nx); b.st[0] = nloc; b.st[1] = nx; }
        const unsigned old = xb_add(&bar[XB_XSUB(b.x)], 1u);
        const unsigned gen = old / nloc;
        if (old + 1u == (gen + 1u) * nloc) {
            __builtin_amdgcn_fence(__ATOMIC_RELEASE, "agent");
            asm volatile("s_waitcnt vmcnt(0)" ::: "memory");
            const unsigned og = xb_add(&bar[XB_TOP], 1u);
            const unsigned tg = og / nx;
            if (og + 1u == (tg + 1u) * nx) xb_add(&bar[XB_TOPGEN], 1u);
            else XB_SPIN(xb_ld(&bar[XB_TOPGEN]) == tg, bar);
            __builtin_amdgcn_fence(__ATOMIC_ACQUIRE, "agent");
            xb_add(&bar[XB_XGEN(b.x)], 1u);
            asm volatile("s_waitcnt vmcnt(0)" ::: "memory");
        } else {
            XB_SPIN(xb_ld(&bar[XB_XGEN(b.x)]) == gen, bar);
            __builtin_amdgcn_fence(__ATOMIC_ACQUIRE, "agent");
            asm volatile("s_waitcnt vmcnt(0)" ::: "memory");
        }
    }
    __syncthreads();
}

namespace pg8 {
constexpr int BM = 256, BK = 64, HALF = 128, HTB = HALF * BK * 2, STAGE_BYTES = 8 * HTB, NXCD = 8, WGM = 8;
__host__ __device__ __forceinline__ int lds_byte(int r, int c) { return (r >> 3) * 1024 + (r & 7) * 128 + ((((c >> 3) ^ (r & 7)) & 7) << 4) + (c & 7) * 2; }
__host__ __device__ __forceinline__ void stage_rc(int b, int& R, int& C) { const int s = b >> 10, sb = b & 1023, ri = sb >> 7, p = (sb >> 4) & 7; R = s * 8 + ri; C = ((p ^ ri) << 3) + ((sb & 15) >> 1); }
__host__ __device__ __forceinline__ int perm32(int rho) { const int n = rho >> 4, i = rho & 15; return 8 * (i >> 2) + 4 * n + (i & 3); }

struct Unit { const char* A; const char* B; int orow, ocol, aux; };

template <class Epi, class Sched, bool GATHER, int ES = 2>
__device__ __forceinline__ void gemm_phase(LAS unsigned char* lds, const int wave_id, const int K, const int lda, const int ldb, const Sched& S, const Epi& E) {
    int lane_ = lane_id(); asm volatile("" : "+v"(lane_));
    const int wid = wave_id, lane = lane_, tid = wid * 64 + lane, wr = wid >> 2, wc = wid & 3, fr = lane & 15, fq = lane >> 4;
    const int nt = (K * ES) / (BK * 2);
    unsigned voffA, voffB; int Rr[2], Cb[2];
    { int R, C; stage_rc(tid * 16, R, C); const int Rb = Epi::PERM ? ((R & ~31) + perm32(R & 31)) : R;
      voffA = (unsigned)(R * lda * ES + C * 2); voffB = (unsigned)(Rb * ldb * ES + C * 2); Rr[0] = R; Rr[1] = R + 64; Cb[0] = C * 2; Cb[1] = C * 2; }
    const size_t pstepA = (size_t)64 * lda * ES, pstepB = (size_t)64 * ldb * ES;
    const size_t kstep = (size_t)(BK * 2);
    const size_t hstepA = GATHER ? 0 : (size_t)HALF * lda * ES, hstepB = (size_t)HALF * ldb * ES;
    const unsigned ldsw = (unsigned)wid * 1024u;
    const int aoff0 = lds_byte(wr * 64 + fr, fq * 8), boff0 = lds_byte(wc * 32 + fr, fq * 8);
    unsigned oc[2][2], on[2][2], ox[2][2];
#define PG8_SA(b, h) (((b) * 2 + (h)) * HTB)
#define PG8_SB(b, h) ((4 + (b) * 2 + (h)) * HTB)
#define PG8_STAGE(bufoff, gbase, voff) do { _Pragma("unroll") for (int _i = 0; _i < 2; ++_i) \
        __builtin_amdgcn_global_load_lds((const unsigned*)((const char*)(gbase) + (voff)[_i]), (LAS unsigned*)(lds + (bufoff) + ldsw + _i * 8192), 16, 0, 0); } while (0)
#define PG8_STAGE1(bufoff, gbase, voff, pstep) do { _Pragma("unroll") for (int _i = 0; _i < 2; ++_i) \
        __builtin_amdgcn_global_load_lds((const unsigned*)((const char*)(gbase) + _i * (pstep) + (voff)), (LAS unsigned*)(lds + (bufoff) + ldsw + _i * 8192), 16, 0, 0); } while (0)
#define PG8_STAGE_A(bufoff, gbase, h, SET) do { if constexpr (GATHER) { PG8_STAGE(bufoff, gbase, SET[h]); } else { PG8_STAGE1(bufoff, (gbase) + (h) * hstepA, voffA, pstepA); } } while (0)
#define PG8_LDA(dst, b, h) do { int aoff1 = aoff0 ^ 64; asm volatile("" : "+v"(aoff1)); _Pragma("unroll") for (int m = 0; m < 4; ++m) { \
        if constexpr (ES == 2) { _Pragma("unroll") for (int k = 0; k < 2; ++k) dst[m][k] = *(const LAS bf16x8*)(lds + PG8_SA(b, h) + (k ? aoff1 : aoff0) + m * 2048); } \
        else { dst##8[m].lo = *(const LAS i4_t*)(lds + PG8_SA(b, h) + aoff0 + m * 2048); dst##8[m].hi = *(const LAS i4_t*)(lds + PG8_SA(b, h) + aoff1 + m * 2048); } } } while (0)
#define PG8_LDB(dst, b, h) do { int boff1 = boff0 ^ 64; asm volatile("" : "+v"(boff1)); _Pragma("unroll") for (int n = 0; n < 2; ++n) { \
        if constexpr (ES == 2) { _Pragma("unroll") for (int k = 0; k < 2; ++k) dst[n][k] = *(const LAS bf16x8*)(lds + PG8_SB(b, h) + (k ? boff1 : boff0) + n * 2048); } \
        else { dst##8[n].lo = *(const LAS i4_t*)(lds + PG8_SB(b, h) + boff0 + n * 2048); dst##8[n].hi = *(const LAS i4_t*)(lds + PG8_SB(b, h) + boff1 + n * 2048); } } } while (0)
#define PG8_MMA(ai, bj, At, Bt) do { __builtin_amdgcn_s_setprio(1); _Pragma("unroll") for (int m = 0; m < 4; ++m) _Pragma("unroll") for (int n = 0; n < 2; ++n) { \
        if constexpr (ES == 2) { _Pragma("unroll") for (int k = 0; k < 2; ++k) acc[ai][bj][m][n] = __builtin_amdgcn_mfma_f32_16x16x32_bf16(Bt[n][k], At[m][k], acc[ai][bj][m][n], 0, 0, 0); } \
        else asm volatile("v_mfma_scale_f32_16x16x128_f8f6f4 %0, %1, %2, %0, %3, %3 op_sel_hi:[0,0,0]" : "+v"(acc[ai][bj][m][n]) : "v"(Bt##8[n]), "v"(At##8[m]), "v"(mxs));     } \
        __builtin_amdgcn_s_setprio(0); } while (0)
#define PG8_WAIT_V(n) asm volatile("s_waitcnt vmcnt(" #n ")" ::: "memory")
#define PG8_WAIT_L(n) asm volatile("s_waitcnt lgkmcnt(" #n ")" ::: "memory")
#define PG8_BAR __builtin_amdgcn_s_barrier()
#define PG8_SCHED __builtin_amdgcn_sched_barrier(0)
    Unit cur, nxt; int ui = 0;
    if (!S.next(0, cur)) return;
    f32x4 acc[2][2][4][2];
#pragma unroll
    for (int a = 0; a < 2; ++a)
#pragma unroll
        for (int b = 0; b < 2; ++b)
#pragma unroll
            for (int m = 0; m < 4; ++m)
#pragma unroll
                for (int n = 0; n < 2; ++n) acc[a][b][m][n] = (f32x4){0.f, 0.f, 0.f, 0.f};
    typedef int i4_t __attribute__((ext_vector_type(4))); typedef int i8_t __attribute__((ext_vector_type(8)));
    const int mxs = 0x7f7f7f7f;
    bf16x8 At[4][2], B0[2][2], B1[2][2]; i8_t At8[4], B08[2], B18[2];
    const char* cA = cur.A; const char* cB = cur.B;
    if constexpr (GATHER) {
#pragma unroll
        for (int h = 0; h < 2; ++h)
#pragma unroll
            for (int i = 0; i < 2; ++i) oc[h][i] = S.rowoff(cur, h * HALF + Rr[i]) + (unsigned)Cb[i];
        asm volatile("s_waitcnt vmcnt(0)" : "+v"(oc[0][0]), "+v"(oc[0][1]), "+v"(oc[1][0]), "+v"(oc[1][1]) :: "memory");
    }
    PG8_STAGE1(PG8_SB(0, 0), cB, voffB, pstepB); PG8_STAGE1(PG8_SB(0, 1), cB + hstepB, voffB, pstepB); PG8_STAGE_A(PG8_SA(0, 0), cA, 0, oc); PG8_STAGE_A(PG8_SA(0, 1), cA, 1, oc);
    if (wr == 1) PG8_BAR;
    PG8_WAIT_V(2); PG8_BAR;
    PG8_STAGE1(PG8_SB(1, 0), cB + kstep, voffB, pstepB); PG8_STAGE_A(PG8_SA(1, 0), cA + kstep, 0, oc); PG8_STAGE1(PG8_SB(1, 1), cB + hstepB + kstep, voffB, pstepB);
    PG8_WAIT_V(6); PG8_BAR;
    for (;;) {
        const bool has_next = S.next(ui + 1, nxt);
        const char* nA = has_next ? nxt.A : cA; const char* nB = has_next ? nxt.B : cB;
        if constexpr (GATHER) {
            if (has_next) {
#pragma unroll
                for (int h = 0; h < 2; ++h)
#pragma unroll
                    for (int i = 0; i < 2; ++i) on[h][i] = S.rowoff(nxt, h * HALF + Rr[i]) + (unsigned)Cb[i];
                asm volatile("s_waitcnt vmcnt(0)" : "+v"(on[0][0]), "+v"(on[0][1]), "+v"(on[1][0]), "+v"(on[1][1]) :: "memory");
            } else {
#pragma unroll
                for (int h = 0; h < 2; ++h)
#pragma unroll
                    for (int i = 0; i < 2; ++i) on[h][i] = oc[h][i];
            }
        }
#pragma clang loop unroll(disable)
        for (int t = 0; t < nt; t += 2) {
            const bool last = (t == nt - 2);
            const char* a1 = cA + (size_t)(t + 1) * kstep;
            const char* a2 = last ? nA : cA + (size_t)(t + 2) * kstep; const char* b2 = last ? nB : cB + (size_t)(t + 2) * kstep;
            const char* a3 = a2 + kstep; const char* b3 = b2 + kstep;
            if constexpr (GATHER) {
#pragma unroll
                for (int h = 0; h < 2; ++h)
#pragma unroll
                    for (int i = 0; i < 2; ++i) ox[h][i] = last ? on[h][i] : oc[h][i];
            }
            PG8_LDB(B0, 0, 0); PG8_LDB(B1, 0, 1); PG8_SCHED; PG8_LDA(At, 0, 0); PG8_STAGE_A(PG8_SA(1, 1), a1, 1, oc);
            PG8_WAIT_V(8); PG8_WAIT_L(0); PG8_BAR; PG8_MMA(0, 0, At, B0); PG8_MMA(0, 1, At, B1); PG8_BAR; PG8_SCHED;
            PG8_LDA(At, 0, 1); PG8_STAGE1(PG8_SB(0, 0), b2, voffB, pstepB); PG8_STAGE1(PG8_SB(0, 1), b2 + hstepB, voffB, pstepB); PG8_STAGE_A(PG8_SA(0, 0), a2, 0, ox);
            PG8_WAIT_V(8); PG8_WAIT_L(0); PG8_BAR; PG8_MMA(1, 0, At, B0); PG8_MMA(1, 1, At, B1); PG8_BAR; PG8_SCHED;
            PG8_LDB(B0, 1, 0); PG8_LDB(B1, 1, 1); PG8_SCHED; PG8_LDA(At, 1, 0); PG8_STAGE_A(PG8_SA(0, 1), a2, 1, ox);
            PG8_WAIT_V(8); PG8_WAIT_L(0); PG8_BAR; PG8_MMA(0, 0, At, B0); PG8_MMA(0, 1, At, B1); PG8_BAR; PG8_SCHED;
            PG8_LDA(At, 1, 1); PG8_STAGE1(PG8_SB(1, 0), b3, voffB, pstepB); PG8_STAGE1(PG8_SB(1, 1), b3 + hstepB, voffB, pstepB); PG8_STAGE_A(PG8_SA(1, 0), a3, 0, ox);
            PG8_WAIT_V(8); PG8_WAIT_L(0); PG8_BAR; PG8_MMA(1, 0, At, B0); PG8_MMA(1, 1, At, B1); PG8_BAR; PG8_SCHED;
        }
        if (wr == 0) PG8_BAR;
        if constexpr (ES == 1) asm volatile("s_nop 15\n\ts_nop 15" ::: "memory");
        { int fr_e = fr, fq_e = fq; asm volatile("" : "+v"(fr_e), "+v"(fq_e));
          E(acc, cur, wr, wc, fr_e, fq_e); }
        if (!has_next) break;
#pragma unroll
        for (int a = 0; a < 2; ++a)
#pragma unroll
            for (int b = 0; b < 2; ++b)
#pragma unroll
                for (int m = 0; m < 4; ++m)
#pragma unroll
                    for (int n = 0; n < 2; ++n) acc[a][b][m][n] = (f32x4){0.f, 0.f, 0.f, 0.f};
        cur = nxt; cA = nA; cB = nB; ++ui;
        if constexpr (GATHER) {
#pragma unroll
            for (int h = 0; h < 2; ++h)
#pragma unroll
                for (int i = 0; i < 2; ++i) oc[h][i] = on[h][i];
        }
        if (wr == 1) PG8_BAR;
    }
    PG8_WAIT_V(0);
    PG8_BAR;
#undef PG8_SA
#undef PG8_SB
#undef PG8_STAGE
#undef PG8_STAGE1
#undef PG8_STAGE_A
#undef PG8_LDA
#undef PG8_LDB
#undef PG8_MMA
#undef PG8_WAIT_V
#undef PG8_WAIT_L
#undef PG8_BAR
#undef PG8_SCHED
}

struct DenseSched {
    const char* A; const char* B; int lda, ldb, nM, nN, nwg, G, c, first, last, es = 2;
    __device__ void init(const void* A_, const void* B_, int lda_, int ldb_, int M, int N, int G_, int c_, int first_ = 0, int count_ = -1) { A = (const char*)A_; B = (const char*)B_; lda = lda_; ldb = ldb_; nM = M / BM; nN = N / BM; nwg = nM * nN; G = G_; c = c_;
        first = first_; last = (count_ < 0) ? nwg : first_ + count_; }
    __device__ __forceinline__ bool next(int i, Unit& u) const {
        const long L = (long)first + (long)i * G + c; if (L >= last) return false;
        int wgid = (int)L; { const int q = nwg / NXCD, r = nwg % NXCD, xcd = wgid % NXCD, off = wgid / NXCD; wgid = (xcd < r ? xcd * (q + 1) : r * (q + 1) + (xcd - r) * q) + off; }
        const int nig = WGM * nN, gid = wgid / nig, fm = gid * WGM, gsz = (nM - fm) < WGM ? (nM - fm) : WGM;
        const int pm = fm + ((wgid % nig) % gsz), pn = (wgid % nig) / gsz;
        u.A = A + (size_t)pm * BM * lda * es; u.B = B + (size_t)pn * BM * ldb * es; u.orow = pm * BM; u.ocol = pn * BM; u.aux = 0; return true;
    }
    __device__ __forceinline__ unsigned rowoff(const Unit&, int) const { return 0u; }
};
}

template <int MODE> struct EpiBf16 {
    static constexpr bool PERM = true;
    bf16_t* O; int ldc; const float* sv; float inv_dim, mul;
    __device__ __forceinline__ void operator()(const f32x4 (&acc)[2][2][4][2], const pg8::Unit& u, int wr, int wc, int fr, int fq) const {
        const int row0 = u.orow + wr * 64 + fr, col0 = u.ocol + wc * 32 + 8 * fq;
#pragma unroll
        for (int ai = 0; ai < 2; ++ai)
#pragma unroll
            for (int m = 0; m < 4; ++m) { const int row = row0 + ai * 128 + m * 16;
                float s = mul; if (MODE == 1) s = mul / sqrtf(sv[row] * inv_dim + EPS); if (MODE == 2) s = mul * sv[row]; if (MODE == 3) s = mul / sqrtf(fx_get((const fx64*)sv + row) * inv_dim + EPS);
                bf16_t* rowp = O + (size_t)row * ldc + col0;
#pragma unroll
                for (int bj = 0; bj < 2; ++bj) { const f32x4 v0 = acc[ai][bj][m][0] * s, v1 = acc[ai][bj][m][1] * s;
                    u32x4 w; w.x = cvt_pk_bf16(v0[0], v0[1]); w.y = cvt_pk_bf16(v0[2], v0[3]); w.z = cvt_pk_bf16(v1[0], v1[1]); w.w = cvt_pk_bf16(v1[2], v1[3]);
                    *(u32x4*)(rowp + bj * 128) = w; } }
    }
};
struct EpiF8Rms {
    static constexpr bool PERM = true;
    unsigned char* O; int ldc; const float* ssq; float inv_dim, mul;
    __device__ __forceinline__ void operator()(const f32x4 (&acc)[2][2][4][2], const pg8::Unit& u, int wr, int wc, int fr, int fq) const {
        const int row0 = u.orow + wr * 64 + fr, col0 = u.ocol + wc * 32 + 8 * fq;
#pragma unroll
        for (int ai = 0; ai < 2; ++ai)
#pragma unroll
            for (int m = 0; m < 4; ++m) { const int row = row0 + ai * 128 + m * 16; const float s = mul / sqrtf(ssq[row] * inv_dim + EPS); unsigned char* rowp = O + (size_t)row * ldc + col0;
#pragma unroll
                for (int bj = 0; bj < 2; ++bj) { const f32x4 v0 = acc[ai][bj][m][0] * s, v1 = acc[ai][bj][m][1] * s;
                    u32x2 w; w.x = pk4_fp8(v0[0], v0[1], v0[2], v0[3]); w.y = pk4_fp8(v1[0], v1[1], v1[2], v1[3]); *(u32x2*)(rowp + bj * 128) = w; } }
    }
};
struct EpiF8 {
    static constexpr bool PERM = true;
    unsigned char* O; int ldc; float mul;
    __device__ __forceinline__ void operator()(const f32x4 (&acc)[2][2][4][2], const pg8::Unit& u, int wr, int wc, int fr, int fq) const {
        const int row0 = u.orow + wr * 64 + fr, col0 = u.ocol + wc * 32 + 8 * fq;
#pragma unroll
        for (int ai = 0; ai < 2; ++ai)
#pragma unroll
            for (int m = 0; m < 4; ++m) { unsigned char* rowp = O + (size_t)(row0 + ai * 128 + m * 16) * ldc + col0;
#pragma unroll
                for (int bj = 0; bj < 2; ++bj) { const f32x4 v0 = acc[ai][bj][m][0] * mul, v1 = acc[ai][bj][m][1] * mul;
                    u32x2 w; w.x = pk4_fp8(v0[0], v0[1], v0[2], v0[3]); w.y = pk4_fp8(v1[0], v1[1], v1[2], v1[3]); *(u32x2*)(rowp + bj * 128) = w; } }
    }
};
__device__ __forceinline__ void rope8(f32x4& v0, f32x4& v1, const f32x2* cs) {
    const f32x4 c01 = *(const f32x4*)cs, c23 = *(const f32x4*)(cs + 2);
    f32x4 a = v0, b = v1;
    v0[0] = a[0] * c01[0] - a[1] * c01[1]; v0[1] = a[1] * c01[0] + a[0] * c01[1];
    v0[2] = a[2] * c01[2] - a[3] * c01[3]; v0[3] = a[3] * c01[2] + a[2] * c01[3];
    v1[0] = b[0] * c23[0] - b[1] * c23[1]; v1[1] = b[1] * c23[0] + b[0] * c23[1];
    v1[2] = b[2] * c23[2] - b[3] * c23[3]; v1[3] = b[3] * c23[2] + b[2] * c23[3];
}
struct EpiZ {
    static constexpr bool PERM = true;
    bf16_t* zb; bf16_t* krope; const float* ssq_x; fx64* ssq_q; fx64* ssq_kv; const f32x2* tab;
    __device__ __forceinline__ void operator()(const f32x4 (&acc)[2][2][4][2], const pg8::Unit& u, int wr, int wc, int fr, int fq) const {
        const int row0 = u.orow + wr * 64 + fr, col0 = u.ocol + wc * 32 + 8 * fq;
        fx64* ssq = (u.ocol == C_Q || u.ocol == C_Q + 256) ? ssq_q : (u.ocol == C_KV ? ssq_kv : nullptr);
        const bool isrope = (u.ocol == C_KR) && (wc < 2);
#pragma unroll
        for (int ai = 0; ai < 2; ++ai)
#pragma unroll
            for (int m = 0; m < 4; ++m) { const int row = row0 + ai * 128 + m * 16;
                const float s = 1.0f / sqrtf(ssq_x[row] * (1.0f / DM) + EPS);
                bf16_t* rowp = zb + (size_t)row * ZC + col0; float q = 0.f;
#pragma unroll
                for (int bj = 0; bj < 2; ++bj) { f32x4 v0 = acc[ai][bj][m][0] * s, v1 = acc[ai][bj][m][1] * s;
                    q += (v0[0] * v0[0] + v0[1] * v0[1]) + (v0[2] * v0[2] + v0[3] * v0[3]) + (v1[0] * v1[0] + v1[1] * v1[1]) + (v1[2] * v1[2] + v1[3] * v1[3]);
                    u32x4 w; w.x = cvt_pk_bf16(v0[0], v0[1]); w.y = cvt_pk_bf16(v0[2], v0[3]); w.z = cvt_pk_bf16(v1[0], v1[1]); w.w = cvt_pk_bf16(v1[2], v1[3]);
                    *(u32x4*)(rowp + bj * 128) = w;
                    if (bj == 0 && isrope) { const int c = wc * 32 + 8 * fq;
                        rope8(v0, v1, tab + (size_t)row * 32 + (c >> 1));
                        u32x4 w2; w2.x = cvt_pk_bf16(v0[0], v0[1]); w2.y = cvt_pk_bf16(v0[2], v0[3]); w2.z = cvt_pk_bf16(v1[0], v1[1]); w2.w = cvt_pk_bf16(v1[2], v1[3]);
                        *(u32x4*)(krope + (size_t)row * DR + c) = w2; } }
                if (ssq) { q += __shfl_xor(q, 16); q += __shfl_xor(q, 32); if (fq == 0) fx_add(ssq + row, q); } }
    }
};
struct EpiQ {
    static constexpr bool PERM = true;
    bf16_t* qb; const fx64* ssq_q; const f32x2* tab;
    __device__ __forceinline__ void operator()(const f32x4 (&acc)[2][2][4][2], const pg8::Unit& u, int wr, int wc, int fr, int fq) const {
        const int row0 = u.orow + wr * 64 + fr, col0 = u.ocol + wc * 32 + 8 * fq;
        const float qs = LOG2E * 0.07216878364870322f;
#pragma unroll
        for (int ai = 0; ai < 2; ++ai)
#pragma unroll
            for (int m = 0; m < 4; ++m) { const int row = row0 + ai * 128 + m * 16;
                const float s = 1.0f / sqrtf(fx_get(ssq_q + row) * (1.0f / QL) + EPS);
                bf16_t* rowp = qb + (size_t)row * (NH * DQK) + col0;
#pragma unroll
                for (int bj = 0; bj < 2; ++bj) { f32x4 v0 = acc[ai][bj][m][0] * s, v1 = acc[ai][bj][m][1] * s;
                    const int d = (col0 + bj * 128) % DQK;
                    if (d >= DN) rope8(v0, v1, tab + (size_t)row * 32 + ((d - DN) >> 1));
                    v0 = v0 * qs; v1 = v1 * qs;
                    u32x4 w; w.x = cvt_pk_bf16(v0[0], v0[1]); w.y = cvt_pk_bf16(v0[2], v0[3]); w.z = cvt_pk_bf16(v1[0], v1[1]); w.w = cvt_pk_bf16(v1[2], v1[3]);
                    *(u32x4*)(rowp + bj * 128) = w; } }
    }
};
template <bool KPERM> struct EpiColScale {
    static constexpr bool PERM = false;
    bf16_t* O; int ldc; const fx64* ssq; float inv_dim;
    __device__ __forceinline__ void operator()(const f32x4 (&acc)[2][2][4][2], const pg8::Unit& u, int wr, int wc, int fr, int fq) const {
        const int row0 = u.orow + wr * 64 + fr, colb = u.ocol + wc * 32;
        const int fqp = KPERM ? (((fq & 1) << 1) | (fq >> 1)) : fq;
#pragma unroll
        for (int bj = 0; bj < 2; ++bj)
#pragma unroll
            for (int n = 0; n < 2; ++n) { const fx64* qp = ssq + colb + bj * 128 + n * 16 + 4 * fq; f32x4 sc;
#pragma unroll
                for (int e = 0; e < 4; ++e) sc[e] = 1.0f / sqrtf(fx_get(qp + e) * inv_dim + EPS);
#pragma unroll
                for (int ai = 0; ai < 2; ++ai)
#pragma unroll
                    for (int m = 0; m < 4; ++m) { bf16_t* rowp = O + (size_t)(row0 + ai * 128 + m * 16) * ldc + colb + 4 * fqp; const f32x4 v = acc[ai][bj][m][n] * sc;
                        u32x2 w; w.x = cvt_pk_bf16(v[0], v[1]); w.y = cvt_pk_bf16(v[2], v[3]); *(u32x2*)(rowp + bj * 128 + n * 16) = w; } }
    }
};
template <bool FROM_F32> struct EpiResidHL {
    static constexpr bool PERM = true;
    const float* xf; const bf16_t* xih; const bf16_t* xil; bf16_t* xh; bf16_t* xl; fx64* ssq; unsigned char* x8; float amul;
    __device__ __forceinline__ void operator()(const f32x4 (&acc)[2][2][4][2], const pg8::Unit& u, int wr, int wc, int fr, int fq) const {
        const int row0 = u.orow + wr * 64 + fr, col0 = u.ocol + wc * 32 + 8 * fq;
#pragma unroll
        for (int ai = 0; ai < 2; ++ai) {
            f32x4 xv[4][2][2];
#pragma unroll
            for (int m = 0; m < 4; ++m)
#pragma unroll
                for (int bj = 0; bj < 2; ++bj) { const size_t off = (size_t)(row0 + ai * 128 + m * 16) * DM + col0 + bj * 128;
                    if (FROM_F32) { xv[m][bj][0] = NTL((const f32x4*)(xf + off)); xv[m][bj][1] = NTL((const f32x4*)(xf + off + 4)); }
                    else { const u32x4 h = NTL((const u32x4*)(xih + off)), l = NTL((const u32x4*)(xil + off));
                        xv[m][bj][0] = (f32x4){bf_lo(h.x) + bf_lo(l.x), bf_hi(h.x) + bf_hi(l.x), bf_lo(h.y) + bf_lo(l.y), bf_hi(h.y) + bf_hi(l.y)};
                        xv[m][bj][1] = (f32x4){bf_lo(h.z) + bf_lo(l.z), bf_hi(h.z) + bf_hi(l.z), bf_lo(h.w) + bf_lo(l.w), bf_hi(h.w) + bf_hi(l.w)}; } }
#pragma unroll
            for (int m = 0; m < 4; ++m) { const int row = row0 + ai * 128 + m * 16; float q = 0.f;
#pragma unroll
                for (int bj = 0; bj < 2; ++bj) { const size_t off = (size_t)row * DM + col0 + bj * 128;
                    const f32x4 v0 = xv[m][bj][0] + acc[ai][bj][m][0] * amul, v1 = xv[m][bj][1] + acc[ai][bj][m][1] * amul;
                    q += ((v0[0] * v0[0] + v0[1] * v0[1]) + (v0[2] * v0[2] + v0[3] * v0[3])) + ((v1[0] * v1[0] + v1[1] * v1[1]) + (v1[2] * v1[2] + v1[3] * v1[3]));
                    u32x4 h; h.x = cvt_pk_bf16(v0[0], v0[1]); h.y = cvt_pk_bf16(v0[2], v0[3]); h.z = cvt_pk_bf16(v1[0], v1[1]); h.w = cvt_pk_bf16(v1[2], v1[3]); *(u32x4*)(xh + off) = h;
                    u32x4 l; l.x = cvt_pk_bf16(v0[0] - bf_lo(h.x), v0[1] - bf_hi(h.x)); l.y = cvt_pk_bf16(v0[2] - bf_lo(h.y), v0[3] - bf_hi(h.y));
                    l.z = cvt_pk_bf16(v1[0] - bf_lo(h.z), v1[1] - bf_hi(h.z)); l.w = cvt_pk_bf16(v1[2] - bf_lo(h.w), v1[3] - bf_hi(h.w)); *(u32x4*)(xl + off) = l;
                    if (x8) { u32x2 w; w.x = pk4_fp8(v0[0], v0[1], v0[2], v0[3]); w.y = pk4_fp8(v1[0], v1[1], v1[2], v1[3]); *(u32x2*)(x8 + off) = w; } }
                q += __shfl_xor(q, 16); q += __shfl_xor(q, 32); if (fq == 0) fx_add(ssq + row, q); }
        }
    }
};
struct EpiSoftmax {
    static constexpr bool PERM = true;
    bf16_t* P; int ldc; LAS float* tmax; LAS float* tsum; const fx64* ssq; float inv_dim; float smul; unsigned char* P8;
    __device__ __forceinline__ void operator()(f32x4 (&acc)[2][2][4][2], const pg8::Unit& u, int wr, int wc, int fr, int fq) const {
        const int col0 = u.ocol + wc * 32 + 8 * fq;
#pragma unroll
        for (int ai = 0; ai < 2; ++ai)
#pragma unroll
            for (int m = 0; m < 4; ++m) { float v = -3.0e38f; const float rs = smul / sqrtf(fx_get(ssq + u.orow + ai * 128 + wr * 64 + m * 16 + fr) * inv_dim + EPS);
#pragma unroll
                for (int bj = 0; bj < 2; ++bj)
#pragma unroll
                    for (int n = 0; n < 2; ++n) { const f32x4 x = acc[ai][bj][m][n] * rs; acc[ai][bj][m][n] = x; v = fmaxf(fmaxf(fmaxf(v, x[0]), fmaxf(x[1], x[2])), x[3]); }
                v = fmaxf(v, __shfl_xor(v, 16)); v = fmaxf(v, __shfl_xor(v, 32));
                if (fq == 0) tmax[(ai * 128 + wr * 64 + m * 16 + fr) * 4 + wc] = v; }
        LDS_WAIT(); __builtin_amdgcn_s_barrier(); asm volatile("" ::: "memory");
#pragma unroll
        for (int ai = 0; ai < 2; ++ai)
#pragma unroll
            for (int m = 0; m < 4; ++m) { const f32x4 t = *(const LAS f32x4*)(tmax + (ai * 128 + wr * 64 + m * 16 + fr) * 4);
                const float rm = fmaxf(fmaxf(t[0], t[1]), fmaxf(t[2], t[3])); float s = 0.f;
#pragma unroll
                for (int bj = 0; bj < 2; ++bj)
#pragma unroll
                    for (int n = 0; n < 2; ++n) { f32x4 x = acc[ai][bj][m][n] - rm;
#pragma unroll
                        for (int e = 0; e < 4; ++e) x[e] = __builtin_amdgcn_exp2f(x[e]);
                        s += (x[0] + x[1]) + (x[2] + x[3]); acc[ai][bj][m][n] = x; }
                s += __shfl_xor(s, 16); s += __shfl_xor(s, 32);
                if (fq == 0) tsum[(ai * 128 + wr * 64 + m * 16 + fr) * 4 + wc] = s; }
        LDS_WAIT(); __builtin_amdgcn_s_barrier(); asm volatile("" ::: "memory");
#pragma unroll
        for (int ai = 0; ai < 2; ++ai)
#pragma unroll
            for (int m = 0; m < 4; ++m) { const int rl = ai * 128 + wr * 64 + m * 16 + fr; const f32x4 t = *(const LAS f32x4*)(tsum + rl * 4);
                const float inv = 1.0f / ((t[0] + t[1]) + (t[2] + t[3]));
                bf16_t* rowp = P + (size_t)(u.orow + rl) * ldc + col0; unsigned char* rowp8 = P8 + (size_t)(u.orow + rl) * ldc + col0;
#pragma unroll
                for (int bj = 0; bj < 2; ++bj) { const f32x4 v0 = acc[ai][bj][m][0] * inv, v1 = acc[ai][bj][m][1] * inv;
                    if (P8) { const f32x4 a0 = v0 * F8_SP, a1 = v1 * F8_SP; u32x2 w; w.x = pk4_fp8(a0[0], a0[1], a0[2], a0[3]); w.y = pk4_fp8(a1[0], a1[1], a1[2], a1[3]); *(u32x2*)(rowp8 + bj * 128) = w; }
                    else { u32x4 w; w.x = cvt_pk_bf16(v0[0], v0[1]); w.y = cvt_pk_bf16(v0[2], v0[3]); w.z = cvt_pk_bf16(v1[0], v1[1]); w.w = cvt_pk_bf16(v1[2], v1[3]);
                    *(u32x4*)(rowp + bj * 128) = w; } } }
    }
};
struct EpiF8Row {
    static constexpr bool PERM = true;
    unsigned char* O; int ldc; const float* sv; float mul;
    __device__ __forceinline__ void operator()(const f32x4 (&acc)[2][2][4][2], const pg8::Unit& u, int wr, int wc, int fr, int fq) const {
        const int row0 = u.orow + wr * 64 + fr, col0 = u.ocol + wc * 32 + 8 * fq;
#pragma unroll
        for (int ai = 0; ai < 2; ++ai)
#pragma unroll
            for (int m = 0; m < 4; ++m) { const int row = row0 + ai * 128 + m * 16; const float s = sv[row] * mul; unsigned char* rowp = O + (size_t)row * ldc + col0;
#pragma unroll
                for (int bj = 0; bj < 2; ++bj) { const f32x4 v0 = acc[ai][bj][m][0] * s, v1 = acc[ai][bj][m][1] * s;
                    u32x2 w; w.x = pk4_fp8(v0[0], v0[1], v0[2], v0[3]); w.y = pk4_fp8(v1[0], v1[1], v1[2], v1[3]); *(u32x2*)(rowp + bj * 128) = w; } }
    }
};
struct EpiGateUp8 {
    static constexpr bool PERM = true;
    unsigned char* act; const float* row_rs;
    __device__ __forceinline__ void operator()(const f32x4 (&acc)[2][2][4][2], const pg8::Unit& u, int wr, int wc, int fr, int fq) const {
        const int row0 = u.orow + wr * 64 + fr, col0 = u.ocol + wc * 32 + 8 * fq;
#pragma unroll
        for (int ai = 0; ai < 2; ++ai)
#pragma unroll
            for (int m = 0; m < 4; ++m) { const int row = row0 + ai * 128 + m * 16; const float s = row_rs[row] * (1.0f / F8_SW);
                float o[8];
#pragma unroll
                for (int n = 0; n < 2; ++n)
#pragma unroll
                    for (int e = 0; e < 4; ++e) { const float g = acc[ai][0][m][n][e] * s, up = acc[ai][1][m][n][e] * s; o[n * 4 + e] = g / (1.0f + __expf(-g)) * up * F8_SACT; }
                u32x2 w; w.x = pk4_fp8(o[0], o[1], o[2], o[3]); w.y = pk4_fp8(o[4], o[5], o[6], o[7]);
                *(u32x2*)(act + (size_t)row * DE + col0) = w; }
    }
};
struct EpiGateUp {
    static constexpr bool PERM = true;
    bf16_t* act; const float* row_rs;
    __device__ __forceinline__ void operator()(const f32x4 (&acc)[2][2][4][2], const pg8::Unit& u, int wr, int wc, int fr, int fq) const {
        const int row0 = u.orow + wr * 64 + fr, col0 = u.ocol + wc * 32 + 8 * fq;
#pragma unroll
        for (int ai = 0; ai < 2; ++ai)
#pragma unroll
            for (int m = 0; m < 4; ++m) { const int row = row0 + ai * 128 + m * 16; const float s = row_rs[row];
                float o[8];
#pragma unroll
                for (int n = 0; n < 2; ++n)
#pragma unroll
                    for (int e = 0; e < 4; ++e) { const float g = acc[ai][0][m][n][e] * s, up = acc[ai][1][m][n][e] * s; o[n * 4 + e] = g / (1.0f + __expf(-g)) * up; }
                u32x4 w; w.x = cvt_pk_bf16(o[0], o[1]); w.y = cvt_pk_bf16(o[2], o[3]); w.z = cvt_pk_bf16(o[4], o[5]); w.w = cvt_pk_bf16(o[6], o[7]);
                *(u32x4*)(act + (size_t)row * DE + col0) = w; }
    }
};

struct EpiRouter {
    static constexpr bool PERM = false;
    float* slab;
    __device__ __forceinline__ void operator()(const f32x4 (&acc)[2][2][4][2], const pg8::Unit& u, int wr, int wc, int fr, int fq) const {
        if (wc < 3) {
            const int row0 = u.orow + wr * 64 + fr, col0 = wc * 32 + 4 * fq;
#pragma unroll
            for (int ai = 0; ai < 2; ++ai)
#pragma unroll
                for (int m = 0; m < 4; ++m) { float* rowp = slab + ((size_t)u.aux * NTOK + row0 + ai * 128 + m * 16) * 96 + col0;
#pragma unroll
                    for (int n = 0; n < 2; ++n) *(f32x4*)(rowp + n * 16) = acc[ai][0][m][n] + acc[ai][1][m][n]; }
        }
    }
};

struct MtSched {
    const char* kx_; const char* wq; int G, c, es;
    __device__ __forceinline__ bool next(int i, pg8::Unit& u) const { const int L = i * G + c; if (L >= NB * XH * 8) return false;
        const int bh = L >> 3, pn = L & 7, b = bh >> 2, h = bh & 3;
        u.A = kx_ + ((size_t)(b * MEM) * DM + h * XD) * es; u.B = wq + ((size_t)(pn * 256) * DM + h * XD) * es; u.orow = bh * MEM; u.ocol = pn * 256; u.aux = 0; return true; }
    __device__ __forceinline__ unsigned rowoff(const pg8::Unit&, int) const { return 0u; }
};
struct VWtSched {
    const char* wo; const char* vx_; int G, c, es;
    __device__ __forceinline__ bool next(int i, pg8::Unit& u) const { const int L = i * G + c; if (L >= NB * XH * 8) return false;
        const int bh = L >> 3, pm = L & 7, b = bh >> 2, h = bh & 3;
        u.A = wo + ((size_t)(pm * 256) * DM + h * XD) * es; u.B = vx_ + ((size_t)(b * MEM) * DM + h * XD) * es; u.orow = b * DM + pm * 256; u.ocol = h * MEM; u.aux = 0; return true; }
    __device__ __forceinline__ unsigned rowoff(const pg8::Unit&, int) const { return 0u; }
};
struct CrossSSched {
    const char* xa; const char* mt; int G, c, es;
    __device__ __forceinline__ bool next(int i, pg8::Unit& u) const { const int L = i * G + c; if (L >= NB * XH * 8) return false;
        const int b = L >> 5, h = (L >> 3) & 3, qb = L & 7;
        u.A = xa + (size_t)(b * T + qb * 256) * DM * es; u.B = mt + (size_t)((b * XH + h) * MEM) * DM * es; u.orow = b * T + qb * 256; u.ocol = h * MEM; u.aux = 0; return true; }
    __device__ __forceinline__ unsigned rowoff(const pg8::Unit&, int) const { return 0u; }
};
struct CrossOSched {
    const char* pb; const char* vwt; int G, c, es;
    __device__ __forceinline__ bool next(int i, pg8::Unit& u) const { const int L = i * G + c; if (L >= NB * 8 * 8) return false;
        const int b = L >> 6, qb = (L >> 3) & 7, pn = L & 7;
        u.A = pb + (size_t)(b * T + qb * 256) * (XH * MEM) * es; u.B = vwt + (size_t)(b * DM + pn * 256) * (XH * MEM) * es; u.orow = b * T + qb * 256; u.ocol = pn * 256; u.aux = 0; return true; }
    __device__ __forceinline__ unsigned rowoff(const pg8::Unit&, int) const { return 0u; }
};
struct RouterSched {
    const char* xh; const char* xl; const char* wrt; int G, c;
    __device__ __forceinline__ bool next(int i, pg8::Unit& u) const { const int L = i * G + c; if (L >= (NTOK / 256) * 4) return false;
        const int pm = L >> 2, kq = L & 3;
        u.A = (kq < 2 ? xh : xl) + ((size_t)pm * 256 * DM + (kq & 1) * 1024) * 2; u.B = wrt + (size_t)kq * 1024 * 2; u.orow = pm * 256; u.ocol = 0; u.aux = kq; return true; }
    __device__ __forceinline__ unsigned rowoff(const pg8::Unit&, int) const { return 0u; }
};
struct MoeSched {
    const char* A; const char* B; const int* row_tok; const LAS int* blk_e; int nunits, ntl2, G, c; size_t a_blk_stride, b_exp_stride, b_tile_stride; int ocol_step; unsigned rowbytes;
    __device__ __forceinline__ bool next(int i, pg8::Unit& u) const { const int L = i * G + c; if (L >= nunits) return false;
        const int blk = L >> ntl2, nt = L & ((1 << ntl2) - 1), e = blk_e[blk];
        u.A = A + (size_t)blk * a_blk_stride; u.B = B + (size_t)e * b_exp_stride + (size_t)nt * b_tile_stride; u.orow = blk * 256; u.ocol = nt * ocol_step; u.aux = e; return true; }
    __device__ __forceinline__ unsigned rowoff(const pg8::Unit& u, int r) const { return (unsigned)row_tok[u.orow + r] * rowbytes; }
};

struct Args {
    const float* x; const float* mem; const int* pos; const float* g_mix; const float* w_in; const float* w_conv; const float* g_q_a; const float* w_q_up; const float* g_kv_a; const float* w_kv_up;
    const float* g_conv_out; const float* g_attn_out; const float* w_out; const float* g_xattn; const float* g_mem; const float* w_xq; const float* w_xk; const float* w_xv; const float* w_xo;
    const float* g_moe; const float* w_group; const float* b_group; const float* w_router; const float* b_router; const float* w_gate; const float* w_up; const float* w_down; const float* g_final;
    float* out; unsigned char* ws; unsigned mask; unsigned flags;
};

template <int MAP> __device__ __forceinline__ int map_row(int n) {
    if (MAP == 1) { if (n < C_KR) return n; const int r = n - C_KR; return C_KR + (r < 32 ? 2 * r : 2 * (r - 32) + 1); }
    if (MAP == 2) { const int h = n / DQK, d = n % DQK; if (d < DN) return n; const int r = d - DN; return h * DQK + DN + (r < 32 ? 2 * r : 2 * (r - 32) + 1); }
    if (MAP == 3) { const int h = n >> 8, d = n & 255; return d < DN ? h * DN + d : NH * DN + h * DV + (d - DN); }
    if (MAP == 4) { return ((n >> 7) << 8) + (n & 127); }
    if (MAP == 5) { return ((n >> 7) << 8) + 128 + (n & 127); }
    return n;
}
template <int MAP, bool HAS_GAIN>
__device__ __forceinline__ void transpose_item(const float* W, int ldw, const float* gain, const float* gain2, int gsplit, bf16_t* WT, int ldo, LAS float* scr, int k0, int n0, int lane) {
    float gv = 1.0f;
    if (HAS_GAIN) { const float* gp = (k0 < gsplit) ? gain + k0 : gain2 + (k0 - gsplit); gv = gp[lane]; }
    const int kr = lane >> 3, nc = (lane & 7) * 4;
    f32x4 v[8];
#pragma unroll
    for (int i = 0; i < 8; ++i) v[i] = NTL((const f32x4*)(W + (size_t)(k0 + 8 * i + kr) * ldw + n0 + nc));
#pragma unroll
    for (int i = 0; i < 8; ++i) { const int kk = 8 * i + kr; float g = 1.0f;
        if (HAS_GAIN) g = __shfl(gv, kk);
        LAS float* d = scr + kk * 33 + nc; d[0] = v[i][0] * g; d[1] = v[i][1] * g; d[2] = v[i][2] * g; d[3] = v[i][3] * g; }
    LDS_WAIT(); asm volatile("" ::: "memory");
    const int c = lane & 7;
#pragma unroll
    for (int j = 0; j < 4; ++j) { const int n = (lane >> 3) + 8 * j; const LAS float* s = scr + (8 * c) * 33 + n;
        u32x4 o; o.x = cvt_pk_bf16(s[0 * 33], s[1 * 33]); o.y = cvt_pk_bf16(s[2 * 33], s[3 * 33]); o.z = cvt_pk_bf16(s[4 * 33], s[5 * 33]); o.w = cvt_pk_bf16(s[6 * 33], s[7 * 33]);
        *(u32x4*)(WT + (size_t)map_row<MAP>(n0 + n) * ldo + k0 + 8 * c) = o; }
    LDS_WAIT(); asm volatile("" ::: "memory");
}
template <int MAP, bool HAS_GAIN>
__device__ __forceinline__ void transpose_item8(const float* W, int ldw, const float* gain, float scale, unsigned char* WT, int ldo, LAS float* scr, int k0, int n0, int lane) {
    float gv = scale;
    if (HAS_GAIN) gv = gain[k0 + lane] * scale;
    const int kr = lane >> 3, nc = (lane & 7) * 4;
    f32x4 v[8];
#pragma unroll
    for (int i = 0; i < 8; ++i) v[i] = NTL((const f32x4*)(W + (size_t)(k0 + 8 * i + kr) * ldw + n0 + nc));
#pragma unroll
    for (int i = 0; i < 8; ++i) { const int kk = 8 * i + kr; const float g = __shfl(gv, kk);
        LAS float* d = scr + kk * 33 + nc; d[0] = v[i][0] * g; d[1] = v[i][1] * g; d[2] = v[i][2] * g; d[3] = v[i][3] * g; }
    LDS_WAIT(); asm volatile("" ::: "memory");
    const int c = lane & 7;
#pragma unroll
    for (int j = 0; j < 4; ++j) { const int n = (lane >> 3) + 8 * j; const LAS float* s = scr + (8 * c) * 33 + n;
        u32x2 o; o.x = pk4_fp8(s[0 * 33], s[1 * 33], s[2 * 33], s[3 * 33]); o.y = pk4_fp8(s[4 * 33], s[5 * 33], s[6 * 33], s[7 * 33]);
        *(u32x2*)(WT + (size_t)map_row<MAP>(n0 + n) * ldo + k0 + 8 * c) = o; }
    LDS_WAIT(); asm volatile("" ::: "memory");
}

struct XItem { const float* W; const float* gain; unsigned char* WT; int ldw, ldo, k0, n0, gu, upoff; float scale; };
constexpr int XP_PITCH = 528, XP_BUF = 128 * XP_PITCH;
static_assert(2 * XP_BUF <= TAB_OFF, "transposer LDS");
__device__ __forceinline__ void xp_load(f32x4 (&v)[8][4], f32x4 (&g)[8], const XItem& x, int wave, int lane) {
    const int nq = (wave & 1) * 64 + lane, kg = wave >> 1;
    if (x.gain) { const float* gp = x.gain + x.k0 + 4 * kg;
#pragma unroll
        for (int j = 0; j < 8; ++j) g[j] = *(const f32x4*)(gp + 16 * j); }
    else {
#pragma unroll
        for (int j = 0; j < 8; ++j) g[j] = (f32x4){1.f, 1.f, 1.f, 1.f}; }
    const float* p = x.W + (size_t)(x.k0 + 4 * kg) * x.ldw + x.n0 + 4 * nq;
#pragma unroll
    for (int j = 0; j < 8; ++j)
#pragma unroll
        for (int r = 0; r < 4; ++r) v[j][r] = __builtin_nontemporal_load((const f32x4*)(p + (size_t)(16 * j + r) * x.ldw));
}
__device__ __forceinline__ void xp_pack(const f32x4 (&v)[8][4], const f32x4 (&g)[8], const XItem& x, LAS unsigned char* buf, int wave, int lane) {
    const int nq = (wave & 1) * 64 + lane, kg = wave >> 1;
    LAS unsigned char* d = buf + nq * XP_PITCH + kg * 128;
#pragma unroll
    for (int j = 0; j < 8; ++j) {
        const f32x4 gs = g[j] * x.scale;
        u32x4 o;
#pragma unroll
        for (int i = 0; i < 4; ++i) o[i] = pk4_fp8(v[j][0][i] * gs[0], v[j][1][i] * gs[1], v[j][2][i] * gs[2], v[j][3][i] * gs[3]);
        *(LAS u32x4*)(d + j * 16) = o;
    }
}
__device__ __forceinline__ void xp_store(const XItem& x, const LAS unsigned char* buf, int wave, int lane) {
    const int c = lane & 7;
#pragma unroll
    for (int u = 0; u < 2; ++u) {
        const int nq = (wave * 2 + u) * 8 + (lane >> 3);
        const LAS unsigned char* s = buf + nq * XP_PITCH + c * 16;
        u32x4 r[4];
#pragma unroll
        for (int q = 0; q < 4; ++q) r[q] = *(const LAS u32x4*)(s + q * 128);
#pragma unroll
        for (int i = 0; i < 4; ++i) { const int n = x.n0 + 4 * nq + i; const int row = x.gu ? ((n >> 7) << 8) + (n & 127) + x.upoff : n;
            __builtin_nontemporal_store((u32x4){r[0][i], r[1][i], r[2][i], r[3][i]}, (u32x4*)(x.WT + (size_t)row * x.ldo + x.k0 + 16 * c)); }
    }
}
__device__ __forceinline__ void row_to_bf16(const float* xrow, bf16_t* orow, float* ssq_out, int lane) {
    const f32x4* xr = (const f32x4*)xrow + lane; f32x4 v[8]; float s = 0.f;
#pragma unroll
    for (int j = 0; j < 8; ++j) { v[j] = NTL(xr + 64 * j); s += (v[j][0] * v[j][0] + v[j][1] * v[j][1]) + (v[j][2] * v[j][2] + v[j][3] * v[j][3]); }
    s = wave_sum(s);
    u32x2* o8 = (u32x2*)orow + lane;
#pragma unroll
    for (int j = 0; j < 8; ++j) { u32x2 w; w.x = cvt_pk_bf16(v[j][0], v[j][1]); w.y = cvt_pk_bf16(v[j][2], v[j][3]); o8[64 * j] = w; }
    if (lane == 0) *ssq_out = s;
}

__device__ __forceinline__ void row_to_f8(const float* xrow, unsigned char* orow, float* ssq_out, int lane) {
    const f32x4* xr = (const f32x4*)xrow + lane; f32x4 v[8]; float s = 0.f;
#pragma unroll
    for (int j = 0; j < 8; ++j) { v[j] = NTL(xr + 64 * j); s += (v[j][0] * v[j][0] + v[j][1] * v[j][1]) + (v[j][2] * v[j][2] + v[j][3] * v[j][3]); }
    s = wave_sum(s);
    unsigned* o4 = (unsigned*)orow + lane;
#pragma unroll
    for (int j = 0; j < 8; ++j) o4[64 * j] = pk4_fp8(v[j][0], v[j][1], v[j][2], v[j][3]);
    if (lane == 0) *ssq_out = s;
}

constexpr int KROW = 400, VROW = 144;
constexpr int KBUF = 64 * KROW, VBUF = 128 * VROW;
constexpr int ATT_K0 = 0, ATT_V0 = 2 * KBUF;
static_assert(2 * KBUF + 2 * VBUF <= RING_BYTES, "attention LDS");
__device__ __forceinline__ void mla_attn_unit(LAS unsigned char* lds, const int wave_id, const bf16_t* qb, const bf16_t* kb, const bf16_t* kr, const bf16_t* vT, bf16_t* oatt, fx64* ssq_att, int b, int h, int qblk) {
    int lane_ = lane_id(); asm volatile("" : "+v"(lane_));
    const int wid = wave_id, lane = lane_, tid = wid * 64 + lane, r32 = lane & 31, hi = lane >> 5;
    const int q0 = qblk * 256 + wid * 32;
    const size_t tok0 = (size_t)b * T;
    bf16x8 qf[12];
    { const bf16_t* qrow = qb + (tok0 + q0 + r32) * (NH * DQK) + h * DQK + hi * 8;
#pragma unroll
      for (int ks = 0; ks < 12; ++ks) qf[ks] = *(const bf16x8*)(qrow + ks * 16); }
    const int kn_r0 = tid >> 4, kn_c = tid & 15;
    const int kr_r = tid >> 3, kr_c = tid & 7;
    const int v_r0 = tid >> 3, v_c = tid & 7;
    const bf16_t* gkn = kb + (tok0 + kn_r0) * (NH * DN) + h * DN + kn_c * 8;
    const bf16_t* gkr = kr + (tok0 + kr_r) * DR + kr_c * 8;
    const bf16_t* gv = vT + (size_t)(h * DV + v_r0) * NTOK + tok0 + v_c * 8;
    const int lkn = kn_r0 * KROW + kn_c * 16, lkr = kr_r * KROW + 256 + kr_c * 16, lv = v_r0 * VROW + v_c * 16;
    const int ntiles = 4 * (qblk + 1);
    u32x4 sk0, sk1, skr, sv0, sv1;
#define ATT_LOAD(j) do { const size_t ko = (size_t)(j) * 64; sk0 = *(const u32x4*)(gkn + ko * (NH * DN)); sk1 = *(const u32x4*)(gkn + (ko + 32) * (NH * DN)); \
        skr = *(const u32x4*)(gkr + ko * DR); sv0 = *(const u32x4*)(gv + ko); sv1 = *(const u32x4*)(gv + ko + (size_t)64 * NTOK); } while (0)
#define ATT_WRITE(bufi) do { LAS unsigned char* kbp = lds + ATT_K0 + (bufi) * KBUF; LAS unsigned char* vbp = lds + ATT_V0 + (bufi) * VBUF; \
        *(LAS u32x4*)(kbp + lkn) = sk0; *(LAS u32x4*)(kbp + lkn + 32 * KROW) = sk1; *(LAS u32x4*)(kbp + lkr) = skr; \
        *(LAS u32x4*)(vbp + lv) = sv0; *(LAS u32x4*)(vbp + lv + 64 * VROW) = sv1; } while (0)
    f32x16 o[4];
#pragma unroll
    for (int d = 0; d < 4; ++d)
#pragma unroll
        for (int r = 0; r < 16; ++r) o[d][r] = 0.f;
    float m_run = -1.0e30f, l_run = 0.f;
    ATT_LOAD(0); ATT_WRITE(0);
    __syncthreads();
    for (int j = 0; j < ntiles; ++j) {
        const int buf = j & 1;
        if (j + 1 < ntiles) ATT_LOAD(j + 1);
        const int jrel = j - 4 * qblk;
        if (jrel <= (wid >> 1)) {
            const LAS unsigned char* kp = lds + ATT_K0 + buf * KBUF + r32 * KROW + hi * 16;
            const LAS unsigned char* vp = lds + ATT_V0 + buf * VBUF + r32 * VROW + hi * 16;
            f32x16 s0, s1;
#pragma unroll
            for (int r = 0; r < 16; ++r) { s0[r] = 0.f; s1[r] = 0.f; }
#pragma unroll
            for (int ks = 0; ks < 12; ++ks) { const bf16x8 a0 = *(const LAS bf16x8*)(kp + ks * 32), a1 = *(const LAS bf16x8*)(kp + 32 * KROW + ks * 32);
                s0 = __builtin_amdgcn_mfma_f32_32x32x16_bf16(a0, qf[ks], s0, 0, 0, 0);
                s1 = __builtin_amdgcn_mfma_f32_32x32x16_bf16(a1, qf[ks], s1, 0, 0, 0); }
            if (jrel == (wid >> 1)) {
                const int qrel = (wid & 1) * 32 + r32;
#pragma unroll
                for (int r = 0; r < 16; ++r) { const int kk = (r & 3) + 8 * (r >> 2) + 4 * hi;
                    if (kk > qrel) s0[r] = -1.0e30f; if (kk + 32 > qrel) s1[r] = -1.0e30f; }
            }
            float mx = s0[0];
#pragma unroll
            for (int r = 1; r < 16; ++r) mx = fmaxf(mx, s0[r]);
#pragma unroll
            for (int r = 0; r < 16; ++r) mx = fmaxf(mx, s1[r]);
            mx = fmaxf(mx, __shfl_xor(mx, 32));
            const float mn = fmaxf(m_run, mx), alpha = __builtin_amdgcn_exp2f(m_run - mn); m_run = mn;
            float ps = 0.f;
#pragma unroll
            for (int r = 0; r < 16; ++r) { s0[r] = __builtin_amdgcn_exp2f(s0[r] - mn); s1[r] = __builtin_amdgcn_exp2f(s1[r] - mn); ps += s0[r] + s1[r]; }
            l_run = l_run * alpha + ps;
#pragma unroll
            for (int d = 0; d < 4; ++d)
#pragma unroll
                for (int r = 0; r < 16; ++r) o[d][r] *= alpha;
            bf16x8 pf[4];
#pragma unroll
            for (int s = 0; s < 4; ++s) { const int base = (s & 1) * 8; u32x4 w;
                if (s < 2) { w.x = cvt_pk_bf16(s0[base + 0], s0[base + 1]); w.y = cvt_pk_bf16(s0[base + 2], s0[base + 3]); w.z = cvt_pk_bf16(s0[base + 4], s0[base + 5]); w.w = cvt_pk_bf16(s0[base + 6], s0[base + 7]); }
                else       { w.x = cvt_pk_bf16(s1[base + 0], s1[base + 1]); w.y = cvt_pk_bf16(s1[base + 2], s1[base + 3]); w.z = cvt_pk_bf16(s1[base + 4], s1[base + 5]); w.w = cvt_pk_bf16(s1[base + 6], s1[base + 7]); }
                pf[s] = *(bf16x8*)&w; }
#pragma unroll
            for (int d = 0; d < 4; ++d)
#pragma unroll
                for (int s = 0; s < 4; ++s) { const bf16x8 vf = *(const LAS bf16x8*)(vp + d * 32 * VROW + s * 32);
                    o[d] = __builtin_amdgcn_mfma_f32_32x32x16_bf16(vf, pf[s], o[d], 0, 0, 0); }
        }
        if (j + 1 < ntiles) ATT_WRITE(buf ^ 1);
        __syncthreads();
    }
#undef ATT_LOAD
#undef ATT_WRITE
    const float l = l_run + __shfl_xor(l_run, 32), inv = 1.0f / l;
    float q = 0.f;
    bf16_t* orow = oatt + (tok0 + q0 + r32) * (NH * DV) + h * DV + 4 * hi;
#pragma unroll
    for (int d = 0; d < 4; ++d)
#pragma unroll
        for (int g = 0; g < 4; ++g) { const float a0 = o[d][4 * g] * inv, a1 = o[d][4 * g + 1] * inv, a2 = o[d][4 * g + 2] * inv, a3 = o[d][4 * g + 3] * inv;
            q += (a0 * a0 + a1 * a1) + (a2 * a2 + a3 * a3);
            u32x2 w; w.x = cvt_pk_bf16(a0, a1); w.y = cvt_pk_bf16(a2, a3); *(u32x2*)(orow + d * 32 + g * 8) = w; }
    q += __shfl_xor(q, 32);
    if (hi == 0) fx_add(ssq_att + tok0 + q0 + r32, q);
}

#define ssq_x ((float*)(ws + CTL_SSQ_X))
#define ssq_q ((fx64*)(ws + CTL_SSQ_Q))
#define ssq_kv ((fx64*)(ws + CTL_SSQ_KV))
#define ssq_att ((fx64*)(ws + CTL_SSQ_ATT))
#define ssq_1 ((fx64*)(ws + CTL_SSQ_1))
#define ssq_mem ((float*)(ws + CTL_SSQ_MEM))
#define cnt ((int*)(ws + CTL_CNT))
#define tab ((f32x2*)(ws + WS_TAB))
#define Wrt ((bf16_t*)(ws + WS_WRT))
#define ssq_2 ((fx64*)(ws + CTL_SSQ_2))
#define x2l ((bf16_t*)(ws + A_X2L))
#define x1l ((bf16_t*)(ws + A_X2L))
#define rslab ((float*)(ws + A_SLAB))
#define tok_eid ((int*)(ws + TOK_EID))
#define tok_gw ((float*)(ws + TOK_GW))
#define tok_rank ((int*)(ws + TOK_RANK))
#define tok_dest ((int*)(ws + TOK_DEST))
#define tok_rstd ((float*)(ws + TOK_RSTD))
#define row_tok ((int*)(ws + ROW_TOK))
#define row_rs ((float*)(ws + ROW_RS))
#define row_w ((float*)(ws + ROW_W))
#define Win_t ((bf16_t*)(ws + WS_WIN))
#define Wq_t ((bf16_t*)(ws + WS_WQ))
#define Wkv_t ((bf16_t*)(ws + WS_WKV))
#define Wout_t ((bf16_t*)(ws + WS_WOUT))
#define Wxq_n ((bf16_t*)(ws + WS_WXQ))
#define Wxk_t ((bf16_t*)(ws + WS_WXK))
#define Wxv_t ((bf16_t*)(ws + WS_WXV))
#define Wxo_t ((bf16_t*)(ws + WS_WXO))
#define Wgu_t ((bf16_t*)(ws + WS_WGU))
#define Wd_t ((bf16_t*)(ws + WS_WD))
#define zb ((bf16_t*)(ws + A_ZB))
#define x1b ((bf16_t*)(ws + A_X1B))
#define qx ((bf16_t*)(ws + A_QX))
#define x2b ((bf16_t*)(ws + A_X2B))
#define actb ((bf16_t*)(ws + A_ACT))
#define xb ((bf16_t*)(ws + A_XB))
#define qb ((bf16_t*)(ws + A_QB))
#define ycat ((bf16_t*)(ws + A_YCAT))
#define pbuf ((bf16_t*)(ws + A_PBUF))
#define kb ((bf16_t*)(ws + A_KB))
#define ox ((bf16_t*)(ws + A_OX))
#define vT ((bf16_t*)(ws + A_VT))
#define oatt ((bf16_t*)(ws + A_OATT))
#define memb ((bf16_t*)(ws + A_MEMB))
#define kx ((bf16_t*)(ws + A_KX))
#define vx ((bf16_t*)(ws + A_VXT))
#define Mt ((bf16_t*)(ws + A_MT))
#define VWt ((bf16_t*)(ws + A_VWT))
#define krope ((bf16_t*)(ws + A_KROPE))
#define ybuf ((bf16_t*)(ws + A_YBUF))
#define x2f8 ((unsigned char*)(ws + ARENA + 90 * MiB))
#define x1f8 x2f8
#define Mt8 ((unsigned char*)(ws + A_MT))
#define VWt8 ((unsigned char*)(ws + A_VWT))
#define P8b ((unsigned char*)(ws + A_PBUF))
#define act8 ((unsigned char*)(ws + A_ACT))
#define Wgu8 ((unsigned char*)(ws + WS_WGU))
#define Wd8 ((unsigned char*)(ws + WS_WD))
typedef const __attribute__((address_space(4))) Args* KArgs;
#define PHASE_ARGS() KArgs ka = (KArgs)__builtin_amdgcn_kernarg_segment_ptr(); asm volatile("" : "+s"(ka)); unsigned char* ws = ka->ws
#define PHASE_IDS() int lane_ = lane_id(); asm volatile("" : "+v"(lane_)); const int lane = lane_, wave = wave_id, tid = wave * 64 + lane; \
    const int gw = vcu * NWAVES + wave, NGW = G * NWAVES, gt = vcu * (NWAVES * 64) + tid, NGT = G * NWAVES * 64; (void)lane; (void)gw; (void)NGW; (void)gt; (void)NGT
__global__ void __launch_bounds__(NWAVES * 64, 2) hymba_fwd(Args a_unused) {
    extern __shared__ __attribute__((aligned(16))) unsigned char lds_raw[];
    LAS unsigned char* lds = (LAS unsigned char*)lds_raw;
    volatile LAS unsigned* MISC = (volatile LAS unsigned*)(lds + MISC_OFF);
    const int wave_id = __builtin_amdgcn_readfirstlane(threadIdx.x >> 6);
    const int G = gridDim.x, bx = blockIdx.x;
    const int vcu = (G % 8 == 0) ? (bx % 8) * (G / 8) + bx / 8 : bx;
    unsigned mask; XcdBarrier bar;
    { PHASE_ARGS(); mask = ka->mask; bar.bar = (unsigned*)(ws + WS_CTL); bar.x = 0; bar.st = nullptr; bar.wave = 0; }
    for (int u = wave_id * 64 + lane_id(); u < (LDS_BYTES - TAB_OFF) / 4; u += NWAVES * 64) ((LAS unsigned*)(lds + TAB_OFF))[u] = 0u;
    __syncthreads();
    const bool one_launch = (mask & (mask - 1u)) != 0u;
    if (one_launch) bar = xcd_barrier_post(bar.bar, MISC, wave_id);
#ifndef CT_MASK
#define CT_MASK 0xffffu
#endif
#define IN(k) ((((CT_MASK) >> (k)) & 1u) != 0u && ((mask >> (k)) & 1u) != 0u)
#define SEL(real, dummy) ((ka->flags & 2u) ? (dummy) : (real))
#define DUMMYF ((float*)(ws + WS_DUMMY))
#define SEAM(k) do { if (IN(k) && (mask >> ((k) + 1)) != 0u) xcd_barrier(bar); } while (0)

    if (IN(0)) {
        PHASE_ARGS();
        PHASE_IDS();
        LAS float* scr = (LAS float*)(lds + wave * 16384);
        constexpr int I_IN = 32 * (IN_COLS / 32), I_Q = 8 * 48, I_KV = 4 * 64, I_SQ = 32 * 64;
        constexpr int NITEMS = I_IN + I_Q + I_KV + I_SQ;
        for (int it = gw; it < NITEMS; it += NGW) {
            int r = it;
            if (r < I_IN) { const int nb = r % (IN_COLS / 32), kb_ = r / (IN_COLS / 32); transpose_item<1, true>(ka->w_in, IN_COLS, ka->g_mix, ka->g_mix, DM, Win_t, DM, scr, kb_ * 64, nb * 32, lane); continue; } r -= I_IN;
            if (r < I_Q) { const int nb = r % 48, kb_ = r / 48; transpose_item<2, true>(ka->w_q_up, NH * DQK, ka->g_q_a, ka->g_q_a, QL, Wq_t, QL, scr, kb_ * 64, nb * 32, lane); continue; } r -= I_Q;
            if (r < I_KV) { const int nb = r % 64, kb_ = r / 64; transpose_item<3, true>(ka->w_kv_up, NH * (DN + DV), ka->g_kv_a, ka->g_kv_a, KVL, Wkv_t, KVL, scr, kb_ * 64, nb * 32, lane); continue; } r -= I_KV;
            { const int nb = r % 64, kb_ = r / 64; transpose_item<0, true>(ka->w_out, DM, ka->g_conv_out, ka->g_attn_out, CW, Wout_t, DM, scr, kb_ * 64, nb * 32, lane); }
        }
        for (int m = gw; m < NTOK; m += NGW) row_to_bf16(ka->x + (size_t)m * DM, xb + (size_t)m * DM, ssq_x + m, lane);
        for (int m = gw; m < NMEM; m += NGW) row_to_f8(ka->mem + (size_t)m * DM, (unsigned char*)memb + (size_t)m * DM, ssq_mem + m, lane);
        for (int i = gt; i < NTOK * 32; i += NGT) { const int tok = i >> 5, p = i & 31;
            const float inv_freq = 1.0f / powf(10000.0f, (float)(2 * p) / 64.0f), ang = (float)ka->pos[tok] * inv_freq;
            tab[i] = (f32x2){cosf(ang), sinf(ang)}; }
        for (int i = gt; i < DM * DM / 8; i += NGT) { const int cr = i / (DM / 8); const float g = ka->g_xattn[cr]; const f32x4 p0 = NTL((const f32x4*)ka->w_xq + 2 * i) * g, p1 = NTL((const f32x4*)ka->w_xq + 2 * i + 1) * g;
            const f32x4 q0 = p0 * F8_SX, q1 = p1 * F8_SX; u32x2 w; w.x = pk4_fp8(q0[0], q0[1], q0[2], q0[3]); w.y = pk4_fp8(q1[0], q1[1], q1[2], q1[3]); ((u32x2*)Wxq_n)[i] = w; }
        for (int i = gt; i < 256 * DM; i += NGT) { const int n = i / DM, k = i % DM; unsigned a0 = 0u, a1 = 0u;
            const int c = (n < NRT) ? n : ((n >= 128 && n < 128 + NRT) ? n - 128 : -1);
            if (c >= 0) { const float w = ka->g_moe[k] * (c < NG ? ka->w_group[(size_t)k * NG + c] : ka->w_router[(size_t)k * NE + (c - NG)]);
                const unsigned hb = cvt_pk_bf16(w, 0.f) & 0xffffu;
                if (n < 128) { a0 = hb; a1 = hb; } else { a0 = cvt_pk_bf16(w - bf_lo(hb), 0.f) & 0xffffu; } }
            Wrt[(size_t)n * (2 * DM) + k] = (bf16_t)a0; Wrt[(size_t)n * (2 * DM) + DM + k] = (bf16_t)a1; }
        for (int i = gt; i < (ZC - IN_COLS) * DM / 8; i += NGT) ((u32x4*)(Win_t + (size_t)IN_COLS * DM))[i] = (u32x4){0u, 0u, 0u, 0u};
    }
    SEAM(0);

    if (IN(1)) {
        PHASE_ARGS();
        PHASE_IDS();
        auto xp_all = [&]() {
            constexpr int NX = 2048 + 1024 + 192;
            auto xitem = [&](int it) -> XItem { XItem x;
                if (it < 2048) { const int e = it >> 5, up = (it >> 4) & 1, kb_ = it & 15;
                    x.W = (up ? ka->w_up : ka->w_gate) + (size_t)e * DM * DE; x.gain = ka->g_moe; x.WT = Wgu8 + (size_t)e * 1024 * DM; x.ldw = DE; x.ldo = DM; x.k0 = kb_ * 128; x.n0 = 0; x.gu = 1; x.upoff = up * 128; x.scale = F8_SW; }
                else if (it < 3072) { const int r = it - 2048, e = r >> 4, kb_ = (r >> 2) & 3, nb = r & 3;
                    x.W = ka->w_down + (size_t)e * DE * DM; x.gain = nullptr; x.WT = Wd8 + (size_t)e * DM * DE; x.ldw = DM; x.ldo = DE; x.k0 = kb_ * 128; x.n0 = nb * 512; x.gu = 0; x.upoff = 0; x.scale = F8_SD; }
                else { const int r = it - 3072, which = r >> 6, kb_ = (r >> 2) & 15, nb = r & 3;
                    x.W = which == 0 ? ka->w_xk : (which == 1 ? ka->w_xv : ka->w_xo); x.gain = which < 2 ? ka->g_mem : nullptr;
                    x.WT = which == 0 ? (unsigned char*)Wxk_t : (which == 1 ? (unsigned char*)Wxv_t : (unsigned char*)Wxo_t); x.ldw = DM; x.ldo = DM; x.k0 = kb_ * 128; x.n0 = nb * 512; x.gu = 0; x.upoff = 0; x.scale = F8_SX; }
                return x; };
            f32x4 v[8][4], gq[8];
            int it = vcu, b = 0;
            XItem cur = xitem(it < NX ? it : 0);
            if (it < NX) xp_load(v, gq, cur, wave, lane);
            while (it < NX) {
                LAS unsigned char* buf = lds + b * XP_BUF;
                xp_pack(v, gq, cur, buf, wave, lane);
                const int nit = it + G;
                XItem nxt = xitem(nit < NX ? nit : 0);
                if (nit < NX) xp_load(v, gq, nxt, wave, lane);
                __syncthreads();
                xp_store(cur, buf, wave, lane);
                cur = nxt; it = nit; b ^= 1;
            }
            __syncthreads();
        };
        const bool late = ((bx >> 3) & 1) != 0;
        if (!late) xp_all();
        {
            pg8::DenseSched S; S.init(xb, Win_t, DM, DM, NTOK, ZC, G, bx);
            EpiZ E{zb, krope, ssq_x, SEL(ssq_q, (fx64*)DUMMYF), SEL(ssq_kv, (fx64*)DUMMYF + NTOK), tab};
            pg8::gemm_phase<EpiZ, pg8::DenseSched, false>(lds, wave_id, DM, DM, DM, S, E);
        }
        if (late) { __syncthreads(); xp_all(); }
    }
    SEAM(1);

    if (IN(2)) {
        PHASE_ARGS();
        const bool deal = (G == 256);
        const int grp = deal ? (bx >> 6) : -1, c6 = deal ? (bx & 63) : bx, g6 = deal ? 64 : G, gL = g6, cL = c6;
        if (!deal || grp == 0) { pg8::DenseSched S; S.init(memb, Wxk_t, DM, DM, NMEM, DM, gL, cL); S.es = 1; EpiF8Rms E{(unsigned char*)kx, DM, ssq_mem, 1.0f / DM, 1.0f / F8_SX};
          pg8::gemm_phase<EpiF8Rms, pg8::DenseSched, false, 1>(lds, wave_id, DM, DM, DM, S, E); }
        if (!deal || grp == 1) { pg8::DenseSched S; S.init(memb, Wxv_t, DM, DM, NMEM, DM, gL, cL); S.es = 1; EpiF8Rms E{(unsigned char*)vx, DM, ssq_mem, 1.0f / DM, 1.0f / F8_SX};
          pg8::gemm_phase<EpiF8Rms, pg8::DenseSched, false, 1>(lds, wave_id, DM, DM, DM, S, E); }
        { pg8::DenseSched S; S.init(zb + C_Q, Wq_t, ZC, QL, NTOK, NH * DQK, deal ? 128 : G, deal ? (bx & 127) : bx, 0, deal ? (grp >= 2 ? 384 : 0) : -1); EpiQ E{qb, ssq_q, tab};
          pg8::gemm_phase<EpiQ, pg8::DenseSched, false>(lds, wave_id, QL, ZC, QL, S, E); }
        { const int f = grp == 1 ? 128 : (grp == 2 ? 192 : 0), n = grp == 0 ? 128 : ((grp == 1 || grp == 2) ? 64 : 0);
          pg8::DenseSched S; S.init(zb + C_KV, Wkv_t, ZC, KVL, NTOK, NH * DN, g6, c6, deal ? f : 0, deal ? n : -1); EpiBf16<3> E{kb, NH * DN, (const float*)ssq_kv, 1.0f / KVL, 1.0f};
          pg8::gemm_phase<EpiBf16<3>, pg8::DenseSched, false>(lds, wave_id, KVL, ZC, KVL, S, E); }
        { const int f = grp == 1 ? 64 : (grp == 3 ? 192 : 0), n = grp == 0 ? 64 : (grp == 1 ? 128 : (grp == 3 ? 64 : 0));
          pg8::DenseSched S; S.init(Wkv_t + (size_t)NH * DN * KVL, zb + C_KV, KVL, ZC, NH * DV, NTOK, g6, c6, deal ? f : 0, deal ? n : -1); EpiColScale<true> E{vT, NTOK, ssq_kv, 1.0f / KVL};
          pg8::gemm_phase<EpiColScale<true>, pg8::DenseSched, false>(lds, wave_id, KVL, KVL, ZC, S, E); }
    }
    SEAM(2);

    if (IN(3)) {
        PHASE_ARGS();
        PHASE_IDS();
        auto conv_rows = [&]() {
            float wc0[2][8], wc1[2][8], wc2[2][8];
#pragma unroll
            for (int g = 0; g < 2; ++g)
#pragma unroll
                for (int e = 0; e < 8; ++e) { const int c = g * 512 + lane * 8 + e; wc0[g][e] = ka->w_conv[c]; wc1[g][e] = ka->w_conv[CW + c]; wc2[g][e] = ka->w_conv[2 * CW + c]; }
            for (int ch = gw; ch < NTOK / 8; ch += NGW) {
                const int t0 = ch * 8, tl = t0 & (T - 1);
                float u1[2][8], u2[2][8];
#pragma unroll
                for (int g = 0; g < 2; ++g) { const int c = g * 512 + lane * 8;
                    if (tl >= 1) { const u32x4 cg = *(const u32x4*)(zb + (size_t)(t0 - 1) * ZC + CW + c), hg = *(const u32x4*)(zb + (size_t)(t0 - 1) * ZC + 2 * CW + c);
#pragma unroll
                        for (int e = 0; e < 4; ++e) { u1[g][2 * e] = bf_lo(cg[e]) * bf_lo(hg[e]); u1[g][2 * e + 1] = bf_hi(cg[e]) * bf_hi(hg[e]); } }
                    else {
#pragma unroll
                        for (int e = 0; e < 8; ++e) u1[g][e] = 0.f; }
                    if (tl >= 2) { const u32x4 cg = *(const u32x4*)(zb + (size_t)(t0 - 2) * ZC + CW + c), hg = *(const u32x4*)(zb + (size_t)(t0 - 2) * ZC + 2 * CW + c);
#pragma unroll
                        for (int e = 0; e < 4; ++e) { u2[g][2 * e] = bf_lo(cg[e]) * bf_lo(hg[e]); u2[g][2 * e + 1] = bf_hi(cg[e]) * bf_hi(hg[e]); } }
                    else {
#pragma unroll
                        for (int e = 0; e < 8; ++e) u2[g][e] = 0.f; } }
                for (int rp = 0; rp < 8; rp += 2) {
                    u32x4 bg[2][2], cg[2][2], hg[2][2];
#pragma unroll
                    for (int rr = 0; rr < 2; ++rr)
#pragma unroll
                        for (int g = 0; g < 2; ++g) { const size_t row = (size_t)(t0 + rp + rr); const int c = g * 512 + lane * 8;
                            bg[rr][g] = NTL((const u32x4*)(zb + row * ZC + c)); cg[rr][g] = NTL((const u32x4*)(zb + row * ZC + CW + c)); hg[rr][g] = NTL((const u32x4*)(zb + row * ZC + 2 * CW + c)); }
#pragma unroll
                    for (int rr = 0; rr < 2; ++rr) { const size_t row = (size_t)(t0 + rp + rr);
                        float y[2][8]; float q = 0.f;
#pragma unroll
                        for (int g = 0; g < 2; ++g) {
#pragma unroll
                            for (int e = 0; e < 8; ++e) { const float bb = (e & 1) ? bf_hi(bg[rr][g][e >> 1]) : bf_lo(bg[rr][g][e >> 1]), cc = (e & 1) ? bf_hi(cg[rr][g][e >> 1]) : bf_lo(cg[rr][g][e >> 1]), hh = (e & 1) ? bf_hi(hg[rr][g][e >> 1]) : bf_lo(hg[rr][g][e >> 1]);
                                const float u0 = cc * hh, cv = wc0[g][e] * u2[g][e] + wc1[g][e] * u1[g][e] + wc2[g][e] * u0;
                                y[g][e] = bb * cv; q += y[g][e] * y[g][e]; u2[g][e] = u1[g][e]; u1[g][e] = u0; } }
                        q = wave_sum(q);
                        const float rs = 1.0f / sqrtf(q * (1.0f / CW) + EPS);
#pragma unroll
                        for (int g = 0; g < 2; ++g) { const int c = g * 512 + lane * 8;
                            u32x4 w; w.x = cvt_pk_bf16(y[g][0] * rs, y[g][1] * rs); w.y = cvt_pk_bf16(y[g][2] * rs, y[g][3] * rs); w.z = cvt_pk_bf16(y[g][4] * rs, y[g][5] * rs); w.w = cvt_pk_bf16(y[g][6] * rs, y[g][7] * rs);
                            *(u32x4*)(ycat + row * DM + c) = w; } }
                }
            }
        };
        const bool late = ((bx >> 3) & 1) != 0;
        if (!late) conv_rows();
        for (int pp = vcu; pp < NB * NH * 4; pp += G) { const int b = pp >> 5, h = (pp >> 2) & 7, ip = pp & 3;
            mla_attn_unit(lds, wave_id, qb, kb, krope, vT, oatt, SEL(ssq_att, (fx64*)DUMMYF), b, h, 7 - ip);
            mla_attn_unit(lds, wave_id, qb, kb, krope, vT, oatt, SEL(ssq_att, (fx64*)DUMMYF), b, h, ip); }
        if (late) conv_rows();
    }
    SEAM(3);

    if (IN(4)) {
        PHASE_ARGS();
        PHASE_IDS();
        for (int ch = gw; ch < NTOK / 4; ch += NGW) {
            u32x4 og[4][2]; float ra[4];
#pragma unroll
            for (int rr = 0; rr < 4; ++rr) { const size_t row = (size_t)ch * 4 + rr;
#pragma unroll
                for (int g = 0; g < 2; ++g) og[rr][g] = NTL((const u32x4*)(oatt + row * (NH * DV) + g * 512 + lane * 8));
                ra[rr] = 1.0f / sqrtf(fx_get(ssq_att + row) * (1.0f / (NH * DV)) + EPS); }
#pragma unroll
            for (int rr = 0; rr < 4; ++rr) { const size_t row = (size_t)ch * 4 + rr;
#pragma unroll
                for (int g = 0; g < 2; ++g) { u32x4 w2;
#pragma unroll
                    for (int e = 0; e < 4; ++e) w2[e] = cvt_pk_bf16(bf_lo(og[rr][g][e]) * ra[rr], bf_hi(og[rr][g][e]) * ra[rr]);
                    *(u32x4*)(ycat + row * DM + CW + g * 512 + lane * 8) = w2; } }
        }
    }
    SEAM(4);

    if (IN(5)) {
        PHASE_ARGS();
        const bool late = ((bx >> 3) & 1) != 0;
        if (late) {
    #if XATT_FP8
            { MtSched S{(const char*)kx, (const char*)Wxq_n, G, vcu, 1}; EpiF8 E{Mt8, DM, F8_SM * LOG2E * 0.04419417382415922f / F8_SX};
              pg8::gemm_phase<EpiF8, MtSched, false, 1>(lds, wave_id, XD, DM, DM, S, E); }
            { VWtSched S{(const char*)Wxo_t, (const char*)vx, G, vcu, 1}; EpiF8 E{VWt8, XH * MEM, F8_SV / F8_SX};
              pg8::gemm_phase<EpiF8, VWtSched, false, 1>(lds, wave_id, XD, DM, DM, S, E); }
    #else
            { MtSched S{(const char*)kx, (const char*)Wxq_n, G, vcu, 2}; EpiBf16<0> E{Mt, DM, nullptr, 0.f, LOG2E * 0.04419417382415922f};
              pg8::gemm_phase<EpiBf16<0>, MtSched, false>(lds, wave_id, XD, DM, DM, S, E); }
            { VWtSched S{(const char*)Wxo_t, (const char*)vx, G, vcu, 2}; EpiBf16<0> E{VWt, XH * MEM, nullptr, 0.f, 1.0f};
              pg8::gemm_phase<EpiBf16<0>, VWtSched, false>(lds, wave_id, XD, DM, DM, S, E); }
    #endif
        }
        {
            pg8::DenseSched S; S.init(ycat, Wout_t, DM, DM, NTOK, DM, G, bx);
            EpiResidHL<true> E{ka->x, nullptr, nullptr, x1b, x1l, SEL(ssq_1, (fx64*)DUMMYF), XATT_FP8 ? x1f8 : nullptr, 1.0f};
            pg8::gemm_phase<EpiResidHL<true>, pg8::DenseSched, false>(lds, wave_id, DM, DM, DM, S, E);
        }
        if (!late) {
    #if XATT_FP8
            { MtSched S{(const char*)kx, (const char*)Wxq_n, G, vcu, 1}; EpiF8 E{Mt8, DM, F8_SM * LOG2E * 0.04419417382415922f / F8_SX};
              pg8::gemm_phase<EpiF8, MtSched, false, 1>(lds, wave_id, XD, DM, DM, S, E); }
            { VWtSched S{(const char*)Wxo_t, (const char*)vx, G, vcu, 1}; EpiF8 E{VWt8, XH * MEM, F8_SV / F8_SX};
              pg8::gemm_phase<EpiF8, VWtSched, false, 1>(lds, wave_id, XD, DM, DM, S, E); }
    #else
            { MtSched S{(const char*)kx, (const char*)Wxq_n, G, vcu, 2}; EpiBf16<0> E{Mt, DM, nullptr, 0.f, LOG2E * 0.04419417382415922f};
              pg8::gemm_phase<EpiBf16<0>, MtSched, false>(lds, wave_id, XD, DM, DM, S, E); }
            { VWtSched S{(const char*)Wxo_t, (const char*)vx, G, vcu, 2}; EpiBf16<0> E{VWt, XH * MEM, nullptr, 0.f, 1.0f};
              pg8::gemm_phase<EpiBf16<0>, VWtSched, false>(lds, wave_id, XD, DM, DM, S, E); }
    #endif
        }
    }
    SEAM(5);

    if (IN(7)) {
        PHASE_ARGS();
#if XATT_FP8
        CrossSSched S{(const char*)x1f8, (const char*)Mt8, G, vcu, 1};
        EpiSoftmax E{pbuf, XH * MEM, (LAS float*)(lds + EPI_OFF), (LAS float*)(lds + EPI_OFF + 4096), ssq_1, 1.0f / DM, 1.0f / F8_SM, P8b};
        pg8::gemm_phase<EpiSoftmax, CrossSSched, false, 1>(lds, wave_id, DM, DM, DM, S, E);
#else
        CrossSSched S{(const char*)x1b, (const char*)Mt, G, vcu, 2};
        EpiSoftmax E{pbuf, XH * MEM, (LAS float*)(lds + EPI_OFF), (LAS float*)(lds + EPI_OFF + 4096), ssq_1, 1.0f / DM, 1.0f, nullptr};
        pg8::gemm_phase<EpiSoftmax, CrossSSched, false>(lds, wave_id, DM, DM, DM, S, E);
#endif
    }
    SEAM(7);

    if (IN(9)) {
        PHASE_ARGS();
        { PHASE_IDS(); for (int i = gt; i < DM / 8; i += NGT) ((u32x4*)(x2b + (size_t)NTOK * DM))[i] = (u32x4){0u, 0u, 0u, 0u};
          if (MOE_FP8) for (int i = gt; i < DM / 16; i += NGT) ((u32x4*)(x2f8 + (size_t)NTOK * DM))[i] = (u32x4){0u, 0u, 0u, 0u}; }
#if XATT_FP8
        CrossOSched S{(const char*)P8b, (const char*)VWt8, G, vcu, 1};
        EpiResidHL<false> E{nullptr, x1b, x1l, SEL(x2b, (bf16_t*)DUMMYF), SEL(x2l, (bf16_t*)DUMMYF + (size_t)NTOK * DM), SEL(ssq_2, (fx64*)DUMMYF), MOE_FP8 ? x2f8 : nullptr, 1.0f / (F8_SP * F8_SV)};
        pg8::gemm_phase<EpiResidHL<false>, CrossOSched, false, 1>(lds, wave_id, XH * MEM, XH * MEM, XH * MEM, S, E);
#else
        CrossOSched S{(const char*)pbuf, (const char*)VWt, G, vcu, 2};
        EpiResidHL<false> E{nullptr, x1b, x1l, SEL(x2b, (bf16_t*)DUMMYF), SEL(x2l, (bf16_t*)DUMMYF + (size_t)NTOK * DM), SEL(ssq_2, (fx64*)DUMMYF), MOE_FP8 ? x2f8 : nullptr, 1.0f};
        pg8::gemm_phase<EpiResidHL<false>, CrossOSched, false>(lds, wave_id, XH * MEM, XH * MEM, XH * MEM, S, E);
#endif
    }
    SEAM(9);

    if (IN(10)) {
        PHASE_ARGS();
        RouterSched S{(const char*)x2b, (const char*)x2l, (const char*)Wrt, G, bx};
        EpiRouter E{rslab};
        pg8::gemm_phase<EpiRouter, RouterSched, false>(lds, wave_id, 1024, DM, 2 * DM, S, E);
    }
    SEAM(10);

    if (IN(11)) {
        PHASE_ARGS();
        PHASE_IDS();
        for (int i = gt; i < LROWS; i += NGT) { row_tok[i] = NTOK; row_rs[i] = 0.f; row_w[i] = 0.f; }
        for (int tok = gt; tok < NTOK; tok += NGT) {
            const float rstd = 1.0f / sqrtf(fx_get(ssq_2 + tok) * (1.0f / DM) + EPS);
            f32x4 g0 = (f32x4){0.f, 0.f, 0.f, 0.f}, g1 = g0;
#pragma unroll
            for (int kq = 0; kq < 4; ++kq) { const float* p = rslab + ((size_t)kq * NTOK + tok) * 96; g0 += *(const f32x4*)p; g1 += *(const f32x4*)(p + 4); }
            float gl[8] = {g0[0], g0[1], g0[2], g0[3], g1[0], g1[1], g1[2], g1[3]};
#pragma unroll
            for (int j = 0; j < 8; ++j) gl[j] = gl[j] * rstd + ka->b_group[j];
            int gi = 0; float gm = gl[0];
#pragma unroll
            for (int j = 1; j < 8; ++j) if (gl[j] > gm) { gm = gl[j]; gi = j; }
            float gs = 0.f;
#pragma unroll
            for (int j = 0; j < 8; ++j) gs += __expf(gl[j] - gm);
            const float gp = 1.0f / gs;
            f32x4 e0 = (f32x4){0.f, 0.f, 0.f, 0.f}, e1v = e0;
#pragma unroll
            for (int kq = 0; kq < 4; ++kq) { const float* p = rslab + ((size_t)kq * NTOK + tok) * 96 + NG + gi * 8; e0 += *(const f32x4*)p; e1v += *(const f32x4*)(p + 4); }
            const f32x4 b0 = *(const f32x4*)(ka->b_router + gi * 8), b1 = *(const f32x4*)(ka->b_router + gi * 8 + 4);
            float el[8] = {e0[0], e0[1], e0[2], e0[3], e1v[0], e1v[1], e1v[2], e1v[3]};
            const float bl[8] = {b0[0], b0[1], b0[2], b0[3], b1[0], b1[1], b1[2], b1[3]};
#pragma unroll
            for (int j = 0; j < 8; ++j) el[j] = el[j] * rstd + bl[j];
            int i1 = 0; float e1 = el[0];
#pragma unroll
            for (int j = 1; j < 8; ++j) if (el[j] > e1) { e1 = el[j]; i1 = j; }
            int i2 = 0; float e2 = -3.0e38f;
#pragma unroll
            for (int j = 0; j < 8; ++j) if (j != i1 && el[j] > e2) { e2 = el[j]; i2 = j; }
            const float t1 = 1.0f / (1.0f + __expf(e2 - e1)), t2 = 1.0f - t1;
            if (!(ka->flags & 2u)) { const int E1 = gi * 8 + i1, E2 = gi * 8 + i2;
                const int k1 = atomicAdd(cnt + E1, 1), k2 = atomicAdd(cnt + E2, 1);
                tok_eid[2 * tok] = E1; tok_eid[2 * tok + 1] = E2; tok_gw[2 * tok] = gp * t1; tok_gw[2 * tok + 1] = gp * t2; tok_rank[2 * tok] = k1; tok_rank[2 * tok + 1] = k2; tok_rstd[tok] = rstd; }
        }
    }
    SEAM(11);

    LAS int* t_start = (LAS int*)(lds + TAB_OFF); LAS int* t_blk = t_start + 64;
    if (IN(12) || IN(13) || IN(14)) {
        PHASE_ARGS();
        if (wave_id == 0 && lane_id() == 0) { int s = 0; for (int e = 0; e < NE; ++e) { const int c = __hip_atomic_load(cnt + e, __ATOMIC_RELAXED, __HIP_MEMORY_SCOPE_AGENT), nb = (c + 255) >> 8; t_start[e] = s * 256; for (int k = 0; k < nb; ++k) t_blk[s + k] = e; s += nb; }
            MISC[8] = (unsigned)s; }
        __syncthreads();
    }
    const int nblk = (int)MISC[8];

    if (IN(12)) {
        PHASE_ARGS();
        PHASE_IDS();
        for (int s = gt; s < NTOK * 2; s += NGT) { const int tok = s >> 1, e = tok_eid[s], d = t_start[e] + tok_rank[s];
            row_tok[d] = tok; row_rs[d] = tok_rstd[tok]; row_w[d] = tok_gw[s]; tok_dest[s] = d; }
    }
    SEAM(12);

    if (IN(13)) {
        PHASE_ARGS();
#if MOE_FP8
        MoeSched S{(const char*)x2f8, (const char*)Wgu8, row_tok, t_blk, nblk * 4, 2, G, vcu, 0, (size_t)1024 * DM, (size_t)256 * DM, 128, (unsigned)DM};
        EpiGateUp8 E{act8, row_rs};
        pg8::gemm_phase<EpiGateUp8, MoeSched, true, 1>(lds, wave_id, DM, DM, DM, S, E);
#else
        MoeSched S{(const char*)x2b, (const char*)Wgu_t, row_tok, t_blk, nblk * 4, 2, G, vcu, 0, (size_t)1024 * DM * 2, (size_t)256 * DM * 2, 128, (unsigned)(DM * 2)};
        EpiGateUp E{actb, row_rs};
        pg8::gemm_phase<EpiGateUp, MoeSched, true>(lds, wave_id, DM, DM, DM, S, E);
#endif
    }
    SEAM(13);

    if (IN(14)) {
        PHASE_ARGS();
#if MOE_FP8
        MoeSched S{(const char*)act8, (const char*)Wd8, row_tok, t_blk, nblk * 8, 3, G, vcu, (size_t)256 * DE, (size_t)DM * DE, (size_t)256 * DE, 256, 0u};
        EpiF8Row E{(unsigned char*)ybuf, DM, row_w, F8_SY / (F8_SACT * F8_SD)};
        pg8::gemm_phase<EpiF8Row, MoeSched, false, 1>(lds, wave_id, DE, DE, DE, S, E);
#else
        MoeSched S{(const char*)actb, (const char*)Wd_t, row_tok, t_blk, nblk * 8, 3, G, vcu, (size_t)256 * DE * 2, (size_t)DM * DE * 2, (size_t)256 * DE * 2, 256, 0u};
        EpiBf16<2> E{ybuf, DM, row_w, 0.f, 1.0f};
        pg8::gemm_phase<EpiBf16<2>, MoeSched, false>(lds, wave_id, DE, DE, DE, S, E);
#endif
    }
    SEAM(14);

    if (IN(15)) {
        PHASE_ARGS();
        PHASE_IDS();
        for (int m = gw; m < NTOK; m += NGW) {
            f32x4* xr = (f32x4*)(ka->out + (size_t)m * DM) + lane; f32x4 v[8]; float s = 0.f;
            const u32x2* xh_ = (const u32x2*)(x2b + (size_t)m * DM) + lane; const u32x2* xl_ = (const u32x2*)(x2l + (size_t)m * DM) + lane;
            const bool moe = (ka->flags & 1u) != 0u;
            const int d0 = moe ? tok_dest[2 * m] : 0, d1 = moe ? tok_dest[2 * m + 1] : 0;
#if MOE_FP8
            const unsigned* y0 = (const unsigned*)((const unsigned char*)ybuf + (size_t)d0 * DM) + lane; const unsigned* y1 = (const unsigned*)((const unsigned char*)ybuf + (size_t)d1 * DM) + lane;
#else
            const u32x2* y0 = (const u32x2*)(ybuf + (size_t)d0 * DM) + lane; const u32x2* y1 = (const u32x2*)(ybuf + (size_t)d1 * DM) + lane;
#endif
#pragma unroll
            for (int j = 0; j < 8; ++j) { const u32x2 h = NTL(xh_ + 64 * j), l = NTL(xl_ + 64 * j);
                v[j] = (f32x4){bf_lo(h.x) + bf_lo(l.x), bf_hi(h.x) + bf_hi(l.x), bf_lo(h.y) + bf_lo(l.y), bf_hi(h.y) + bf_hi(l.y)};
#if MOE_FP8
                if (moe) { const int p0 = (int)NTL(y0 + 64 * j), p1 = (int)NTL(y1 + 64 * j);
                    const f32x2 a0 = __builtin_amdgcn_cvt_pk_f32_fp8(p0, false), a1 = __builtin_amdgcn_cvt_pk_f32_fp8(p0, true), b0 = __builtin_amdgcn_cvt_pk_f32_fp8(p1, false), b1 = __builtin_amdgcn_cvt_pk_f32_fp8(p1, true);
                    v[j][0] += (a0.x + b0.x) * (1.0f / F8_SY); v[j][1] += (a0.y + b0.y) * (1.0f / F8_SY); v[j][2] += (a1.x + b1.x) * (1.0f / F8_SY); v[j][3] += (a1.y + b1.y) * (1.0f / F8_SY); }
#else
                if (moe) { const u32x2 p0 = y0[64 * j], p1 = y1[64 * j];
                    v[j][0] += bf_lo(p0.x) + bf_lo(p1.x); v[j][1] += bf_hi(p0.x) + bf_hi(p1.x); v[j][2] += bf_lo(p0.y) + bf_lo(p1.y); v[j][3] += bf_hi(p0.y) + bf_hi(p1.y); }
#endif
                s += (v[j][0] * v[j][0] + v[j][1] * v[j][1]) + (v[j][2] * v[j][2] + v[j][3] * v[j][3]); }
            s = wave_sum(s); const float rs = 1.0f / sqrtf(s * (1.0f / DM) + EPS);
            const f32x4* gf = (const f32x4*)ka->g_final + lane;
#pragma unroll
            for (int j = 0; j < 8; ++j) NTS(v[j] * rs * gf[64 * j], xr + 64 * j);
        }
    }
#undef IN
#undef SEAM
}

extern "C" void kernel_launch(void* const* d_in, const int* in_sizes, int n_in, void* d_out, int out_size, void* d_ws, size_t ws_size, hipStream_t stream) {
    static int grid = 0;
    if (grid == 0) {
        if (n_in != 28 || out_size != NTOK * DM || ws_size < WS_NEED) { fprintf(stderr, "kernel_launch: unexpected shapes (n_in %d, out %d, ws %zu < %zu)\n", n_in, out_size, ws_size, (size_t)WS_NEED); grid = -1; return; }
        int dev = 0, cus = 0, per_cu = 0;
        if (hipGetDevice(&dev) != hipSuccess || hipDeviceGetAttribute(&cus, hipDeviceAttributeMultiprocessorCount, dev) != hipSuccess) { grid = -1; return; }
        if (hipFuncSetAttribute((const void*)hymba_fwd, hipFuncAttributeMaxDynamicSharedMemorySize, LDS_BYTES) != hipSuccess) { fprintf(stderr, "kernel_launch: hipFuncSetAttribute failed\n"); grid = -1; return; }
        if (hipOccupancyMaxActiveBlocksPerMultiprocessor(&per_cu, (const void*)hymba_fwd, NWAVES * 64, LDS_BYTES) != hipSuccess || per_cu < 1) { fprintf(stderr, "kernel_launch: occupancy query says %d\n", per_cu); (void)hipGetLastError(); grid = -1; return; }
        grid = cus;
    }
    if (grid < 0) return;
    (void)hipMemsetAsync((char*)d_ws + WS_CTL, 0, CTL_BYTES, stream);
    Args a{};
    a.x = (const float*)d_in[0]; a.mem = (const float*)d_in[1]; a.pos = (const int*)d_in[2]; a.g_mix = (const float*)d_in[3]; a.w_in = (const float*)d_in[4]; a.w_conv = (const float*)d_in[5];
    a.g_q_a = (const float*)d_in[6]; a.w_q_up = (const float*)d_in[7]; a.g_kv_a = (const float*)d_in[8]; a.w_kv_up = (const float*)d_in[9]; a.g_conv_out = (const float*)d_in[10]; a.g_attn_out = (const float*)d_in[11];
    a.w_out = (const float*)d_in[12]; a.g_xattn = (const float*)d_in[13]; a.g_mem = (const float*)d_in[14]; a.w_xq = (const float*)d_in[15]; a.w_xk = (const float*)d_in[16]; a.w_xv = (const float*)d_in[17]; a.w_xo = (const float*)d_in[18];
    a.g_moe = (const float*)d_in[19]; a.w_group = (const float*)d_in[20]; a.b_group = (const float*)d_in[21]; a.w_router = (const float*)d_in[22]; a.b_router = (const float*)d_in[23];
    a.w_gate = (const float*)d_in[24]; a.w_up = (const float*)d_in[25]; a.w_down = (const float*)d_in[26]; a.g_final = (const float*)d_in[27];
    a.out = (float*)d_out; a.ws = (unsigned char*)d_ws;
    a.flags = ((PH_MASK >> 14) & 1u) ? 1u : 0u;
#if N_LAUNCH_SPLIT
    for (int p = 0; p < 16; ++p) { if (!((PH_MASK >> p) & 1u)) continue; a.mask = 1u << p;
        if ((DUP_MASK >> p) & 1u) { a.flags |= 2u; for (int rep_ = 0; rep_ < DUP_COUNT; ++rep_) hipLaunchKernelGGL(hymba_fwd, dim3(grid), dim3(NWAVES * 64), LDS_BYTES, stream, a); a.flags &= ~2u; }
        hipLaunchKernelGGL(hymba_fwd, dim3(grid), dim3(NWAVES * 64), LDS_BYTES, stream, a); }
#else
    a.mask = PH_MASK;
    hipLaunchKernelGGL(hymba_fwd, dim3(grid), dim3(NWAVES * 64), LDS_BYTES, stream, a);
#endif
}
```

```cpp
#include <hip/hip_runtime.h>
#include <cstdio>
#include <cstdint>

#define LAS __attribute__((address_space(3)))
typedef unsigned short bf16_t;
typedef short bf16x8 __attribute__((ext_vector_type(8)));
typedef float f32x2 __attribute__((ext_vector_type(2)));
typedef float f32x4 __attribute__((ext_vector_type(4)));
typedef float f32x16 __attribute__((ext_vector_type(16)));
typedef unsigned u32x2 __attribute__((ext_vector_type(2)));
typedef unsigned u32x4 __attribute__((ext_vector_type(4)));

#ifndef PH_MASK
#define PH_MASK 0xfebfu
#endif
#ifndef DUP_MASK
#define DUP_MASK 0u
#endif
#ifndef DUP_COUNT
#define DUP_COUNT 1
#endif
#ifndef MOE_FP8
#define MOE_FP8 1
#endif
#ifndef XATT_FP8
#define XATT_FP8 1
#endif
#ifndef N_LAUNCH_SPLIT
#define N_LAUNCH_SPLIT 0
#endif

constexpr int NB = 8, T = 2048, DM = 2048, NTOK = NB * T;
constexpr int MEM = 256, NMEM = NB * MEM;
constexpr int CW = 1024;
constexpr int NH = 8, DN = 128, DR = 64, DV = 128, DQK = DN + DR;
constexpr int QL = 512, KVL = 256;
constexpr int ZC = 4096;
constexpr int C_Q = 3072, C_KV = 3584, C_KR = 3840, IN_COLS = 3904;
constexpr int XH = 4, XD = 512;
constexpr int NG = 8, EPG = 8, NE = 64, DE = 512, NRT = NG + NE;
constexpr int LROWS = (NTOK * 2 / 256 + NE) * 256;
constexpr float EPS = 1e-6f;
constexpr float LOG2E = 1.4426950408889634f;

constexpr size_t MiB = 1u << 20;
constexpr size_t WS_CTL = 0, CTL_BYTES = 1 * MiB;
constexpr size_t CTL_SSQ_X = 64 * 1024, CTL_SSQ_MEM = 128 * 1024, CTL_CNT = 144 * 1024;
constexpr size_t CTL_SSQ_Q = 256 * 1024, CTL_SSQ_KV = 384 * 1024, CTL_SSQ_ATT = 512 * 1024, CTL_SSQ_1 = 640 * 1024, CTL_SSQ_2 = 768 * 1024;
constexpr size_t WS_TAB = 1 * MiB;
constexpr size_t WS_WRT = 5 * MiB;
constexpr size_t WS_TOKI = 6 * MiB;
constexpr size_t TOK_EID = WS_TOKI, TOK_GW = TOK_EID + 128 * 1024, TOK_RANK = TOK_GW + 128 * 1024, TOK_DEST = TOK_RANK + 128 * 1024, TOK_RSTD = TOK_DEST + 128 * 1024;
constexpr size_t ROW_TOK = TOK_RSTD + 64 * 1024, ROW_RS = ROW_TOK + 192 * 1024, ROW_W = ROW_RS + 192 * 1024;
constexpr size_t WS_WIN = 8 * MiB, WS_WQ = 24 * MiB, WS_WKV = 26 * MiB, WS_WOUT = 28 * MiB, WS_WXQ = 36 * MiB, WS_WXK = 44 * MiB, WS_WXV = 52 * MiB, WS_WXO = 60 * MiB;
constexpr size_t WS_WGU = 68 * MiB, WS_WD = 324 * MiB, ARENA = 452 * MiB;
constexpr size_t A_ZB = ARENA, A_X1B = ARENA, A_QX = ARENA + 64 * MiB, A_X2B = ARENA, A_ACT = ARENA + 65 * MiB;
constexpr size_t A_XB = ARENA + 128 * MiB, A_QB = A_XB, A_YCAT = ARENA + 384 * MiB, A_PBUF = A_XB;
constexpr size_t A_KB = ARENA + 192 * MiB, A_OX = A_KB, A_VT = ARENA + 224 * MiB, A_OATT = ARENA + 256 * MiB;
constexpr size_t A_MEMB = ARENA + 288 * MiB, A_KX = A_MEMB + 8 * MiB, A_VXT = A_MEMB + 16 * MiB, A_KROPE = A_MEMB + 24 * MiB;
constexpr size_t A_X2L = ARENA + 192 * MiB;
constexpr size_t A_SLAB = ARENA + 256 * MiB;
constexpr size_t A_MT = ARENA + 320 * MiB, A_VWT = ARENA + 352 * MiB;
constexpr size_t A_YBUF = ARENA + 256 * MiB;
constexpr size_t WS_END = ARENA + 448 * MiB;
constexpr size_t WS_DUMMY = WS_END;
constexpr size_t WS_NEED = (DUP_MASK != 0u) ? WS_END + 128 * MiB : WS_END;

constexpr int RING_BYTES = 131072;
constexpr int EPI_OFF = RING_BYTES;
constexpr int TAB_OFF = EPI_OFF + 8192;
constexpr int MISC_OFF = TAB_OFF + 1024;
constexpr int LDS_BYTES = 147456;
static_assert(MISC_OFF + 256 <= LDS_BYTES, "LDS map");
constexpr int NWAVES = 8;

__device__ __forceinline__ int lane_id() { return (int)__builtin_amdgcn_mbcnt_hi(~0u, __builtin_amdgcn_mbcnt_lo(~0u, 0u)); }
__device__ __forceinline__ unsigned cvt_pk_bf16(float lo, float hi) { unsigned r; asm volatile("v_cvt_pk_bf16_f32 %0, %1, %2" : "=v"(r) : "v"(lo), "v"(hi)); return r; }
__device__ __forceinline__ float bf_lo(unsigned w) { return __uint_as_float(w << 16); }
__device__ __forceinline__ float bf_hi(unsigned w) { return __uint_as_float(w & 0xffff0000u); }
__device__ __forceinline__ float wave_sum(float v) {
#pragma unroll
    for (int o = 1; o < 64; o <<= 1) v += __shfl_xor(v, o);
    return v;
}
typedef unsigned long long fx64;
__device__ __forceinline__ void fx_add(fx64* p, float q) { atomicAdd(p, (fx64)(q * 4294967296.0f)); }
__device__ __forceinline__ float fx_get(const fx64* p) { return (float)(*p) * 2.3283064365386963e-10f; }
__device__ __forceinline__ unsigned pk4_fp8(float a, float b, float c, float d) { int w = __builtin_amdgcn_cvt_pk_fp8_f32(a, b, 0, false); w = __builtin_amdgcn_cvt_pk_fp8_f32(c, d, w, true); return (unsigned)w; }
constexpr float F8_SX = 64.0f, F8_SW = 64.0f, F8_SD = 32.0f, F8_SACT = 16.0f, F8_SY = 16.0f, F8_SM = 32.0f, F8_SV = 4.0f, F8_SP = 256.0f;
#define LDS_WAIT() asm volatile("s_waitcnt lgkmcnt(0)" ::: "memory")
#define NTL(p) __builtin_nontemporal_load(p)
#define NTS(v, p) __builtin_nontemporal_store(v, p)
#define VM_WAIT() asm volatile("s_waitcnt vmcnt(0)" ::: "memory")

#define XB_TMO      128
#define XB_XCNT(j)  (256  + 64 * (j))
#define XB_XSUB(j)  (1280 + 64 * (j))
#define XB_XGEN(j)  (2304 + 64 * (j))
#define XB_TOP      3328
#define XB_TOPGEN   3392
#define XCD_BAR_WORDS 3456
#define XB_SPIN_CAP (1u << 18)
__device__ __forceinline__ unsigned xb_ld(unsigned* p)              { return __hip_atomic_load(p, __ATOMIC_RELAXED, __HIP_MEMORY_SCOPE_AGENT); }
__device__ __forceinline__ unsigned xb_add(unsigned* p, unsigned v) { return __hip_atomic_fetch_add(p, v, __ATOMIC_RELAXED, __HIP_MEMORY_SCOPE_AGENT); }
__device__ __forceinline__ unsigned xb_xcc_id() { return (unsigned)__builtin_amdgcn_s_getreg((3 << 11) | 20) & 0xFu; }
#define XB_SPIN(cond, bar) do { unsigned _sp = 0; while (cond) { __builtin_amdgcn_s_sleep(1); \
    if ((++_sp & 255u) == 0u) { if (xb_ld(&(bar)[XB_TMO])) break; if (_sp > XB_SPIN_CAP) { atomicAdd(&(bar)[XB_TMO], 1u); break; } } } } while (0)
struct XcdBarrier { unsigned* bar; unsigned x; volatile LAS unsigned* st; int wave; };
#define XB_THREAD0(b) ((b).wave == 0 && lane_id() == 0)
__device__ __forceinline__ XcdBarrier xcd_barrier_post(unsigned* bar, volatile LAS unsigned* st, int wave) {
    XcdBarrier b; b.bar = bar; b.x = xb_xcc_id(); b.st = st; b.wave = wave;
    if (XB_THREAD0(b)) (void)xb_add(&bar[XB_XCNT(b.x)], 1u);
    return b;
}
__device__ __forceinline__ void xcd_barrier_complete(unsigned* bar, unsigned x, unsigned& nloc, unsigned& nx) {
    const unsigned G = gridDim.x * gridDim.y * gridDim.z;
    unsigned sum, cnt, mine, sp = 0u;
    for (;;) {
        sum = 0u; cnt = 0u; mine = 0u;
#pragma unroll
        for (unsigned j = 0; j < 16; ++j) { const unsigned c = xb_ld(&bar[XB_XCNT(j)]); sum += c; cnt += (c > 0u) ? 1u : 0u; mine = (j == x) ? c : mine; }
        if (sum == G) break;
        __builtin_amdgcn_s_sleep(1);
        if ((++sp & 255u) == 0u) { if (xb_ld(&bar[XB_TMO])) break; if (sp > XB_SPIN_CAP) { atomicAdd(&bar[XB_TMO], 1u); break; } }
    }
    nloc = mine > 0u ? mine : 1u; nx = cnt > 0u ? cnt : 1u;
}
__device__ __forceinline__ void xcd_barrier(const XcdBarrier& b) {
    asm volatile("s_waitcnt vmcnt(0)" ::: "memory");
    __syncthreads();
    if (XB_THREAD0(b)) {
        unsigned* bar = b.bar;
        __builtin_amdgcn_s_waitcnt(0);
        unsigned nloc = b.st[0], nx = b.st[1];
        if (nloc == 0u) { xcd_barrier_complete(bar, b.x, nloc, nx); b.st[0] = nloc; b.st[1] = nx; }
        const unsigned old = xb_add(&bar[XB_XSUB(b.x)], 1u);
        const unsigned gen = old / nloc;
        if (old + 1u == (gen + 1u) * nloc) {
            __builtin_amdgcn_fence(__ATOMIC_RELEASE, "agent");
            asm volatile("s_waitcnt vmcnt(0)" ::: "memory");
            const unsigned og = xb_add(&bar[XB_TOP], 1u);
            const unsigned tg = og / nx;
            if (og + 1u == (tg + 1u) * nx) xb_add(&bar[XB_TOPGEN], 1u);
            else XB_SPIN(xb_ld(&bar[XB_TOPGEN]) == tg, bar);
            __builtin_amdgcn_fence(__ATOMIC_ACQUIRE, "agent");
            xb_add(&bar[XB_XGEN(b.x)], 1u);
            asm volatile("s_waitcnt vmcnt(0)" ::: "memory");
        } else {
            XB_SPIN(xb_ld(&bar[XB_XGEN(b.x)]) == gen, bar);
            __builtin_amdgcn_fence(__ATOMIC_ACQUIRE, "agent");
            asm volatile("s_waitcnt vmcnt(0)" ::: "memory");
        }
    }
    __syncthreads();
}

namespace pg8 {
constexpr int BM = 256, BK = 64, HALF = 128, HTB = HALF * BK * 2, STAGE_BYTES = 8 * HTB, NXCD = 8, WGM = 8;
__host__ __device__ __forceinline__ int lds_byte(int r, int c) { return (r >> 3) * 1024 + (r & 7) * 128 + ((((c >> 3) ^ (r & 7)) & 7) << 4) + (c & 7) * 2; }
__host__ __device__ __forceinline__ void stage_rc(int b, int& R, int& C) { const int s = b >> 10, sb = b & 1023, ri = sb >> 7, p = (sb >> 4) & 7; R = s * 8 + ri; C = ((p ^ ri) << 3) + ((sb & 15) >> 1); }
__host__ __device__ __forceinline__ int perm32(int rho) { const int n = rho >> 4, i = rho & 15; return 8 * (i >> 2) + 4 * n + (i & 3); }

struct Unit { const char* A; const char* B; int orow, ocol, aux; };

template <class Epi, class Sched, bool GATHER, int ES = 2>
__device__ __forceinline__ void gemm_phase(LAS unsigned char* lds, const int wave_id, const int K, const int lda, const int ldb, const Sched& S, const Epi& E) {
    int lane_ = lane_id(); asm volatile("" : "+v"(lane_));
    const int wid = wave_id, lane = lane_, tid = wid * 64 + lane, wr = wid >> 2, wc = wid & 3, fr = lane & 15, fq = lane >> 4;
    const int nt = (K * ES) / (BK * 2);
    unsigned voffA, voffB; int Rr[2], Cb[2];
    { int R, C; stage_rc(tid * 16, R, C); const int Rb = Epi::PERM ? ((R & ~31) + perm32(R & 31)) : R;
      voffA = (unsigned)(R * lda * ES + C * 2); voffB = (unsigned)(Rb * ldb * ES + C * 2); Rr[0] = R; Rr[1] = R + 64; Cb[0] = C * 2; Cb[1] = C * 2; }
    const size_t pstepA = (size_t)64 * lda * ES, pstepB = (size_t)64 * ldb * ES;
    const size_t kstep = (size_t)(BK * 2);
    const size_t hstepA = GATHER ? 0 : (size_t)HALF * lda * ES, hstepB = (size_t)HALF * ldb * ES;
    const unsigned ldsw = (unsigned)wid * 1024u;
    const int aoff0 = lds_byte(wr * 64 + fr, fq * 8), boff0 = lds_byte(wc * 32 + fr, fq * 8);
    unsigned oc[2][2], on[2][2], ox[2][2];
#define PG8_SA(b, h) (((b) * 2 + (h)) * HTB)
#define PG8_SB(b, h) ((4 + (b) * 2 + (h)) * HTB)
#define PG8_STAGE(bufoff, gbase, voff) do { _Pragma("unroll") for (int _i = 0; _i < 2; ++_i) \
        __builtin_amdgcn_global_load_lds((const unsigned*)((const char*)(gbase) + (voff)[_i]), (LAS unsigned*)(lds + (bufoff) + ldsw + _i * 8192), 16, 0, 0); } while (0)
#define PG8_STAGE1(bufoff, gbase, voff, pstep) do { _Pragma("unroll") for (int _i = 0; _i < 2; ++_i) \
        __builtin_amdgcn_global_load_lds((const unsigned*)((const char*)(gbase) + _i * (pstep) + (voff)), (LAS unsigned*)(lds + (bufoff) + ldsw + _i * 8192), 16, 0, 0); } while (0)
#define PG8_STAGE_A(bufoff, gbase, h, SET) do { if constexpr (GATHER) { PG8_STAGE(bufoff, gbase, SET[h]); } else { PG8_STAGE1(bufoff, (gbase) + (h) * hstepA, voffA, pstepA); } } while (0)
#define PG8_LDA(dst, b, h) do { int aoff1 = aoff0 ^ 64; asm volatile("" : "+v"(aoff1)); _Pragma("unroll") for (int m = 0; m < 4; ++m) { \
        if constexpr (ES == 2) { _Pragma("unroll") for (int k = 0; k < 2; ++k) dst[m][k] = *(const LAS bf16x8*)(lds + PG8_SA(b, h) + (k ? aoff1 : aoff0) + m * 2048); } \
        else { dst##8[m].lo = *(const LAS i4_t*)(lds + PG8_SA(b, h) + aoff0 + m * 2048); dst##8[m].hi = *(const LAS i4_t*)(lds + PG8_SA(b, h) + aoff1 + m * 2048); } } } while (0)
#define PG8_LDB(dst, b, h) do { int boff1 = boff0 ^ 64; asm volatile("" : "+v"(boff1)); _Pragma("unroll") for (int n = 0; n < 2; ++n) { \
        if constexpr (ES == 2) { _Pragma("unroll") for (int k = 0; k < 2; ++k) dst[n][k] = *(const LAS bf16x8*)(lds + PG8_SB(b, h) + (k ? boff1 : boff0) + n * 2048); } \
        else { dst##8[n].lo = *(const LAS i4_t*)(lds + PG8_SB(b, h) + boff0 + n * 2048); dst##8[n].hi = *(const LAS i4_t*)(lds + PG8_SB(b, h) + boff1 + n * 2048); } } } while (0)
#define PG8_MMA(ai, bj, At, Bt) do { __builtin_amdgcn_s_setprio(1); _Pragma("unroll") for (int m = 0; m < 4; ++m) _Pragma("unroll") for (int n = 0; n < 2; ++n) { \
        if constexpr (ES == 2) { _Pragma("unroll") for (int k = 0; k < 2; ++k) acc[ai][bj][m][n] = __builtin_amdgcn_mfma_f32_16x16x32_bf16(Bt[n][k], At[m][k], acc[ai][bj][m][n], 0, 0, 0); } \
        else asm volatile("v_mfma_scale_f32_16x16x128_f8f6f4 %0, %1, %2, %0, %3, %3 op_sel_hi:[0,0,0]" : "+v"(acc[ai][bj][m][n]) : "v"(Bt##8[n]), "v"(At##8[m]), "v"(mxs));     } \
        __builtin_amdgcn_s_setprio(0); } while (0)
#define PG8_WAIT_V(n) asm volatile("s_waitcnt vmcnt(" #n ")" ::: "memory")
#define PG8_WAIT_L(n) asm volatile("s_waitcnt lgkmcnt(" #n ")" ::: "memory")
#define PG8_BAR __builtin_amdgcn_s_barrier()
#define PG8_SCHED __builtin_amdgcn_sched_barrier(0)
    Unit cur, nxt; int ui = 0;
    if (!S.next(0, cur)) return;
    f32x4 acc[2][2][4][2];
#pragma unroll
    for (int a = 0; a < 2; ++a)
#pragma unroll
        for (int b = 0; b < 2; ++b)
#pragma unroll
            for (int m = 0; m < 4; ++m)
#pragma unroll
                for (int n = 0; n < 2; ++n) acc[a][b][m][n] = (f32x4){0.f, 0.f, 0.f, 0.f};
    typedef int i4_t __attribute__((ext_vector_type(4))); typedef int i8_t __attribute__((ext_vector_type(8)));
    const int mxs = 0x7f7f7f7f;
    bf16x8 At[4][2], B0[2][2], B1[2][2]; i8_t At8[4], B08[2], B18[2];
    const char* cA = cur.A; const char* cB = cur.B;
    if constexpr (GATHER) {
#pragma unroll
        for (int h = 0; h < 2; ++h)
#pragma unroll
            for (int i = 0; i < 2; ++i) oc[h][i] = S.rowoff(cur, h * HALF + Rr[i]) + (unsigned)Cb[i];
        asm volatile("s_waitcnt vmcnt(0)" : "+v"(oc[0][0]), "+v"(oc[0][1]), "+v"(oc[1][0]), "+v"(oc[1][1]) :: "memory");
    }
    PG8_STAGE1(PG8_SB(0, 0), cB, voffB, pstepB); PG8_STAGE1(PG8_SB(0, 1), cB + hstepB, voffB, pstepB); PG8_STAGE_A(PG8_SA(0, 0), cA, 0, oc); PG8_STAGE_A(PG8_SA(0, 1), cA, 1, oc);
    if (wr == 1) PG8_BAR;
    PG8_WAIT_V(2); PG8_BAR;
    PG8_STAGE1(PG8_SB(1, 0), cB + kstep, voffB, pstepB); PG8_STAGE_A(PG8_SA(1, 0), cA + kstep, 0, oc); PG8_STAGE1(PG8_SB(1, 1), cB + hstepB + kstep, voffB, pstepB);
    PG8_WAIT_V(6); PG8_BAR;
    for (;;) {
        const bool has_next = S.next(ui + 1, nxt);
        const char* nA = has_next ? nxt.A : cA; const char* nB = has_next ? nxt.B : cB;
        if constexpr (GATHER) {
            if (has_next) {
#pragma unroll
                for (int h = 0; h < 2; ++h)
#pragma unroll
                    for (int i = 0; i < 2; ++i) on[h][i] = S.rowoff(nxt, h * HALF + Rr[i]) + (unsigned)Cb[i];
                asm volatile("s_waitcnt vmcnt(0)" : "+v"(on[0][0]), "+v"(on[0][1]), "+v"(on[1][0]), "+v"(on[1][1]) :: "memory");
            } else {
#pragma unroll
                for (int h = 0; h < 2; ++h)
#pragma unroll
                    for (int i = 0; i < 2; ++i) on[h][i] = oc[h][i];
            }
        }
#pragma clang loop unroll(disable)
        for (int t = 0; t < nt; t += 2) {
            const bool last = (t == nt - 2);
            const char* a1 = cA + (size_t)(t + 1) * kstep;
            const char* a2 = last ? nA : cA + (size_t)(t + 2) * kstep; const char* b2 = last ? nB : cB + (size_t)(t + 2) * kstep;
            const char* a3 = a2 + kstep; const char* b3 = b2 + kstep;
            if constexpr (GATHER) {
#pragma unroll
                for (int h = 0; h < 2; ++h)
#pragma unroll
                    for (int i = 0; i < 2; ++i) ox[h][i] = last ? on[h][i] : oc[h][i];
            }
            PG8_LDB(B0, 0, 0); PG8_LDB(B1, 0, 1); PG8_SCHED; PG8_LDA(At, 0, 0); PG8_STAGE_A(PG8_SA(1, 1), a1, 1, oc);
            PG8_WAIT_V(8); PG8_WAIT_L(0); PG8_BAR; PG8_MMA(0, 0, At, B0); PG8_MMA(0, 1, At, B1); PG8_BAR; PG8_SCHED;
            PG8_LDA(At, 0, 1); PG8_STAGE1(PG8_SB(0, 0), b2, voffB, pstepB); PG8_STAGE1(PG8_SB(0, 1), b2 + hstepB, voffB, pstepB); PG8_STAGE_A(PG8_SA(0, 0), a2, 0, ox);
            PG8_WAIT_V(8); PG8_WAIT_L(0); PG8_BAR; PG8_MMA(1, 0, At, B0); PG8_MMA(1, 1, At, B1); PG8_BAR; PG8_SCHED;
            PG8_LDB(B0, 1, 0); PG8_LDB(B1, 1, 1); PG8_SCHED; PG8_LDA(At, 1, 0); PG8_STAGE_A(PG8_SA(0, 1), a2, 1, ox);
            PG8_WAIT_V(8); PG8_WAIT_L(0); PG8_BAR; PG8_MMA(0, 0, At, B0); PG8_MMA(0, 1, At, B1); PG8_BAR; PG8_SCHED;
            PG8_LDA(At, 1, 1); PG8_STAGE1(PG8_SB(1, 0), b3, voffB, pstepB); PG8_STAGE1(PG8_SB(1, 1), b3 + hstepB, voffB, pstepB); PG8_STAGE_A(PG8_SA(1, 0), a3, 0, ox);
            PG8_WAIT_V(8); PG8_WAIT_L(0); PG8_BAR; PG8_MMA(1, 0, At, B0); PG8_MMA(1, 1, At, B1); PG8_BAR; PG8_SCHED;
        }
        if (wr == 0) PG8_BAR;
        if constexpr (ES == 1) asm volatile("s_nop 15\n\ts_nop 15" ::: "memory");
        { int fr_e = fr, fq_e = fq; asm volatile("" : "+v"(fr_e), "+v"(fq_e));
          E(acc, cur, wr, wc, fr_e, fq_e); }
        if (!has_next) break;
#pragma unroll
        for (int a = 0; a < 2; ++a)
#pragma unroll
            for (int b = 0; b < 2; ++b)
#pragma unroll
                for (int m = 0; m < 4; ++m)
#pragma unroll
                    for (int n = 0; n < 2; ++n) acc[a][b][m][n] = (f32x4){0.f, 0.f, 0.f, 0.f};
        cur = nxt; cA = nA; cB = nB; ++ui;
        if constexpr (GATHER) {
#pragma unroll
            for (int h = 0; h < 2; ++h)
#pragma unroll
                for (int i = 0; i < 2; ++i) oc[h][i] = on[h][i];
        }
        if (wr == 1) PG8_BAR;
    }
    PG8_WAIT_V(0);
    PG8_BAR;
#undef PG8_SA
#undef PG8_SB
#undef PG8_STAGE
#undef PG8_STAGE1
#undef PG8_STAGE_A
#undef PG8_LDA
#undef PG8_LDB
#undef PG8_MMA
#undef PG8_WAIT_V
#undef PG8_WAIT_L
#undef PG8_BAR
#undef PG8_SCHED
}

struct DenseSched {
    const char* A; const char* B; int lda, ldb, nM, nN, nwg, G, c, first, last, es = 2;
    __device__ void init(const void* A_, const void* B_, int lda_, int ldb_, int M, int N, int G_, int c_, int first_ = 0, int count_ = -1) { A = (const char*)A_; B = (const char*)B_; lda = lda_; ldb = ldb_; nM = M / BM; nN = N / BM; nwg = nM * nN; G = G_; c = c_;
        first = first_; last = (count_ < 0) ? nwg : first_ + count_; }
    __device__ __forceinline__ bool next(int i, Unit& u) const {
        const long L = (long)first + (long)i * G + c; if (L >= last) return false;
        int wgid = (int)L; { const int q = nwg / NXCD, r = nwg % NXCD, xcd = wgid % NXCD, off = wgid / NXCD; wgid = (xcd < r ? xcd * (q + 1) : r * (q + 1) + (xcd - r) * q) + off; }
        const int nig = WGM * nN, gid = wgid / nig, fm = gid * WGM, gsz = (nM - fm) < WGM ? (nM - fm) : WGM;
        const int pm = fm + ((wgid % nig) % gsz), pn = (wgid % nig) / gsz;
        u.A = A + (size_t)pm * BM * lda * es; u.B = B + (size_t)pn * BM * ldb * es; u.orow = pm * BM; u.ocol = pn * BM; u.aux = 0; return true;
    }
    __device__ __forceinline__ unsigned rowoff(const Unit&, int) const { return 0u; }
};
}

template <int MODE> struct EpiBf16 {
    static constexpr bool PERM = true;
    bf16_t* O; int ldc; const float* sv; float inv_dim, mul;
    __device__ __forceinline__ void operator()(const f32x4 (&acc)[2][2][4][2], const pg8::Unit& u, int wr, int wc, int fr, int fq) const {
        const int row0 = u.orow + wr * 64 + fr, col0 = u.ocol + wc * 32 + 8 * fq;
#pragma unroll
        for (int ai = 0; ai < 2; ++ai)
#pragma unroll
            for (int m = 0; m < 4; ++m) { const int row = row0 + ai * 128 + m * 16;
                float s = mul; if (MODE == 1) s = mul / sqrtf(sv[row] * inv_dim + EPS); if (MODE == 2) s = mul * sv[row]; if (MODE == 3) s = mul / sqrtf(fx_get((const fx64*)sv + row) * inv_dim + EPS);
                bf16_t* rowp = O + (size_t)row * ldc + col0;
#pragma unroll
                for (int bj = 0; bj < 2; ++bj) { const f32x4 v0 = acc[ai][bj][m][0] * s, v1 = acc[ai][bj][m][1] * s;
                    u32x4 w; w.x = cvt_pk_bf16(v0[0], v0[1]); w.y = cvt_pk_bf16(v0[2], v0[3]); w.z = cvt_pk_bf16(v1[0], v1[1]); w.w = cvt_pk_bf16(v1[2], v1[3]);
                    *(u32x4*)(rowp + bj * 128) = w; } }
    }
};
struct EpiF8Rms {
    static constexpr bool PERM = true;
    unsigned char* O; int ldc; const float* ssq; float inv_dim, mul;
    __device__ __forceinline__ void operator()(const f32x4 (&acc)[2][2][4][2], const pg8::Unit& u, int wr, int wc, int fr, int fq) const {
        const int row0 = u.orow + wr * 64 + fr, col0 = u.ocol + wc * 32 + 8 * fq;
#pragma unroll
        for (int ai = 0; ai < 2; ++ai)
#pragma unroll
            for (int m = 0; m < 4; ++m) { const int row = row0 + ai * 128 + m * 16; const float s = mul / sqrtf(ssq[row] * inv_dim + EPS); unsigned char* rowp = O + (size_t)row * ldc + col0;
#pragma unroll
                for (int bj = 0; bj < 2; ++bj) { const f32x4 v0 = acc[ai][bj][m][0] * s, v1 = acc[ai][bj][m][1] * s;
                    u32x2 w; w.x = pk4_fp8(v0[0], v0[1], v0[2], v0[3]); w.y = pk4_fp8(v1[0], v1[1], v1[2], v1[3]); *(u32x2*)(rowp + bj * 128) = w; } }
    }
};
struct EpiF8 {
    static constexpr bool PERM = true;
    unsigned char* O; int ldc; float mul;
    __device__ __forceinline__ void operator()(const f32x4 (&acc)[2][2][4][2], const pg8::Unit& u, int wr, int wc, int fr, int fq) const {
        const int row0 = u.orow + wr * 64 + fr, col0 = u.ocol + wc * 32 + 8 * fq;
#pragma unroll
        for (int ai = 0; ai < 2; ++ai)
#pragma unroll
            for (int m = 0; m < 4; ++m) { unsigned char* rowp = O + (size_t)(row0 + ai * 128 + m * 16) * ldc + col0;
#pragma unroll
                for (int bj = 0; bj < 2; ++bj) { const f32x4 v0 = acc[ai][bj][m][0] * mul, v1 = acc[ai][bj][m][1] * mul;
                    u32x2 w; w.x = pk4_fp8(v0[0], v0[1], v0[2], v0[3]); w.y = pk4_fp8(v1[0], v1[1], v1[2], v1[3]); *(u32x2*)(rowp + bj * 128) = w; } }
    }
};
__device__ __forceinline__ void rope8(f32x4& v0, f32x4& v1, const f32x2* cs) {
    const f32x4 c01 = *(const f32x4*)cs, c23 = *(const f32x4*)(cs + 2);
    f32x4 a = v0, b = v1;
    v0[0] = a[0] * c01[0] - a[1] * c01[1]; v0[1] = a[1] * c01[0] + a[0] * c01[1];
    v0[2] = a[2] * c01[2] - a[3] * c01[3]; v0[3] = a[3] * c01[2] + a[2] * c01[3];
    v1[0] = b[0] * c23[0] - b[1] * c23[1]; v1[1] = b[1] * c23[0] + b[0] * c23[1];
    v1[2] = b[2] * c23[2] - b[3] * c23[3]; v1[3] = b[3] * c23[2] + b[2] * c23[3];
}
struct EpiZ {
    static constexpr bool PERM = true;
    bf16_t* zb; bf16_t* krope; const float* ssq_x; fx64* ssq_q; fx64* ssq_kv; const f32x2* tab;
    __device__ __forceinline__ void operator()(const f32x4 (&acc)[2][2][4][2], const pg8::Unit& u, int wr, int wc, int fr, int fq) const {
        const int row0 = u.orow + wr * 64 + fr, col0 = u.ocol + wc * 32 + 8 * fq;
        fx64* ssq = (u.ocol == C_Q || u.ocol == C_Q + 256) ? ssq_q : (u.ocol == C_KV ? ssq_kv : nullptr);
        const bool isrope = (u.ocol == C_KR) && (wc < 2);
#pragma unroll
        for (int ai = 0; ai < 2; ++ai)
#pragma unroll
            for (int m = 0; m < 4; ++m) { const int row = row0 + ai * 128 + m * 16;
                const float s = 1.0f / sqrtf(ssq_x[row] * (1.0f / DM) + EPS);
                bf16_t* rowp = zb + (size_t)row * ZC + col0; float q = 0.f;
#pragma unroll
                for (int bj = 0; bj < 2; ++bj) { f32x4 v0 = acc[ai][bj][m][0] * s, v1 = acc[ai][bj][m][1] * s;
                    q += (v0[0] * v0[0] + v0[1] * v0[1]) + (v0[2] * v0[2] + v0[3] * v0[3]) + (v1[0] * v1[0] + v1[1] * v1[1]) + (v1[2] * v1[2] + v1[3] * v1[3]);
                    u32x4 w; w.x = cvt_pk_bf16(v0[0], v0[1]); w.y = cvt_pk_bf16(v0[2], v0[3]); w.z = cvt_pk_bf16(v1[0], v1[1]); w.w = cvt_pk_bf16(v1[2], v1[3]);
                    *(u32x4*)(rowp + bj * 128) = w;
                    if (bj == 0 && isrope) { const int c = wc * 32 + 8 * fq;
                        rope8(v0, v1, tab + (size_t)row * 32 + (c >> 1));
                        u32x4 w2; w2.x = cvt_pk_bf16(v0[0], v0[1]); w2.y = cvt_pk_bf16(v0[2], v0[3]); w2.z = cvt_pk_bf16(v1[0], v1[1]); w2.w = cvt_pk_bf16(v1[2], v1[3]);
                        *(u32x4*)(krope + (size_t)row * DR + c) = w2; } }
                if (ssq) { q += __shfl_xor(q, 16); q += __shfl_xor(q, 32); if (fq == 0) fx_add(ssq + row, q); } }
    }
};
struct EpiQ {
    static constexpr bool PERM = true;
    bf16_t* qb; const fx64* ssq_q; const f32x2* tab;
    __device__ __forceinline__ void operator()(const f32x4 (&acc)[2][2][4][2], const pg8::Unit& u, int wr, int wc, int fr, int fq) const {
        const int row0 = u.orow + wr * 64 + fr, col0 = u.ocol + wc * 32 + 8 * fq;
        const float qs = LOG2E * 0.07216878364870322f;
#pragma unroll
        for (int ai = 0; ai < 2; ++ai)
#pragma unroll
            for (int m = 0; m < 4; ++m) { const int row = row0 + ai * 128 + m * 16;
                const float s = 1.0f / sqrtf(fx_get(ssq_q + row) * (1.0f / QL) + EPS);
                bf16_t* rowp = qb + (size_t)row * (NH * DQK) + col0;
#pragma unroll
                for (int bj = 0; bj < 2; ++bj) { f32x4 v0 = acc[ai][bj][m][0] * s, v1 = acc[ai][bj][m][1] * s;
                    const int d = (col0 + bj * 128) % DQK;
                    if (d >= DN) rope8(v0, v1, tab + (size_t)row * 32 + ((d - DN) >> 1));
                    v0 = v0 * qs; v1 = v1 * qs;
                    u32x4 w; w.x = cvt_pk_bf16(v0[0], v0[1]); w.y = cvt_pk_bf16(v0[2], v0[3]); w.z = cvt_pk_bf16(v1[0], v1[1]); w.w = cvt_pk_bf16(v1[2], v1[3]);
                    *(u32x4*)(rowp + bj * 128) = w; } }
    }
};
template <bool KPERM> struct EpiColScale {
    static constexpr bool PERM = false;
    bf16_t* O; int ldc; const fx64* ssq; float inv_dim;
    __device__ __forceinline__ void operator()(const f32x4 (&acc)[2][2][4][2], const pg8::Unit& u, int wr, int wc, int fr, int fq) const {
        const int row0 = u.orow + wr * 64 + fr, colb = u.ocol + wc * 32;
        const int fqp = KPERM ? (((fq & 1) << 1) | (fq >> 1)) : fq;
#pragma unroll
        for (int bj = 0; bj < 2; ++bj)
#pragma unroll
            for (int n = 0; n < 2; ++n) { const fx64* qp = ssq + colb + bj * 128 + n * 16 + 4 * fq; f32x4 sc;
#pragma unroll
                for (int e = 0; e < 4; ++e) sc[e] = 1.0f / sqrtf(fx_get(qp + e) * inv_dim + EPS);
#pragma unroll
                for (int ai = 0; ai < 2; ++ai)
#pragma unroll
                    for (int m = 0; m < 4; ++m) { bf16_t* rowp = O + (size_t)(row0 + ai * 128 + m * 16) * ldc + colb + 4 * fqp; const f32x4 v = acc[ai][bj][m][n] * sc;
                        u32x2 w; w.x = cvt_pk_bf16(v[0], v[1]); w.y = cvt_pk_bf16(v[2], v[3]); *(u32x2*)(rowp + bj * 128 + n * 16) = w; } }
    }
};
template <bool FROM_F32> struct EpiResidHL {
    static constexpr bool PERM = true;
    const float* xf; const bf16_t* xih; const bf16_t* xil; bf16_t* xh; bf16_t* xl; fx64* ssq; unsigned char* x8; float amul;
    __device__ __forceinline__ void operator()(const f32x4 (&acc)[2][2][4][2], const pg8::Unit& u, int wr, int wc, int fr, int fq) const {
        const int row0 = u.orow + wr * 64 + fr, col0 = u.ocol + wc * 32 + 8 * fq;
#pragma unroll
        for (int ai = 0; ai < 2; ++ai) {
            f32x4 xv[4][2][2];
#pragma unroll
            for (int m = 0; m < 4; ++m)
#pragma unroll
                for (int bj = 0; bj < 2; ++bj) { const size_t off = (size_t)(row0 + ai * 128 + m * 16) * DM + col0 + bj * 128;
                    if (FROM_F32) { xv[m][bj][0] = NTL((const f32x4*)(xf + off)); xv[m][bj][1] = NTL((const f32x4*)(xf + off + 4)); }
                    else { const u32x4 h = NTL((const u32x4*)(xih + off)), l = NTL((const u32x4*)(xil + off));
                        xv[m][bj][0] = (f32x4){bf_lo(h.x) + bf_lo(l.x), bf_hi(h.x) + bf_hi(l.x), bf_lo(h.y) + bf_lo(l.y), bf_hi(h.y) + bf_hi(l.y)};
                        xv[m][bj][1] = (f32x4){bf_lo(h.z) + bf_lo(l.z), bf_hi(h.z) + bf_hi(l.z), bf_lo(h.w) + bf_lo(l.w), bf_hi(h.w) + bf_hi(l.w)}; } }
#pragma unroll
            for (int m = 0; m < 4; ++m) { const int row = row0 + ai * 128 + m * 16; float q = 0.f;
#pragma unroll
                for (int bj = 0; bj < 2; ++bj) { const size_t off = (size_t)row * DM + col0 + bj * 128;
                    const f32x4 v0 = xv[m][bj][0] + acc[ai][bj][m][0] * amul, v1 = xv[m][bj][1] + acc[ai][bj][m][1] * amul;
                    q += ((v0[0] * v0[0] + v0[1] * v0[1]) + (v0[2] * v0[2] + v0[3] * v0[3])) + ((v1[0] * v1[0] + v1[1] * v1[1]) + (v1[2] * v1[2] + v1[3] * v1[3]));
                    u32x4 h; h.x = cvt_pk_bf16(v0[0], v0[1]); h.y = cvt_pk_bf16(v0[2], v0[3]); h.z = cvt_pk_bf16(v1[0], v1[1]); h.w = cvt_pk_bf16(v1[2], v1[3]); *(u32x4*)(xh + off) = h;
                    u32x4 l; l.x = cvt_pk_bf16(v0[0] - bf_lo(h.x), v0[1] - bf_hi(h.x)); l.y = cvt_pk_bf16(v0[2] - bf_lo(h.y), v0[3] - bf_hi(h.y));
                    l.z = cvt_pk_bf16(v1[0] - bf_lo(h.z), v1[1] - bf_hi(h.z)); l.w = cvt_pk_bf16(v1[2] - bf_lo(h.w), v1[3] - bf_hi(h.w)); *(u32x4*)(xl + off) = l;
                    if (x8) { u32x2 w; w.x = pk4_fp8(v0[0], v0[1], v0[2], v0[3]); w.y = pk4_fp8(v1[0], v1[1], v1[2], v1[3]); *(u32x2*)(x8 + off) = w; } }
                q += __shfl_xor(q, 16); q += __shfl_xor(q, 32); if (fq == 0) fx_add(ssq + row, q); }
        }
    }
};
struct EpiSoftmax {
    static constexpr bool PERM = true;
    bf16_t* P; int ldc; LAS float* tmax; LAS float* tsum; const fx64* ssq; float inv_dim; float smul; unsigned char* P8;
    __device__ __forceinline__ void operator()(f32x4 (&acc)[2][2][4][2], const pg8::Unit& u, int wr, int wc, int fr, int fq) const {
        const int col0 = u.ocol + wc * 32 + 8 * fq;
#pragma unroll
        for (int ai = 0; ai < 2; ++ai)
#pragma unroll
            for (int m = 0; m < 4; ++m) { float v = -3.0e38f; const float rs = smul / sqrtf(fx_get(ssq + u.orow + ai * 128 + wr * 64 + m * 16 + fr) * inv_dim + EPS);
#pragma unroll
                for (int bj = 0; bj < 2; ++bj)
#pragma unroll
                    for (int n = 0; n < 2; ++n) { const f32x4 x = acc[ai][bj][m][n] * rs; acc[ai][bj][m][n] = x; v = fmaxf(fmaxf(fmaxf(v, x[0]), fmaxf(x[1], x[2])), x[3]); }
                v = fmaxf(v, __shfl_xor(v, 16)); v = fmaxf(v, __shfl_xor(v, 32));
                if (fq == 0) tmax[(ai * 128 + wr * 64 + m * 16 + fr) * 4 + wc] = v; }
        LDS_WAIT(); __builtin_amdgcn_s_barrier(); asm volatile("" ::: "memory");
#pragma unroll
        for (int ai = 0; ai < 2; ++ai)
#pragma unroll
            for (int m = 0; m < 4; ++m) { const f32x4 t = *(const LAS f32x4*)(tmax + (ai * 128 + wr * 64 + m * 16 + fr) * 4);
                const float rm = fmaxf(fmaxf(t[0], t[1]), fmaxf(t[2], t[3])); float s = 0.f;
#pragma unroll
                for (int bj = 0; bj < 2; ++bj)
#pragma unroll
                    for (int n = 0; n < 2; ++n) { f32x4 x = acc[ai][bj][m][n] - rm;
#pragma unroll
                        for (int e = 0; e < 4; ++e) x[e] = __builtin_amdgcn_exp2f(x[e]);
                        s += (x[0] + x[1]) + (x[2] + x[3]); acc[ai][bj][m][n] = x; }
                s += __shfl_xor(s, 16); s += __shfl_xor(s, 32);
                if (fq == 0) tsum[(ai * 128 + wr * 64 + m * 16 + fr) * 4 + wc] = s; }
        LDS_WAIT(); __builtin_amdgcn_s_barrier(); asm volatile("" ::: "memory");
#pragma unroll
        for (int ai = 0; ai < 2; ++ai)
#pragma unroll
            for (int m = 0; m < 4; ++m) { const int rl = ai * 128 + wr * 64 + m * 16 + fr; const f32x4 t = *(const LAS f32x4*)(tsum + rl * 4);
                const float inv = 1.0f / ((t[0] + t[1]) + (t[2] + t[3]));
                bf16_t* rowp = P + (size_t)(u.orow + rl) * ldc + col0; unsigned char* rowp8 = P8 + (size_t)(u.orow + rl) * ldc + col0;
#pragma unroll
                for (int bj = 0; bj < 2; ++bj) { const f32x4 v0 = acc[ai][bj][m][0] * inv, v1 = acc[ai][bj][m][1] * inv;
                    if (P8) { const f32x4 a0 = v0 * F8_SP, a1 = v1 * F8_SP; u32x2 w; w.x = pk4_fp8(a0[0], a0[1], a0[2], a0[3]); w.y = pk4_fp8(a1[0], a1[1], a1[2], a1[3]); *(u32x2*)(rowp8 + bj * 128) = w; }
                    else { u32x4 w; w.x = cvt_pk_bf16(v0[0], v0[1]); w.y = cvt_pk_bf16(v0[2], v0[3]); w.z = cvt_pk_bf16(v1[0], v1[1]); w.w = cvt_pk_bf16(v1[2], v1[3]);
                    *(u32x4*)(rowp + bj * 128) = w; } } }
    }
};
struct EpiF8Row {
    static constexpr bool PERM = true;
    unsigned char* O; int ldc; const float* sv; float mul;
    __device__ __forceinline__ void operator()(const f32x4 (&acc)[2][2][4][2], const pg8::Unit& u, int wr, int wc, int fr, int fq) const {
        const int row0 = u.orow + wr * 64 + fr, col0 = u.ocol + wc * 32 + 8 * fq;
#pragma unroll
        for (int ai = 0; ai < 2; ++ai)
#pragma unroll
            for (int m = 0; m < 4; ++m) { const int row = row0 + ai * 128 + m * 16; const float s = sv[row] * mul; unsigned char* rowp = O + (size_t)row * ldc + col0;
#pragma unroll
                for (int bj = 0; bj < 2; ++bj) { const f32x4 v0 = acc[ai][bj][m][0] * s, v1 = acc[ai][bj][m][1] * s;
                    u32x2 w; w.x = pk4_fp8(v0[0], v0[1], v0[2], v0[3]); w.y = pk4_fp8(v1[0], v1[1], v1[2], v1[3]); *(u32x2*)(rowp + bj * 128) = w; } }
    }
};
struct EpiGateUp8 {
    static constexpr bool PERM = true;
    unsigned char* act; const float* row_rs;
    __device__ __forceinline__ void operator()(const f32x4 (&acc)[2][2][4][2], const pg8::Unit& u, int wr, int wc, int fr, int fq) const {
        const int row0 = u.orow + wr * 64 + fr, col0 = u.ocol + wc * 32 + 8 * fq;
#pragma unroll
        for (int ai = 0; ai < 2; ++ai)
#pragma unroll
            for (int m = 0; m < 4; ++m) { const int row = row0 + ai * 128 + m * 16; const float s = row_rs[row] * (1.0f / F8_SW);
                float o[8];
#pragma unroll
                for (int n = 0; n < 2; ++n)
#pragma unroll
                    for (int e = 0; e < 4; ++e) { const float g = acc[ai][0][m][n][e] * s, up = acc[ai][1][m][n][e] * s; o[n * 4 + e] = g / (1.0f + __expf(-g)) * up * F8_SACT; }
                u32x2 w; w.x = pk4_fp8(o[0], o[1], o[2], o[3]); w.y = pk4_fp8(o[4], o[5], o[6], o[7]);
                *(u32x2*)(act + (size_t)row * DE + col0) = w; }
    }
};
struct EpiGateUp {
    static constexpr bool PERM = true;
    bf16_t* act; const float* row_rs;
    __device__ __forceinline__ void operator()(const f32x4 (&acc)[2][2][4][2], const pg8::Unit& u, int wr, int wc, int fr, int fq) const {
        const int row0 = u.orow + wr * 64 + fr, col0 = u.ocol + wc * 32 + 8 * fq;
#pragma unroll
        for (int ai = 0; ai < 2; ++ai)
#pragma unroll
            for (int m = 0; m < 4; ++m) { const int row = row0 + ai * 128 + m * 16; const float s = row_rs[row];
                float o[8];
#pragma unroll
                for (int n = 0; n < 2; ++n)
#pragma unroll
                    for (int e = 0; e < 4; ++e) { const float g = acc[ai][0][m][n][e] * s, up = acc[ai][1][m][n][e] * s; o[n * 4 + e] = g / (1.0f + __expf(-g)) * up; }
                u32x4 w; w.x = cvt_pk_bf16(o[0], o[1]); w.y = cvt_pk_bf16(o[2], o[3]); w.z = cvt_pk_bf16(o[4], o[5]); w.w = cvt_pk_bf16(o[6], o[7]);
                *(u32x4*)(act + (size_t)row * DE + col0) = w; }
    }
};

struct EpiRouter {
    static constexpr bool PERM = false;
    float* slab;
    __device__ __forceinline__ void operator()(const f32x4 (&acc)[2][2][4][2], const pg8::Unit& u, int wr, int wc, int fr, int fq) const {
        if (wc < 3) {
            const int row0 = u.orow + wr * 64 + fr, col0 = wc * 32 + 4 * fq;
#pragma unroll
            for (int ai = 0; ai < 2; ++ai)
#pragma unroll
                for (int m = 0; m < 4; ++m) { float* rowp = slab + ((size_t)u.aux * NTOK + row0 + ai * 128 + m * 16) * 96 + col0;
#pragma unroll
                    for (int n = 0; n < 2; ++n) *(f32x4*)(rowp + n * 16) = acc[ai][0][m][n] + acc[ai][1][m][n]; }
        }
    }
};

struct MtSched {
    const char* kx_; const char* wq; int G, c, es;
    __device__ __forceinline__ bool next(int i, pg8::Unit& u) const { const int L = i * G + c; if (L >= NB * XH * 8) return false;
        const int bh = L >> 3, pn = L & 7, b = bh >> 2, h = bh & 3;
        u.A = kx_ + ((size_t)(b * MEM) * DM + h * XD) * es; u.B = wq + ((size_t)(pn * 256) * DM + h * XD) * es; u.orow = bh * MEM; u.ocol = pn * 256; u.aux = 0; return true; }
    __device__ __forceinline__ unsigned rowoff(const pg8::Unit&, int) const { return 0u; }
};
struct VWtSched {
    const char* wo; const char* vx_; int G, c, es;
    __device__ __forceinline__ bool next(int i, pg8::Unit& u) const { const int L = i * G + c; if (L >= NB * XH * 8) return false;
        const int bh = L >> 3, pm = L & 7, b = bh >> 2, h = bh & 3;
        u.A = wo + ((size_t)(pm * 256) * DM + h * XD) * es; u.B = vx_ + ((size_t)(b * MEM) * DM + h * XD) * es; u.orow = b * DM + pm * 256; u.ocol = h * MEM; u.aux = 0; return true; }
    __device__ __forceinline__ unsigned rowoff(const pg8::Unit&, int) const { return 0u; }
};
struct CrossSSched {
    const char* xa; const char* mt; int G, c, es;
    __device__ __forceinline__ bool next(int i, pg8::Unit& u) const { const int L = i * G + c; if (L >= NB * XH * 8) return false;
        const int b = L >> 5, h = (L >> 3) & 3, qb = L & 7;
        u.A = xa + (size_t)(b * T + qb * 256) * DM * es; u.B = mt + (size_t)((b * XH + h) * MEM) * DM * es; u.orow = b * T + qb * 256; u.ocol = h * MEM; u.aux = 0; return true; }
    __device__ __forceinline__ unsigned rowoff(const pg8::Unit&, int) const { return 0u; }
};
struct CrossOSched {
    const char* pb; const char* vwt; int G, c, es;
    __device__ __forceinline__ bool next(int i, pg8::Unit& u) const { const int L = i * G + c; if (L >= NB * 8 * 8) return false;
        const int b = L >> 6, qb = (L >> 3) & 7, pn = L & 7;
        u.A = pb + (size_t)(b * T + qb * 256) * (XH * MEM) * es; u.B = vwt + (size_t)(b * DM + pn * 256) * (XH * MEM) * es; u.orow = b * T + qb * 256; u.ocol = pn * 256; u.aux = 0; return true; }
    __device__ __forceinline__ unsigned rowoff(const pg8::Unit&, int) const { return 0u; }
};
struct RouterSched {
    const char* xh; const char* xl; const char* wrt; int G, c;
    __device__ __forceinline__ bool next(int i, pg8::Unit& u) const { const int L = i * G + c; if (L >= (NTOK / 256) * 4) return false;
        const int pm = L >> 2, kq = L & 3;
        u.A = (kq < 2 ? xh : xl) + ((size_t)pm * 256 * DM + (kq & 1) * 1024) * 2; u.B = wrt + (size_t)kq * 1024 * 2; u.orow = pm * 256; u.ocol = 0; u.aux = kq; return true; }
    __device__ __forceinline__ unsigned rowoff(const pg8::Unit&, int) const { return 0u; }
};
struct MoeSched {
    const char* A; const char* B; const int* row_tok; const LAS int* blk_e; int nunits, ntl2, G, c; size_t a_blk_stride, b_exp_stride, b_tile_stride; int ocol_step; unsigned rowbytes;
    __device__ __forceinline__ bool next(int i, pg8::Unit& u) const { const int L = i * G + c; if (L >= nunits) return false;
        const int blk = L >> ntl2, nt = L & ((1 << ntl2) - 1), e = blk_e[blk];
        u.A = A + (size_t)blk * a_blk_stride; u.B = B + (size_t)e * b_exp_stride + (size_t)nt * b_tile_stride; u.orow = blk * 256; u.ocol = nt * ocol_step; u.aux = e; return true; }
    __device__ __forceinline__ unsigned rowoff(const pg8::Unit& u, int r) const { return (unsigned)row_tok[u.orow + r] * rowbytes; }
};

struct Args {
    const float* x; const float* mem; const int* pos; const float* g_mix; const float* w_in; const float* w_conv; const float* g_q_a; const float* w_q_up; const float* g_kv_a; const float* w_kv_up;
    const float* g_conv_out; const float* g_attn_out; const float* w_out; const float* g_xattn; const float* g_mem; const float* w_xq; const float* w_xk; const float* w_xv; const float* w_xo;
    const float* g_moe; const float* w_group; const float* b_group; const float* w_router; const float* b_router; const float* w_gate; const float* w_up; const float* w_down; const float* g_final;
    float* out; unsigned char* ws; unsigned mask; unsigned flags;
};

template <int MAP> __device__ __forceinline__ int map_row(int n) {
    if (MAP == 1) { if (n < C_KR) return n; const int r = n - C_KR; return C_KR + (r < 32 ? 2 * r : 2 * (r - 32) + 1); }
    if (MAP == 2) { const int h = n / DQK, d = n % DQK; if (d < DN) return n; const int r = d - DN; return h * DQK + DN + (r < 32 ? 2 * r : 2 * (r - 32) + 1); }
    if (MAP == 3) { const int h = n >> 8, d = n & 255; return d < DN ? h * DN + d : NH * DN + h * DV + (d - DN); }
    if (MAP == 4) { return ((n >> 7) << 8) + (n & 127); }
    if (MAP == 5) { return ((n >> 7) << 8) + 128 + (n & 127); }
    return n;
}
template <int MAP, bool HAS_GAIN>
__device__ __forceinline__ void transpose_item(const float* W, int ldw, const float* gain, const float* gain2, int gsplit, bf16_t* WT, int ldo, LAS float* scr, int k0, int n0, int lane) {
    float gv = 1.0f;
    if (HAS_GAIN) { const float* gp = (k0 < gsplit) ? gain + k0 : gain2 + (k0 - gsplit); gv = gp[lane]; }
    const int kr = lane >> 3, nc = (lane & 7) * 4;
    f32x4 v[8];
#pragma unroll
    for (int i = 0; i < 8; ++i) v[i] = NTL((const f32x4*)(W + (size_t)(k0 + 8 * i + kr) * ldw + n0 + nc));
#pragma unroll
    for (int i = 0; i < 8; ++i) { const int kk = 8 * i + kr; float g = 1.0f;
        if (HAS_GAIN) g = __shfl(gv, kk);
        LAS float* d = scr + kk * 33 + nc; d[0] = v[i][0] * g; d[1] = v[i][1] * g; d[2] = v[i][2] * g; d[3] = v[i][3] * g; }
    LDS_WAIT(); asm volatile("" ::: "memory");
    const int c = lane & 7;
#pragma unroll
    for (int j = 0; j < 4; ++j) { const int n = (lane >> 3) + 8 * j; const LAS float* s = scr + (8 * c) * 33 + n;
        u32x4 o; o.x = cvt_pk_bf16(s[0 * 33], s[1 * 33]); o.y = cvt_pk_bf16(s[2 * 33], s[3 * 33]); o.z = cvt_pk_bf16(s[4 * 33], s[5 * 33]); o.w = cvt_pk_bf16(s[6 * 33], s[7 * 33]);
        *(u32x4*)(WT + (size_t)map_row<MAP>(n0 + n) * ldo + k0 + 8 * c) = o; }
    LDS_WAIT(); asm volatile("" ::: "memory");
}
template <int MAP, bool HAS_GAIN>
__device__ __forceinline__ void transpose_item8(const float* W, int ldw, const float* gain, float scale, unsigned char* WT, int ldo, LAS float* scr, int k0, int n0, int lane) {
    float gv = scale;
    if (HAS_GAIN) gv = gain[k0 + lane] * scale;
    const int kr = lane >> 3, nc = (lane & 7) * 4;
    f32x4 v[8];
#pragma unroll
    for (int i = 0; i < 8; ++i) v[i] = NTL((const f32x4*)(W + (size_t)(k0 + 8 * i + kr) * ldw + n0 + nc));
#pragma unroll
    for (int i = 0; i < 8; ++i) { const int kk = 8 * i + kr; const float g = __shfl(gv, kk);
        LAS float* d = scr + kk * 33 + nc; d[0] = v[i][0] * g; d[1] = v[i][1] * g; d[2] = v[i][2] * g; d[3] = v[i][3] * g; }
    LDS_WAIT(); asm volatile("" ::: "memory");
    const int c = lane & 7;
#pragma unroll
    for (int j = 0; j < 4; ++j) { const int n = (lane >> 3) + 8 * j; const LAS float* s = scr + (8 * c) * 33 + n;
        u32x2 o; o.x = pk4_fp8(s[0 * 33], s[1 * 33], s[2 * 33], s[3 * 33]); o.y = pk4_fp8(s[4 * 33], s[5 * 33], s[6 * 33], s[7 * 33]);
        *(u32x2*)(WT + (size_t)map_row<MAP>(n0 + n) * ldo + k0 + 8 * c) = o; }
    LDS_WAIT(); asm volatile("" ::: "memory");
}

struct XItem { const float* W; const float* gain; unsigned char* WT; int ldw, ldo, k0, n0, gu, upoff; float scale; };
constexpr int XP_PITCH = 528, XP_BUF = 128 * XP_PITCH;
static_assert(2 * XP_BUF <= TAB_OFF, "transposer LDS");
__device__ __forceinline__ void xp_load(f32x4 (&v)[8][4], f32x4 (&g)[8], const XItem& x, int wave, int lane) {
    const int nq = (wave & 1) * 64 + lane, kg = wave >> 1;
    if (x.gain) { const float* gp = x.gain + x.k0 + 4 * kg;
#pragma unroll
        for (int j = 0; j < 8; ++j) g[j] = *(const f32x4*)(gp + 16 * j); }
    else {
#pragma unroll
        for (int j = 0; j < 8; ++j) g[j] = (f32x4){1.f, 1.f, 1.f, 1.f}; }
    const float* p = x.W + (size_t)(x.k0 + 4 * kg) * x.ldw + x.n0 + 4 * nq;
#pragma unroll
    for (int j = 0; j < 8; ++j)
#pragma unroll
        for (int r = 0; r < 4; ++r) v[j][r] = __builtin_nontemporal_load((const f32x4*)(p + (size_t)(16 * j + r) * x.ldw));
}
__device__ __forceinline__ void xp_pack(const f32x4 (&v)[8][4], const f32x4 (&g)[8], const XItem& x, LAS unsigned char* buf, int wave, int lane) {
    const int nq = (wave & 1) * 64 + lane, kg = wave >> 1;
    LAS unsigned char* d = buf + nq * XP_PITCH + kg * 128;
#pragma unroll
    for (int j = 0; j < 8; ++j) {
        const f32x4 gs = g[j] * x.scale;
        u32x4 o;
#pragma unroll
        for (int i = 0; i < 4; ++i) o[i] = pk4_fp8(v[j][0][i] * gs[0], v[j][1][i] * gs[1], v[j][2][i] * gs[2], v[j][3][i] * gs[3]);
        *(LAS u32x4*)(d + j * 16) = o;
    }
}
__device__ __forceinline__ void xp_store(const XItem& x, const LAS unsigned char* buf, int wave, int lane) {
    const int c = lane & 7;
#pragma unroll
    for (int u = 0; u < 2; ++u) {
        const int nq = (wave * 2 + u) * 8 + (lane >> 3);
        const LAS unsigned char* s = buf + nq * XP_PITCH + c * 16;
        u32x4 r[4];
#pragma unroll
        for (int q = 0; q < 4; ++q) r[q] = *(const LAS u32x4*)(s + q * 128);
#pragma unroll
        for (int i = 0; i < 4; ++i) { const int n = x.n0 + 4 * nq + i; const int row = x.gu ? ((n >> 7) << 8) + (n & 127) + x.upoff : n;
            __builtin_nontemporal_store((u32x4){r[0][i], r[1][i], r[2][i], r[3][i]}, (u32x4*)(x.WT + (size_t)row * x.ldo + x.k0 + 16 * c)); }
    }
}
__device__ __forceinline__ void row_to_bf16(const float* xrow, bf16_t* orow, float* ssq_out, int lane) {
    const f32x4* xr = (const f32x4*)xrow + lane; f32x4 v[8]; float s = 0.f;
#pragma unroll
    for (int j = 0; j < 8; ++j) { v[j] = NTL(xr + 64 * j); s += (v[j][0] * v[j][0] + v[j][1] * v[j][1]) + (v[j][2] * v[j][2] + v[j][3] * v[j][3]); }
    s = wave_sum(s);
    u32x2* o8 = (u32x2*)orow + lane;
#pragma unroll
    for (int j = 0; j < 8; ++j) { u32x2 w; w.x = cvt_pk_bf16(v[j][0], v[j][1]); w.y = cvt_pk_bf16(v[j][2], v[j][3]); o8[64 * j] = w; }
    if (lane == 0) *ssq_out = s;
}

__device__ __forceinline__ void row_to_f8(const float* xrow, unsigned char* orow, float* ssq_out, int lane) {
    const f32x4* xr = (const f32x4*)xrow + lane; f32x4 v[8]; float s = 0.f;
#pragma unroll
    for (int j = 0; j < 8; ++j) { v[j] = NTL(xr + 64 * j); s += (v[j][0] * v[j][0] + v[j][1] * v[j][1]) + (v[j][2] * v[j][2] + v[j][3] * v[j][3]); }
    s = wave_sum(s);
    unsigned* o4 = (unsigned*)orow + lane;
#pragma unroll
    for (int j = 0; j < 8; ++j) o4[64 * j] = pk4_fp8(v[j][0], v[j][1], v[j][2], v[j][3]);
    if (lane == 0) *ssq_out = s;
}

constexpr int KROW = 400, VROW = 144;
constexpr int KBUF = 64 * KROW, VBUF = 128 * VROW;
constexpr int ATT_K0 = 0, ATT_V0 = 2 * KBUF;
static_assert(2 * KBUF + 2 * VBUF <= RING_BYTES, "attention LDS");
__device__ __forceinline__ void mla_attn_unit(LAS unsigned char* lds, const int wave_id, const bf16_t* qb, const bf16_t* kb, const bf16_t* kr, const bf16_t* vT, bf16_t* oatt, fx64* ssq_att, int b, int h, int qblk) {
    int lane_ = lane_id(); asm volatile("" : "+v"(lane_));
    const int wid = wave_id, lane = lane_, tid = wid * 64 + lane, r32 = lane & 31, hi = lane >> 5;
    const int q0 = qblk * 256 + wid * 32;
    const size_t tok0 = (size_t)b * T;
    bf16x8 qf[12];
    { const bf16_t* qrow = qb + (tok0 + q0 + r32) * (NH * DQK) + h * DQK + hi * 8;
#pragma unroll
      for (int ks = 0; ks < 12; ++ks) qf[ks] = *(const bf16x8*)(qrow + ks * 16); }
    const int kn_r0 = tid >> 4, kn_c = tid & 15;
    const int kr_r = tid >> 3, kr_c = tid & 7;
    const int v_r0 = tid >> 3, v_c = tid & 7;
    const bf16_t* gkn = kb + (tok0 + kn_r0) * (NH * DN) + h * DN + kn_c * 8;
    const bf16_t* gkr = kr + (tok0 + kr_r) * DR + kr_c * 8;
    const bf16_t* gv = vT + (size_t)(h * DV + v_r0) * NTOK + tok0 + v_c * 8;
    const int lkn = kn_r0 * KROW + kn_c * 16, lkr = kr_r * KROW + 256 + kr_c * 16, lv = v_r0 * VROW + v_c * 16;
    const int ntiles = 4 * (qblk + 1);
    u32x4 sk0, sk1, skr, sv0, sv1;
#define ATT_LOAD(j) do { const size_t ko = (size_t)(j) * 64; sk0 = *(const u32x4*)(gkn + ko * (NH * DN)); sk1 = *(const u32x4*)(gkn + (ko + 32) * (NH * DN)); \
        skr = *(const u32x4*)(gkr + ko * DR); sv0 = *(const u32x4*)(gv + ko); sv1 = *(const u32x4*)(gv + ko + (size_t)64 * NTOK); } while (0)
#define ATT_WRITE(bufi) do { LAS unsigned char* kbp = lds + ATT_K0 + (bufi) * KBUF; LAS unsigned char* vbp = lds + ATT_V0 + (bufi) * VBUF; \
        *(LAS u32x4*)(kbp + lkn) = sk0; *(LAS u32x4*)(kbp + lkn + 32 * KROW) = sk1; *(LAS u32x4*)(kbp + lkr) = skr; \
        *(LAS u32x4*)(vbp + lv) = sv0; *(LAS u32x4*)(vbp + lv + 64 * VROW) = sv1; } while (0)
    f32x16 o[4];
#pragma unroll
    for (int d = 0; d < 4; ++d)
#pragma unroll
        for (int r = 0; r < 16; ++r) o[d][r] = 0.f;
    float m_run = -1.0e30f, l_run = 0.f;
    ATT_LOAD(0); ATT_WRITE(0);
    __syncthreads();
    for (int j = 0; j < ntiles; ++j) {
        const int buf = j & 1;
        if (j + 1 < ntiles) ATT_LOAD(j + 1);
        const int jrel = j - 4 * qblk;
        if (jrel <= (wid >> 1)) {
            const LAS unsigned char* kp = lds + ATT_K0 + buf * KBUF + r32 * KROW + hi * 16;
            const LAS unsigned char* vp = lds + ATT_V0 + buf * VBUF + r32 * VROW + hi * 16;
            f32x16 s0, s1;
#pragma unroll
            for (int r = 0; r < 16; ++r) { s0[r] = 0.f; s1[r] = 0.f; }
#pragma unroll
            for (int ks = 0; ks < 12; ++ks) { const bf16x8 a0 = *(const LAS bf16x8*)(kp + ks * 32), a1 = *(const LAS bf16x8*)(kp + 32 * KROW + ks * 32);
                s0 = __builtin_amdgcn_mfma_f32_32x32x16_bf16(a0, qf[ks], s0, 0, 0, 0);
                s1 = __builtin_amdgcn_mfma_f32_32x32x16_bf16(a1, qf[ks], s1, 0, 0, 0); }
            if (jrel == (wid >> 1)) {
                const int qrel = (wid & 1) * 32 + r32;
#pragma unroll
                for (int r = 0; r < 16; ++r) { const int kk = (r & 3) + 8 * (r >> 2) + 4 * hi;
                    if (kk > qrel) s0[r] = -1.0e30f; if (kk + 32 > qrel) s1[r] = -1.0e30f; }
            }
            float mx = s0[0];
#pragma unroll
            for (int r = 1; r < 16; ++r) mx = fmaxf(mx, s0[r]);
#pragma unroll
            for (int r = 0; r < 16; ++r) mx = fmaxf(mx, s1[r]);
            mx = fmaxf(mx, __shfl_xor(mx, 32));
            const float mn = fmaxf(m_run, mx), alpha = __builtin_amdgcn_exp2f(m_run - mn); m_run = mn;
            float ps = 0.f;
#pragma unroll
            for (int r = 0; r < 16; ++r) { s0[r] = __builtin_amdgcn_exp2f(s0[r] - mn); s1[r] = __builtin_amdgcn_exp2f(s1[r] - mn); ps += s0[r] + s1[r]; }
            l_run = l_run * alpha + ps;
#pragma unroll
            for (int d = 0; d < 4; ++d)
#pragma unroll
                for (int r = 0; r < 16; ++r) o[d][r] *= alpha;
            bf16x8 pf[4];
#pragma unroll
            for (int s = 0; s < 4; ++s) { const int base = (s & 1) * 8; u32x4 w;
                if (s < 2) { w.x = cvt_pk_bf16(s0[base + 0], s0[base + 1]); w.y = cvt_pk_bf16(s0[base + 2], s0[base + 3]); w.z = cvt_pk_bf16(s0[base + 4], s0[base + 5]); w.w = cvt_pk_bf16(s0[base + 6], s0[base + 7]); }
                else       { w.x = cvt_pk_bf16(s1[base + 0], s1[base + 1]); w.y = cvt_pk_bf16(s1[base + 2], s1[base + 3]); w.z = cvt_pk_bf16(s1[base + 4], s1[base + 5]); w.w = cvt_pk_bf16(s1[base + 6], s1[base + 7]); }
                pf[s] = *(bf16x8*)&w; }
#pragma unroll
            for (int d = 0; d < 4; ++d)
#pragma unroll
                for (int s = 0; s < 4; ++s) { const bf16x8 vf = *(const LAS bf16x8*)(vp + d * 32 * VROW + s * 32);
                    o[d] = __builtin_amdgcn_mfma_f32_32x32x16_bf16(vf, pf[s], o[d], 0, 0, 0); }
        }
        if (j + 1 < ntiles) ATT_WRITE(buf ^ 1);
        __syncthreads();
    }
#undef ATT_LOAD
#undef ATT_WRITE
    const float l = l_run + __shfl_xor(l_run, 32), inv = 1.0f / l;
    float q = 0.f;
    bf16_t* orow = oatt + (tok0 + q0 + r32) * (NH * DV) + h * DV + 4 * hi;
#pragma unroll
    for (int d = 0; d < 4; ++d)
#pragma unroll
        for (int g = 0; g < 4; ++g) { const float a0 = o[d][4 * g] * inv, a1 = o[d][4 * g + 1] * inv, a2 = o[d][4 * g + 2] * inv, a3 = o[d][4 * g + 3] * inv;
            q += (a0 * a0 + a1 * a1) + (a2 * a2 + a3 * a3);
            u32x2 w; w.x = cvt_pk_bf16(a0, a1); w.y = cvt_pk_bf16(a2, a3); *(u32x2*)(orow + d * 32 + g * 8) = w; }
    q += __shfl_xor(q, 32);
    if (hi == 0) fx_add(ssq_att + tok0 + q0 + r32, q);
}

#define ssq_x ((float*)(ws + CTL_SSQ_X))
#define ssq_q ((fx64*)(ws + CTL_SSQ_Q))
#define ssq_kv ((fx64*)(ws + CTL_SSQ_KV))
#define ssq_att ((fx64*)(ws + CTL_SSQ_ATT))
#define ssq_1 ((fx64*)(ws + CTL_SSQ_1))
#define ssq_mem ((float*)(ws + CTL_SSQ_MEM))
#define cnt ((int*)(ws + CTL_CNT))
#define tab ((f32x2*)(ws + WS_TAB))
#define Wrt ((bf16_t*)(ws + WS_WRT))
#define ssq_2 ((fx64*)(ws + CTL_SSQ_2))
#define x2l ((bf16_t*)(ws + A_X2L))
#define x1l ((bf16_t*)(ws + A_X2L))
#define rslab ((float*)(ws + A_SLAB))
#define tok_eid ((int*)(ws + TOK_EID))
#define tok_gw ((float*)(ws + TOK_GW))
#define tok_rank ((int*)(ws + TOK_RANK))
#define tok_dest ((int*)(ws + TOK_DEST))
#define tok_rstd ((float*)(ws + TOK_RSTD))
#define row_tok ((int*)(ws + ROW_TOK))
#define row_rs ((float*)(ws + ROW_RS))
#define row_w ((float*)(ws + ROW_W))
#define Win_t ((bf16_t*)(ws + WS_WIN))
#define Wq_t ((bf16_t*)(ws + WS_WQ))
#define Wkv_t ((bf16_t*)(ws + WS_WKV))
#define Wout_t ((bf16_t*)(ws + WS_WOUT))
#define Wxq_n ((bf16_t*)(ws + WS_WXQ))
#define Wxk_t ((bf16_t*)(ws + WS_WXK))
#define Wxv_t ((bf16_t*)(ws + WS_WXV))
#define Wxo_t ((bf16_t*)(ws + WS_WXO))
#define Wgu_t ((bf16_t*)(ws + WS_WGU))
#define Wd_t ((bf16_t*)(ws + WS_WD))
#define zb ((bf16_t*)(ws + A_ZB))
#define x1b ((bf16_t*)(ws + A_X1B))
#define qx ((bf16_t*)(ws + A_QX))
#define x2b ((bf16_t*)(ws + A_X2B))
#define actb ((bf16_t*)(ws + A_ACT))
#define xb ((bf16_t*)(ws + A_XB))
#define qb ((bf16_t*)(ws + A_QB))
#define ycat ((bf16_t*)(ws + A_YCAT))
#define pbuf ((bf16_t*)(ws + A_PBUF))
#define kb ((bf16_t*)(ws + A_KB))
#define ox ((bf16_t*)(ws + A_OX))
#define vT ((bf16_t*)(ws + A_VT))
#define oatt ((bf16_t*)(ws + A_OATT))
#define memb ((bf16_t*)(ws + A_MEMB))
#define kx ((bf16_t*)(ws + A_KX))
#define vx ((bf16_t*)(ws + A_VXT))
#define Mt ((bf16_t*)(ws + A_MT))
#define VWt ((bf16_t*)(ws + A_VWT))
#define krope ((bf16_t*)(ws + A_KROPE))
#define ybuf ((bf16_t*)(ws + A_YBUF))
#define x2f8 ((unsigned char*)(ws + ARENA + 90 * MiB))
#define x1f8 x2f8
#define Mt8 ((unsigned char*)(ws + A_MT))
#define VWt8 ((unsigned char*)(ws + A_VWT))
#define P8b ((unsigned char*)(ws + A_PBUF))
#define act8 ((unsigned char*)(ws + A_ACT))
#define Wgu8 ((unsigned char*)(ws + WS_WGU))
#define Wd8 ((unsigned char*)(ws + WS_WD))
typedef const __attribute__((address_space(4))) Args* KArgs;
#define PHASE_ARGS() KArgs ka = (KArgs)__builtin_amdgcn_kernarg_segment_ptr(); asm volatile("" : "+s"(ka)); unsigned char* ws = ka->ws
#define PHASE_IDS() int lane_ = lane_id(); asm volatile("" : "+v"(lane_)); const int lane = lane_, wave = wave_id, tid = wave * 64 + lane; \
    const int gw = vcu * NWAVES + wave, NGW = G * NWAVES, gt = vcu * (NWAVES * 64) + tid, NGT = G * NWAVES * 64; (void)lane; (void)gw; (void)NGW; (void)gt; (void)NGT
__global__ void __launch_bounds__(NWAVES * 64, 2) hymba_fwd(Args a_unused) {
    extern __shared__ __attribute__((aligned(16))) unsigned char lds_raw[];
    LAS unsigned char* lds = (LAS unsigned char*)lds_raw;
    volatile LAS unsigned* MISC = (volatile LAS unsigned*)(lds + MISC_OFF);
    const int wave_id = __builtin_amdgcn_readfirstlane(threadIdx.x >> 6);
    const int G = gridDim.x, bx = blockIdx.x;
    const int vcu = (G % 8 == 0) ? (bx % 8) * (G / 8) + bx / 8 : bx;
    unsigned mask; XcdBarrier bar;
    { PHASE_ARGS(); mask = ka->mask; bar.bar = (unsigned*)(ws + WS_CTL); bar.x = 0; bar.st = nullptr; bar.wave = 0; }
    for (int u = wave_id * 64 + lane_id(); u < (LDS_BYTES - TAB_OFF) / 4; u += NWAVES * 64) ((LAS unsigned*)(lds + TAB_OFF))[u] = 0u;
    __syncthreads();
    const bool one_launch = (mask & (mask - 1u)) != 0u;
    if (one_launch) bar = xcd_barrier_post(bar.bar, MISC, wave_id);
#ifndef CT_MASK
#define CT_MASK 0xffffu
#endif
#define IN(k) ((((CT_MASK) >> (k)) & 1u) != 0u && ((mask >> (k)) & 1u) != 0u)
#define SEL(real, dummy) ((ka->flags & 2u) ? (dummy) : (real))
#define DUMMYF ((float*)(ws + WS_DUMMY))
#define SEAM(k) do { if (IN(k) && (mask >> ((k) + 1)) != 0u) xcd_barrier(bar); } while (0)

    if (IN(0)) {
        PHASE_ARGS();
        PHASE_IDS();
        LAS float* scr = (LAS float*)(lds + wave * 16384);
        constexpr int I_IN = 32 * (IN_COLS / 32);
        for (int it = gw; it < I_IN; it += NGW) { const int nb = it % (IN_COLS / 32), kb_ = it / (IN_COLS / 32); transpose_item<1, true>(ka->w_in, IN_COLS, ka->g_mix, ka->g_mix, DM, Win_t, DM, scr, kb_ * 64, nb * 32, lane); }
        for (int m = gw; m < NTOK; m += NGW) row_to_bf16(ka->x + (size_t)m * DM, xb + (size_t)m * DM, ssq_x + m, lane);
        for (int i = gt; i < NTOK * 32; i += NGT) { const int tok = i >> 5, p = i & 31;
            const float inv_freq = 1.0f / powf(10000.0f, (float)(2 * p) / 64.0f), ang = (float)ka->pos[tok] * inv_freq;
            tab[i] = (f32x2){cosf(ang), sinf(ang)}; }
        for (int i = gt; i < (ZC - IN_COLS) * DM / 8; i += NGT) ((u32x4*)(Win_t + (size_t)IN_COLS * DM))[i] = (u32x4){0u, 0u, 0u, 0u};
    }
    SEAM(0);

    if (IN(1)) {
        PHASE_ARGS();
        PHASE_IDS();
        auto xp_all = [&]() {
            constexpr int NX = 2048 + 1024 + 192;
            auto xitem = [&](int it) -> XItem { XItem x;
                if (it < 2048) { const int e = it >> 5, up = (it >> 4) & 1, kb_ = it & 15;
                    x.W = (up ? ka->w_up : ka->w_gate) + (size_t)e * DM * DE; x.gain = ka->g_moe; x.WT = Wgu8 + (size_t)e * 1024 * DM; x.ldw = DE; x.ldo = DM; x.k0 = kb_ * 128; x.n0 = 0; x.gu = 1; x.upoff = up * 128; x.scale = F8_SW; }
                else if (it < 3072) { const int r = it - 2048, e = r >> 4, kb_ = (r >> 2) & 3, nb = r & 3;
                    x.W = ka->w_down + (size_t)e * DE * DM; x.gain = nullptr; x.WT = Wd8 + (size_t)e * DM * DE; x.ldw = DM; x.ldo = DE; x.k0 = kb_ * 128; x.n0 = nb * 512; x.gu = 0; x.upoff = 0; x.scale = F8_SD; }
                else { const int r = it - 3072, which = r >> 6, kb_ = (r >> 2) & 15, nb = r & 3;
                    x.W = which == 0 ? ka->w_xk : (which == 1 ? ka->w_xv : ka->w_xo); x.gain = which < 2 ? ka->g_mem : nullptr;
                    x.WT = which == 0 ? (unsigned char*)Wxk_t : (which == 1 ? (unsigned char*)Wxv_t : (unsigned char*)Wxo_t); x.ldw = DM; x.ldo = DM; x.k0 = kb_ * 128; x.n0 = nb * 512; x.gu = 0; x.upoff = 0; x.scale = F8_SX; }
                return x; };
            f32x4 v[8][4], gq[8];
            int it = vcu, b = 0;
            XItem cur = xitem(it < NX ? it : 0);
            if (it < NX) xp_load(v, gq, cur, wave, lane);
            while (it < NX) {
                LAS unsigned char* buf = lds + b * XP_BUF;
                xp_pack(v, gq, cur, buf, wave, lane);
                const int nit = it + G;
                XItem nxt = xitem(nit < NX ? nit : 0);
                if (nit < NX) xp_load(v, gq, nxt, wave, lane);
                __syncthreads();
                xp_store(cur, buf, wave, lane);
                cur = nxt; it = nit; b ^= 1;
            }
            __syncthreads();
            { LAS float* scr = (LAS float*)(lds + wave * 16384);
              constexpr int I_Q = 8 * 48, I_KV = 4 * 64, I_SQ = 32 * 64;
              for (int it = gw; it < I_Q + I_KV + I_SQ; it += NGW) {
                  int r = it;
                if (r < I_Q) { const int nb = r % 48, kb_ = r / 48; transpose_item<2, true>(ka->w_q_up, NH * DQK, ka->g_q_a, ka->g_q_a, QL, Wq_t, QL, scr, kb_ * 64, nb * 32, lane); continue; } r -= I_Q;
                if (r < I_KV) { const int nb = r % 64, kb_ = r / 64; transpose_item<3, true>(ka->w_kv_up, NH * (DN + DV), ka->g_kv_a, ka->g_kv_a, KVL, Wkv_t, KVL, scr, kb_ * 64, nb * 32, lane); continue; } r -= I_KV;
                { const int nb = r % 64, kb_ = r / 64; transpose_item<0, true>(ka->w_out, DM, ka->g_conv_out, ka->g_attn_out, CW, Wout_t, DM, scr, kb_ * 64, nb * 32, lane); }
              }
            for (int m = gw; m < NMEM; m += NGW) row_to_f8(ka->mem + (size_t)m * DM, (unsigned char*)memb + (size_t)m * DM, ssq_mem + m, lane);
            for (int i = gt; i < DM * DM / 8; i += NGT) { const int cr = i / (DM / 8); const float g = ka->g_xattn[cr]; const f32x4 p0 = NTL((const f32x4*)ka->w_xq + 2 * i) * g, p1 = NTL((const f32x4*)ka->w_xq + 2 * i + 1) * g;
                const f32x4 q0 = p0 * F8_SX, q1 = p1 * F8_SX; u32x2 w; w.x = pk4_fp8(q0[0], q0[1], q0[2], q0[3]); w.y = pk4_fp8(q1[0], q1[1], q1[2], q1[3]); ((u32x2*)Wxq_n)[i] = w; }
            for (int i = gt; i < 256 * DM; i += NGT) { const int n = i / DM, k = i % DM; unsigned a0 = 0u, a1 = 0u;
                const int c = (n < NRT) ? n : ((n >= 128 && n < 128 + NRT) ? n - 128 : -1);
                if (c >= 0) { const float w = ka->g_moe[k] * (c < NG ? ka->w_group[(size_t)k * NG + c] : ka->w_router[(size_t)k * NE + (c - NG)]);
                    const unsigned hb = cvt_pk_bf16(w, 0.f) & 0xffffu;
                    if (n < 128) { a0 = hb; a1 = hb; } else { a0 = cvt_pk_bf16(w - bf_lo(hb), 0.f) & 0xffffu; } }
                Wrt[(size_t)n * (2 * DM) + k] = (bf16_t)a0; Wrt[(size_t)n * (2 * DM) + DM + k] = (bf16_t)a1; }
            }
            __syncthreads();
        };
        const bool late = ((bx >> 3) & 1) != 0;
        if (!late) xp_all();
        {
            pg8::DenseSched S; S.init(xb, Win_t, DM, DM, NTOK, ZC, G, bx);
            EpiZ E{zb, krope, ssq_x, SEL(ssq_q, (fx64*)DUMMYF), SEL(ssq_kv, (fx64*)DUMMYF + NTOK), tab};
            pg8::gemm_phase<EpiZ, pg8::DenseSched, false>(lds, wave_id, DM, DM, DM, S, E);
        }
        if (late) { __syncthreads(); xp_all(); }
    }
    SEAM(1);

    if (IN(2)) {
        PHASE_ARGS();
        const bool deal = (G == 256);
        const int grp = deal ? (bx >> 6) : -1, c6 = deal ? (bx & 63) : bx, g6 = deal ? 64 : G, gL = g6, cL = c6;
        if (!deal || grp == 0) { pg8::DenseSched S; S.init(memb, Wxk_t, DM, DM, NMEM, DM, gL, cL); S.es = 1; EpiF8Rms E{(unsigned char*)kx, DM, ssq_mem, 1.0f / DM, 1.0f / F8_SX};
          pg8::gemm_phase<EpiF8Rms, pg8::DenseSched, false, 1>(lds, wave_id, DM, DM, DM, S, E); }
        if (!deal || grp == 1) { pg8::DenseSched S; S.init(memb, Wxv_t, DM, DM, NMEM, DM, gL, cL); S.es = 1; EpiF8Rms E{(unsigned char*)vx, DM, ssq_mem, 1.0f / DM, 1.0f / F8_SX};
          pg8::gemm_phase<EpiF8Rms, pg8::DenseSched, false, 1>(lds, wave_id, DM, DM, DM, S, E); }
        { pg8::DenseSched S; S.init(zb + C_Q, Wq_t, ZC, QL, NTOK, NH * DQK, deal ? 128 : G, deal ? (bx & 127) : bx, 0, deal ? (grp >= 2 ? 384 : 0) : -1); EpiQ E{qb, ssq_q, tab};
          pg8::gemm_phase<EpiQ, pg8::DenseSched, false>(lds, wave_id, QL, ZC, QL, S, E); }
        { const int f = grp == 1 ? 128 : (grp == 2 ? 192 : 0), n = grp == 0 ? 128 : ((grp == 1 || grp == 2) ? 64 : 0);
          pg8::DenseSched S; S.init(zb + C_KV, Wkv_t, ZC, KVL, NTOK, NH * DN, g6, c6, deal ? f : 0, deal ? n : -1); EpiBf16<3> E{kb, NH * DN, (const float*)ssq_kv, 1.0f / KVL, 1.0f};
          pg8::gemm_phase<EpiBf16<3>, pg8::DenseSched, false>(lds, wave_id, KVL, ZC, KVL, S, E); }
        { const int f = grp == 1 ? 64 : (grp == 3 ? 192 : 0), n = grp == 0 ? 64 : (grp == 1 ? 128 : (grp == 3 ? 64 : 0));
          pg8::DenseSched S; S.init(Wkv_t + (size_t)NH * DN * KVL, zb + C_KV, KVL, ZC, NH * DV, NTOK, g6, c6, deal ? f : 0, deal ? n : -1); EpiColScale<true> E{vT, NTOK, ssq_kv, 1.0f / KVL};
          pg8::gemm_phase<EpiColScale<true>, pg8::DenseSched, false>(lds, wave_id, KVL, KVL, ZC, S, E); }
    }
    SEAM(2);

    if (IN(3)) {
        PHASE_ARGS();
        PHASE_IDS();
        auto conv_rows = [&]() {
            float wc0[2][8], wc1[2][8], wc2[2][8];
#pragma unroll
            for (int g = 0; g < 2; ++g)
#pragma unroll
                for (int e = 0; e < 8; ++e) { const int c = g * 512 + lane * 8 + e; wc0[g][e] = ka->w_conv[c]; wc1[g][e] = ka->w_conv[CW + c]; wc2[g][e] = ka->w_conv[2 * CW + c]; }
            for (int ch = gw; ch < NTOK / 8; ch += NGW) {
                const int t0 = ch * 8, tl = t0 & (T - 1);
                float u1[2][8], u2[2][8];
#pragma unroll
                for (int g = 0; g < 2; ++g) { const int c = g * 512 + lane * 8;
                    if (tl >= 1) { const u32x4 cg = *(const u32x4*)(zb + (size_t)(t0 - 1) * ZC + CW + c), hg = *(const u32x4*)(zb + (size_t)(t0 - 1) * ZC + 2 * CW + c);
#pragma unroll
                        for (int e = 0; e < 4; ++e) { u1[g][2 * e] = bf_lo(cg[e]) * bf_lo(hg[e]); u1[g][2 * e + 1] = bf_hi(cg[e]) * bf_hi(hg[e]); } }
                    else {
#pragma unroll
                        for (int e = 0; e < 8; ++e) u1[g][e] = 0.f; }
                    if (tl >= 2) { const u32x4 cg = *(const u32x4*)(zb + (size_t)(t0 - 2) * ZC + CW + c), hg = *(const u32x4*)(zb + (size_t)(t0 - 2) * ZC + 2 * CW + c);
#pragma unroll
                        for (int e = 0; e < 4; ++e) { u2[g][2 * e] = bf_lo(cg[e]) * bf_lo(hg[e]); u2[g][2 * e + 1] = bf_hi(cg[e]) * bf_hi(hg[e]); } }
                    else {
#pragma unroll
                        for (int e = 0; e < 8; ++e) u2[g][e] = 0.f; } }
                for (int rp = 0; rp < 8; rp += 2) {
                    u32x4 bg[2][2], cg[2][2], hg[2][2];
#pragma unroll
                    for (int rr = 0; rr < 2; ++rr)
#pragma unroll
                        for (int g = 0; g < 2; ++g) { const size_t row = (size_t)(t0 + rp + rr); const int c = g * 512 + lane * 8;
                            bg[rr][g] = NTL((const u32x4*)(zb + row * ZC + c)); cg[rr][g] = NTL((const u32x4*)(zb + row * ZC + CW + c)); hg[rr][g] = NTL((const u32x4*)(zb + row * ZC + 2 * CW + c)); }
#pragma unroll
                    for (int rr = 0; rr < 2; ++rr) { const size_t row = (size_t)(t0 + rp + rr);
                        float y[2][8]; float q = 0.f;
#pragma unroll
                        for (int g = 0; g < 2; ++g) {
#pragma unroll
                            for (int e = 0; e < 8; ++e) { const float bb = (e & 1) ? bf_hi(bg[rr][g][e >> 1]) : bf_lo(bg[rr][g][e >> 1]), cc = (e & 1) ? bf_hi(cg[rr][g][e >> 1]) : bf_lo(cg[rr][g][e >> 1]), hh = (e & 1) ? bf_hi(hg[rr][g][e >> 1]) : bf_lo(hg[rr][g][e >> 1]);
                                const float u0 = cc * hh, cv = wc0[g][e] * u2[g][e] + wc1[g][e] * u1[g][e] + wc2[g][e] * u0;
                                y[g][e] = bb * cv; q += y[g][e] * y[g][e]; u2[g][e] = u1[g][e]; u1[g][e] = u0; } }
                        q = wave_sum(q);
                        const float rs = 1.0f / sqrtf(q * (1.0f / CW) + EPS);
#pragma unroll
                        for (int g = 0; g < 2; ++g) { const int c = g * 512 + lane * 8;
                            u32x4 w; w.x = cvt_pk_bf16(y[g][0] * rs, y[g][1] * rs); w.y = cvt_pk_bf16(y[g][2] * rs, y[g][3] * rs); w.z = cvt_pk_bf16(y[g][4] * rs, y[g][5] * rs); w.w = cvt_pk_bf16(y[g][6] * rs, y[g][7] * rs);
                            *(u32x4*)(ycat + row * DM + c) = w; } }
                }
            }
        };
        const bool late = ((bx >> 3) & 1) != 0;
        if (!late) conv_rows();
        for (int pp = vcu; pp < NB * NH * 4; pp += G) { const int b = pp >> 5, h = (pp >> 2) & 7, ip = pp & 3;
            mla_attn_unit(lds, wave_id, qb, kb, krope, vT, oatt, SEL(ssq_att, (fx64*)DUMMYF), b, h, 7 - ip);
            mla_attn_unit(lds, wave_id, qb, kb, krope, vT, oatt, SEL(ssq_att, (fx64*)DUMMYF), b, h, ip); }
        if (late) conv_rows();
    }
    SEAM(3);

    if (IN(4)) {
        PHASE_ARGS();
        PHASE_IDS();
        for (int ch = gw; ch < NTOK / 4; ch += NGW) {
            u32x4 og[4][2]; float ra[4];
#pragma unroll
            for (int rr = 0; rr < 4; ++rr) { const size_t row = (size_t)ch * 4 + rr;
#pragma unroll
                for (int g = 0; g < 2; ++g) og[rr][g] = NTL((const u32x4*)(oatt + row * (NH * DV) + g * 512 + lane * 8));
                ra[rr] = 1.0f / sqrtf(fx_get(ssq_att + row) * (1.0f / (NH * DV)) + EPS); }
#pragma unroll
            for (int rr = 0; rr < 4; ++rr) { const size_t row = (size_t)ch * 4 + rr;
#pragma unroll
                for (int g = 0; g < 2; ++g) { u32x4 w2;
#pragma unroll
                    for (int e = 0; e < 4; ++e) w2[e] = cvt_pk_bf16(bf_lo(og[rr][g][e]) * ra[rr], bf_hi(og[rr][g][e]) * ra[rr]);
                    *(u32x4*)(ycat + row * DM + CW + g * 512 + lane * 8) = w2; } }
        }
    }
    SEAM(4);

    if (IN(5)) {
        PHASE_ARGS();
        const bool late = ((bx >> 3) & 1) != 0;
        if (late) {
    #if XATT_FP8
            { MtSched S{(const char*)kx, (const char*)Wxq_n, G, vcu, 1}; EpiF8 E{Mt8, DM, F8_SM * LOG2E * 0.04419417382415922f / F8_SX};
              pg8::gemm_phase<EpiF8, MtSched, false, 1>(lds, wave_id, XD, DM, DM, S, E); }
            { VWtSched S{(const char*)Wxo_t, (const char*)vx, G, vcu, 1}; EpiF8 E{VWt8, XH * MEM, F8_SV / F8_SX};
              pg8::gemm_phase<EpiF8, VWtSched, false, 1>(lds, wave_id, XD, DM, DM, S, E); }
    #else
            { MtSched S{(const char*)kx, (const char*)Wxq_n, G, vcu, 2}; EpiBf16<0> E{Mt, DM, nullptr, 0.f, LOG2E * 0.04419417382415922f};
              pg8::gemm_phase<EpiBf16<0>, MtSched, false>(lds, wave_id, XD, DM, DM, S, E); }
            { VWtSched S{(const char*)Wxo_t, (const char*)vx, G, vcu, 2}; EpiBf16<0> E{VWt, XH * MEM, nullptr, 0.f, 1.0f};
              pg8::gemm_phase<EpiBf16<0>, VWtSched, false>(lds, wave_id, XD, DM, DM, S, E); }
    #endif
        }
        {
            pg8::DenseSched S; S.init(ycat, Wout_t, DM, DM, NTOK, DM, G, bx);
            EpiResidHL<true> E{ka->x, nullptr, nullptr, x1b, x1l, SEL(ssq_1, (fx64*)DUMMYF), XATT_FP8 ? x1f8 : nullptr, 1.0f};
            pg8::gemm_phase<EpiResidHL<true>, pg8::DenseSched, false>(lds, wave_id, DM, DM, DM, S, E);
        }
        if (!late) {
    #if XATT_FP8
            { MtSched S{(const char*)kx, (const char*)Wxq_n, G, vcu, 1}; EpiF8 E{Mt8, DM, F8_SM * LOG2E * 0.04419417382415922f / F8_SX};
              pg8::gemm_phase<EpiF8, MtSched, false, 1>(lds, wave_id, XD, DM, DM, S, E); }
            { VWtSched S{(const char*)Wxo_t, (const char*)vx, G, vcu, 1}; EpiF8 E{VWt8, XH * MEM, F8_SV / F8_SX};
              pg8::gemm_phase<EpiF8, VWtSched, false, 1>(lds, wave_id, XD, DM, DM, S, E); }
    #else
            { MtSched S{(const char*)kx, (const char*)Wxq_n, G, vcu, 2}; EpiBf16<0> E{Mt, DM, nullptr, 0.f, LOG2E * 0.04419417382415922f};
              pg8::gemm_phase<EpiBf16<0>, MtSched, false>(lds, wave_id, XD, DM, DM, S, E); }
            { VWtSched S{(const char*)Wxo_t, (const char*)vx, G, vcu, 2}; EpiBf16<0> E{VWt, XH * MEM, nullptr, 0.f, 1.0f};
              pg8::gemm_phase<EpiBf16<0>, VWtSched, false>(lds, wave_id, XD, DM, DM, S, E); }
    #endif
        }
    }
    SEAM(5);

    if (IN(7)) {
        PHASE_ARGS();
#if XATT_FP8
        CrossSSched S{(const char*)x1f8, (const char*)Mt8, G, vcu, 1};
        EpiSoftmax E{pbuf, XH * MEM, (LAS float*)(lds + EPI_OFF), (LAS float*)(lds + EPI_OFF + 4096), ssq_1, 1.0f / DM, 1.0f / F8_SM, P8b};
        pg8::gemm_phase<EpiSoftmax, CrossSSched, false, 1>(lds, wave_id, DM, DM, DM, S, E);
#else
        CrossSSched S{(const char*)x1b, (const char*)Mt, G, vcu, 2};
        EpiSoftmax E{pbuf, XH * MEM, (LAS float*)(lds + EPI_OFF), (LAS float*)(lds + EPI_OFF + 4096), ssq_1, 1.0f / DM, 1.0f, nullptr};
        pg8::gemm_phase<EpiSoftmax, CrossSSched, false>(lds, wave_id, DM, DM, DM, S, E);
#endif
    }
    SEAM(7);

    if (IN(9)) {
        PHASE_ARGS();
        { PHASE_IDS(); for (int i = gt; i < DM / 8; i += NGT) ((u32x4*)(x2b + (size_t)NTOK * DM))[i] = (u32x4){0u, 0u, 0u, 0u};
          if (MOE_FP8) for (int i = gt; i < DM / 16; i += NGT) ((u32x4*)(x2f8 + (size_t)NTOK * DM))[i] = (u32x4){0u, 0u, 0u, 0u}; }
#if XATT_FP8
        CrossOSched S{(const char*)P8b, (const char*)VWt8, G, vcu, 1};
        EpiResidHL<false> E{nullptr, x1b, x1l, SEL(x2b, (bf16_t*)DUMMYF), SEL(x2l, (bf16_t*)DUMMYF + (size_t)NTOK * DM), SEL(ssq_2, (fx64*)DUMMYF), MOE_FP8 ? x2f8 : nullptr, 1.0f / (F8_SP * F8_SV)};
        pg8::gemm_phase<EpiResidHL<false>, CrossOSched, false, 1>(lds, wave_id, XH * MEM, XH * MEM, XH * MEM, S, E);
#else
        CrossOSched S{(const char*)pbuf, (const char*)VWt, G, vcu, 2};
        EpiResidHL<false> E{nullptr, x1b, x1l, SEL(x2b, (bf16_t*)DUMMYF), SEL(x2l, (bf16_t*)DUMMYF + (size_t)NTOK * DM), SEL(ssq_2, (fx64*)DUMMYF), MOE_FP8 ? x2f8 : nullptr, 1.0f};
        pg8::gemm_phase<EpiResidHL<false>, CrossOSched, false>(lds, wave_id, XH * MEM, XH * MEM, XH * MEM, S, E);
#endif
    }
    SEAM(9);

    if (IN(10)) {
        PHASE_ARGS();
        RouterSched S{(const char*)x2b, (const char*)x2l, (const char*)Wrt, G, bx};
        EpiRouter E{rslab};
        pg8::gemm_phase<EpiRouter, RouterSched, false>(lds, wave_id, 1024, DM, 2 * DM, S, E);
    }
    SEAM(10);

    if (IN(11)) {
        PHASE_ARGS();
        PHASE_IDS();
        for (int i = gt; i < LROWS; i += NGT) { row_tok[i] = NTOK; row_rs[i] = 0.f; row_w[i] = 0.f; }
        for (int tok = gt; tok < NTOK; tok += NGT) {
            const float rstd = 1.0f / sqrtf(fx_get(ssq_2 + tok) * (1.0f / DM) + EPS);
            f32x4 g0 = (f32x4){0.f, 0.f, 0.f, 0.f}, g1 = g0;
#pragma unroll
            for (int kq = 0; kq < 4; ++kq) { const float* p = rslab + ((size_t)kq * NTOK + tok) * 96; g0 += *(const f32x4*)p; g1 += *(const f32x4*)(p + 4); }
            float gl[8] = {g0[0], g0[1], g0[2], g0[3], g1[0], g1[1], g1[2], g1[3]};
#pragma unroll
            for (int j = 0; j < 8; ++j) gl[j] = gl[j] * rstd + ka->b_group[j];
            int gi = 0; float gm = gl[0];
#pragma unroll
            for (int j = 1; j < 8; ++j) if (gl[j] > gm) { gm = gl[j]; gi = j; }
            float gs = 0.f;
#pragma unroll
            for (int j = 0; j < 8; ++j) gs += __expf(gl[j] - gm);
            const float gp = 1.0f / gs;
            f32x4 e0 = (f32x4){0.f, 0.f, 0.f, 0.f}, e1v = e0;
#pragma unroll
            for (int kq = 0; kq < 4; ++kq) { const float* p = rslab + ((size_t)kq * NTOK + tok) * 96 + NG + gi * 8; e0 += *(const f32x4*)p; e1v += *(const f32x4*)(p + 4); }
            const f32x4 b0 = *(const f32x4*)(ka->b_router + gi * 8), b1 = *(const f32x4*)(ka->b_router + gi * 8 + 4);
            float el[8] = {e0[0], e0[1], e0[2], e0[3], e1v[0], e1v[1], e1v[2], e1v[3]};
            const float bl[8] = {b0[0], b0[1], b0[2], b0[3], b1[0], b1[1], b1[2], b1[3]};
#pragma unroll
            for (int j = 0; j < 8; ++j) el[j] = el[j] * rstd + bl[j];
            int i1 = 0; float e1 = el[0];
#pragma unroll
            for (int j = 1; j < 8; ++j) if (el[j] > e1) { e1 = el[j]; i1 = j; }
            int i2 = 0; float e2 = -3.0e38f;
#pragma unroll
            for (int j = 0; j < 8; ++j) if (j != i1 && el[j] > e2) { e2 = el[j]; i2 = j; }
            const float t1 = 1.0f / (1.0f + __expf(e2 - e1)), t2 = 1.0f - t1;
            if (!(ka->flags & 2u)) { const int E1 = gi * 8 + i1, E2 = gi * 8 + i2;
                const int k1 = atomicAdd(cnt + E1, 1), k2 = atomicAdd(cnt + E2, 1);
                tok_eid[2 * tok] = E1; tok_eid[2 * tok + 1] = E2; tok_gw[2 * tok] = gp * t1; tok_gw[2 * tok + 1] = gp * t2; tok_rank[2 * tok] = k1; tok_rank[2 * tok + 1] = k2; tok_rstd[tok] = rstd; }
        }
    }
    SEAM(11);

    LAS int* t_start = (LAS int*)(lds + TAB_OFF); LAS int* t_blk = t_start + 64;
    if (IN(12) || IN(13) || IN(14)) {
        PHASE_ARGS();
        if (wave_id == 0 && lane_id() == 0) { int s = 0; for (int e = 0; e < NE; ++e) { const int c = __hip_atomic_load(cnt + e, __ATOMIC_RELAXED, __HIP_MEMORY_SCOPE_AGENT), nb = (c + 255) >> 8; t_start[e] = s * 256; for (int k = 0; k < nb; ++k) t_blk[s + k] = e; s += nb; }
            MISC[8] = (unsigned)s; }
        __syncthreads();
    }
    const int nblk = (int)MISC[8];

    if (IN(12)) {
        PHASE_ARGS();
        PHASE_IDS();
        for (int s = gt; s < NTOK * 2; s += NGT) { const int tok = s >> 1, e = tok_eid[s], d = t_start[e] + tok_rank[s];
            row_tok[d] = tok; row_rs[d] = tok_rstd[tok]; row_w[d] = tok_gw[s]; tok_dest[s] = d; }
    }
    SEAM(12);

    if (IN(13)) {
        PHASE_ARGS();
#if MOE_FP8
        MoeSched S{(const char*)x2f8, (const char*)Wgu8, row_tok, t_blk, nblk * 4, 2, G, vcu, 0, (size_t)1024 * DM, (size_t)256 * DM, 128, (unsigned)DM};
        EpiGateUp8 E{act8, row_rs};
        pg8::gemm_phase<EpiGateUp8, MoeSched, true, 1>(lds, wave_id, DM, DM, DM, S, E);
#else
        MoeSched S{(const char*)x2b, (const char*)Wgu_t, row_tok, t_blk, nblk * 4, 2, G, vcu, 0, (size_t)1024 * DM * 2, (size_t)256 * DM * 2, 128, (unsigned)(DM * 2)};
        EpiGateUp E{actb, row_rs};
        pg8::gemm_phase<EpiGateUp, MoeSched, true>(lds, wave_id, DM, DM, DM, S, E);
#endif
    }
    SEAM(13);

    if (IN(14)) {
        PHASE_ARGS();
#if MOE_FP8
        MoeSched S{(const char*)act8, (const char*)Wd8, row_tok, t_blk, nblk * 8, 3, G, vcu, (size_t)256 * DE, (size_t)DM * DE, (size_t)256 * DE, 256, 0u};
        EpiF8Row E{(unsigned char*)ybuf, DM, row_w, F8_SY / (F8_SACT * F8_SD)};
        pg8::gemm_phase<EpiF8Row, MoeSched, false, 1>(lds, wave_id, DE, DE, DE, S, E);
#else
        MoeSched S{(const char*)actb, (const char*)Wd_t, row_tok, t_blk, nblk * 8, 3, G, vcu, (size_t)256 * DE * 2, (size_t)DM * DE * 2, (size_t)256 * DE * 2, 256, 0u};
        EpiBf16<2> E{ybuf, DM, row_w, 0.f, 1.0f};
        pg8::gemm_phase<EpiBf16<2>, MoeSched, false>(lds, wave_id, DE, DE, DE, S, E);
#endif
    }
    SEAM(14);

    if (IN(15)) {
        PHASE_ARGS();
        PHASE_IDS();
        for (int m = gw; m < NTOK; m += NGW) {
            f32x4* xr = (f32x4*)(ka->out + (size_t)m * DM) + lane; f32x4 v[8]; float s = 0.f;
            const u32x2* xh_ = (const u32x2*)(x2b + (size_t)m * DM) + lane; const u32x2* xl_ = (const u32x2*)(x2l + (size_t)m * DM) + lane;
            const bool moe = (ka->flags & 1u) != 0u;
            const int d0 = moe ? tok_dest[2 * m] : 0, d1 = moe ? tok_dest[2 * m + 1] : 0;
#if MOE_FP8
            const unsigned* y0 = (const unsigned*)((const unsigned char*)ybuf + (size_t)d0 * DM) + lane; const unsigned* y1 = (const unsigned*)((const unsigned char*)ybuf + (size_t)d1 * DM) + lane;
#else
            const u32x2* y0 = (const u32x2*)(ybuf + (size_t)d0 * DM) + lane; const u32x2* y1 = (const u32x2*)(ybuf + (size_t)d1 * DM) + lane;
#endif
#pragma unroll
            for (int j = 0; j < 8; ++j) { const u32x2 h = NTL(xh_ + 64 * j), l = NTL(xl_ + 64 * j);
                v[j] = (f32x4){bf_lo(h.x) + bf_lo(l.x), bf_hi(h.x) + bf_hi(l.x), bf_lo(h.y) + bf_lo(l.y), bf_hi(h.y) + bf_hi(l.y)};
#if MOE_FP8
                if (moe) { const int p0 = (int)NTL(y0 + 64 * j), p1 = (int)NTL(y1 + 64 * j);
                    const f32x2 a0 = __builtin_amdgcn_cvt_pk_f32_fp8(p0, false), a1 = __builtin_amdgcn_cvt_pk_f32_fp8(p0, true), b0 = __builtin_amdgcn_cvt_pk_f32_fp8(p1, false), b1 = __builtin_amdgcn_cvt_pk_f32_fp8(p1, true);
                    v[j][0] += (a0.x + b0.x) * (1.0f / F8_SY); v[j][1] += (a0.y + b0.y) * (1.0f / F8_SY); v[j][2] += (a1.x + b1.x) * (1.0f / F8_SY); v[j][3] += (a1.y + b1.y) * (1.0f / F8_SY); }
#else
                if (moe) { const u32x2 p0 = y0[64 * j], p1 = y1[64 * j];
                    v[j][0] += bf_lo(p0.x) + bf_lo(p1.x); v[j][1] += bf_hi(p0.x) + bf_hi(p1.x); v[j][2] += bf_lo(p0.y) + bf_lo(p1.y); v[j][3] += bf_hi(p0.y) + bf_hi(p1.y); }
#endif
                s += (v[j][0] * v[j][0] + v[j][1] * v[j][1]) + (v[j][2] * v[j][2] + v[j][3] * v[j][3]); }
            s = wave_sum(s); const float rs = 1.0f / sqrtf(s * (1.0f / DM) + EPS);
            const f32x4* gf = (const f32x4*)ka->g_final + lane;
#pragma unroll
            for (int j = 0; j < 8; ++j) NTS(v[j] * rs * gf[64 * j], xr + 64 * j);
        }
    }
#undef IN
#undef SEAM
}

extern "C" void kernel_launch(void* const* d_in, const int* in_sizes, int n_in, void* d_out, int out_size, void* d_ws, size_t ws_size, hipStream_t stream) {
    static int grid = 0;
    if (grid == 0) {
        if (n_in != 28 || out_size != NTOK * DM || ws_size < WS_NEED) { fprintf(stderr, "kernel_launch: unexpected shapes (n_in %d, out %d, ws %zu < %zu)\n", n_in, out_size, ws_size, (size_t)WS_NEED); grid = -1; return; }
        int dev = 0, cus = 0, per_cu = 0;
        if (hipGetDevice(&dev) != hipSuccess || hipDeviceGetAttribute(&cus, hipDeviceAttributeMultiprocessorCount, dev) != hipSuccess) { grid = -1; return; }
        if (hipFuncSetAttribute((const void*)hymba_fwd, hipFuncAttributeMaxDynamicSharedMemorySize, LDS_BYTES) != hipSuccess) { fprintf(stderr, "kernel_launch: hipFuncSetAttribute failed\n"); grid = -1; return; }
        if (hipOccupancyMaxActiveBlocksPerMultiprocessor(&per_cu, (const void*)hymba_fwd, NWAVES * 64, LDS_BYTES) != hipSuccess || per_cu < 1) { fprintf(stderr, "kernel_launch: occupancy query says %d\n", per_cu); (void)hipGetLastError(); grid = -1; return; }
        grid = cus;
    }
    if (grid < 0) return;
    (void)hipMemsetAsync((char*)d_ws + WS_CTL, 0, CTL_BYTES, stream);
    Args a{};
    a.x = (const float*)d_in[0]; a.mem = (const float*)d_in[1]; a.pos = (const int*)d_in[2]; a.g_mix = (const float*)d_in[3]; a.w_in = (const float*)d_in[4]; a.w_conv = (const float*)d_in[5];
    a.g_q_a = (const float*)d_in[6]; a.w_q_up = (const float*)d_in[7]; a.g_kv_a = (const float*)d_in[8]; a.w_kv_up = (const float*)d_in[9]; a.g_conv_out = (const float*)d_in[10]; a.g_attn_out = (const float*)d_in[11];
    a.w_out = (const float*)d_in[12]; a.g_xattn = (const float*)d_in[13]; a.g_mem = (const float*)d_in[14]; a.w_xq = (const float*)d_in[15]; a.w_xk = (const float*)d_in[16]; a.w_xv = (const float*)d_in[17]; a.w_xo = (const float*)d_in[18];
    a.g_moe = (const float*)d_in[19]; a.w_group = (const float*)d_in[20]; a.b_group = (const float*)d_in[21]; a.w_router = (const float*)d_in[22]; a.b_router = (const float*)d_in[23];
    a.w_gate = (const float*)d_in[24]; a.w_up = (const float*)d_in[25]; a.w_down = (const float*)d_in[26]; a.g_final = (const float*)d_in[27];
    a.out = (float*)d_out; a.ws = (unsigned char*)d_ws;
    a.flags = ((PH_MASK >> 14) & 1u) ? 1u : 0u;
#if N_LAUNCH_SPLIT
    for (int p = 0; p < 16; ++p) { if (!((PH_MASK >> p) & 1u)) continue; a.mask = 1u << p;
        if ((DUP_MASK >> p) & 1u) { a.flags |= 2u; for (int rep_ = 0; rep_ < DUP_COUNT; ++rep_) hipLaunchKernelGGL(hymba_fwd, dim3(grid), dim3(NWAVES * 64), LDS_BYTES, stream, a); a.flags &= ~2u; }
        hipLaunchKernelGGL(hymba_fwd, dim3(grid), dim3(NWAVES * 64), LDS_BYTES, stream, a); }
#else
    a.mask = PH_MASK;
    hipLaunchKernelGGL(hymba_fwd, dim3(grid), dim3(NWAVES * 64), LDS_BYTES, stream, a);
#endif
}
```

```cpp
#include <hip/hip_runtime.h>
#include <cstdio>
#include <cstdint>

#define LAS __attribute__((address_space(3)))
typedef unsigned short bf16_t;
typedef short bf16x8 __attribute__((ext_vector_type(8)));
typedef float f32x2 __attribute__((ext_vector_type(2)));
typedef float f32x4 __attribute__((ext_vector_type(4)));
typedef float f32x16 __attribute__((ext_vector_type(16)));
typedef unsigned u32x2 __attribute__((ext_vector_type(2)));
typedef unsigned u32x4 __attribute__((ext_vector_type(4)));

#ifndef PH_MASK
#define PH_MASK 0xfebfu
#endif
#ifndef DUP_MASK
#define DUP_MASK 0u
#endif
#ifndef DUP_COUNT
#define DUP_COUNT 1
#endif
#ifndef MOE_FP8
#define MOE_FP8 1
#endif
#ifndef XATT_FP8
#define XATT_FP8 1
#endif
#ifndef X1_LO
#define X1_LO 0
#endif
#ifndef X2_LO
#define X2_LO 0
#endif
#ifndef N_LAUNCH_SPLIT
#define N_LAUNCH_SPLIT 0
#endif

constexpr int NB = 8, T = 2048, DM = 2048, NTOK = NB * T;
constexpr int MEM = 256, NMEM = NB * MEM;
constexpr int CW = 1024;
constexpr int NH = 8, DN = 128, DR = 64, DV = 128, DQK = DN + DR;
constexpr int QL = 512, KVL = 256;
constexpr int ZC = 4096;
constexpr int C_Q = 3072, C_KV = 3584, C_KR = 3840, IN_COLS = 3904;
constexpr int XH = 4, XD = 512;
constexpr int NG = 8, EPG = 8, NE = 64, DE = 512, NRT = NG + NE;
constexpr int LROWS = (NTOK * 2 / 256 + NE) * 256;
constexpr float EPS = 1e-6f;
constexpr float LOG2E = 1.4426950408889634f;

constexpr size_t MiB = 1u << 20;
constexpr size_t WS_CTL = 0, CTL_BYTES = 1 * MiB;
constexpr size_t CTL_XQ = 148 * 1024;
constexpr size_t CTL_SSQ_X = 64 * 1024, CTL_SSQ_MEM = 128 * 1024, CTL_CNT = 144 * 1024;
constexpr size_t CTL_SSQ_Q = 256 * 1024, CTL_SSQ_KV = 384 * 1024, CTL_SSQ_ATT = 512 * 1024, CTL_SSQ_1 = 640 * 1024, CTL_SSQ_2 = 768 * 1024;
constexpr size_t WS_TAB = 1 * MiB;
constexpr size_t WS_WRT = 5 * MiB;
constexpr size_t WS_TOKI = 6 * MiB;
constexpr size_t TOK_EID = WS_TOKI, TOK_GW = TOK_EID + 128 * 1024, TOK_RANK = TOK_GW + 128 * 1024, TOK_DEST = TOK_RANK + 128 * 1024, TOK_RSTD = TOK_DEST + 128 * 1024;
constexpr size_t ROW_TOK = TOK_RSTD + 64 * 1024, ROW_RS = ROW_TOK + 192 * 1024, ROW_W = ROW_RS + 192 * 1024;
constexpr size_t WS_WIN = 8 * MiB, WS_WQ = 24 * MiB, WS_WKV = 26 * MiB, WS_WOUT = 28 * MiB, WS_WXQ = 36 * MiB, WS_WXK = 44 * MiB, WS_WXV = 52 * MiB, WS_WXO = 60 * MiB;
constexpr size_t WS_WGU = 68 * MiB, WS_WD = 324 * MiB, ARENA = 452 * MiB;
constexpr size_t A_ZB = ARENA, A_X1B = ARENA, A_QX = ARENA + 64 * MiB, A_X2B = ARENA, A_ACT = ARENA + 65 * MiB;
constexpr size_t A_XB = ARENA + 448 * MiB, A_QB = ARENA + 128 * MiB, A_YCAT = ARENA + 384 * MiB, A_PBUF = A_QB;
constexpr size_t A_KB = ARENA + 192 * MiB, A_OX = A_KB, A_VT = ARENA + 224 * MiB, A_OATT = ARENA + 256 * MiB;
constexpr size_t A_MEMB = ARENA + 288 * MiB, A_KX = A_MEMB + 8 * MiB, A_VXT = A_MEMB + 16 * MiB, A_KROPE = A_MEMB + 24 * MiB;
constexpr size_t A_X2L = ARENA + 192 * MiB;
constexpr size_t A_SLAB = ARENA + 256 * MiB;
constexpr size_t A_MT = ARENA + 320 * MiB, A_VWT = ARENA + 352 * MiB;
constexpr size_t A_YBUF = ARENA + 256 * MiB;
constexpr size_t WS_END = ARENA + 512 * MiB;
constexpr size_t WS_DUMMY = WS_END;
constexpr size_t WS_NEED = (DUP_MASK != 0u) ? WS_END + 128 * MiB : WS_END;

constexpr int RING_BYTES = 131072;
constexpr int EPI_OFF = RING_BYTES;
constexpr int TAB_OFF = EPI_OFF + 8192;
constexpr int MISC_OFF = TAB_OFF + 1024;
constexpr int LDS_BYTES = 147456;
static_assert(MISC_OFF + 256 <= LDS_BYTES, "LDS map");
constexpr int NWAVES = 8;

__device__ __forceinline__ int lane_id() { return (int)__builtin_amdgcn_mbcnt_hi(~0u, __builtin_amdgcn_mbcnt_lo(~0u, 0u)); }
__device__ __forceinline__ unsigned cvt_pk_bf16(float lo, float hi) { unsigned r; asm volatile("v_cvt_pk_bf16_f32 %0, %1, %2" : "=v"(r) : "v"(lo), "v"(hi)); return r; }
__device__ __forceinline__ float bf_lo(unsigned w) { return __uint_as_float(w << 16); }
__device__ __forceinline__ float bf_hi(unsigned w) { return __uint_as_float(w & 0xffff0000u); }
__device__ __forceinline__ float wave_sum(float v) {
#pragma unroll
    for (int o = 1; o < 64; o <<= 1) v += __shfl_xor(v, o);
    return v;
}
typedef unsigned long long fx64;
__device__ __forceinline__ void fx_add(fx64* p, float q) { atomicAdd(p, (fx64)(q * 4294967296.0f)); }
__device__ __forceinline__ float fx_get(const fx64* p) { return (float)(*p) * 2.3283064365386963e-10f; }
__device__ __forceinline__ unsigned pk4_fp8(float a, float b, float c, float d) { int w = __builtin_amdgcn_cvt_pk_fp8_f32(a, b, 0, false); w = __builtin_amdgcn_cvt_pk_fp8_f32(c, d, w, true); return (unsigned)w; }
constexpr float F8_SX = 64.0f, F8_SW = 64.0f, F8_SD = 32.0f, F8_SACT = 16.0f, F8_SY = 16.0f, F8_SM = 32.0f, F8_SV = 4.0f, F8_SP = 256.0f;
#define LDS_WAIT() asm volatile("s_waitcnt lgkmcnt(0)" ::: "memory")
#define NTL(p) __builtin_nontemporal_load(p)
#define NTS(v, p) __builtin_nontemporal_store(v, p)
#define VM_WAIT() asm volatile("s_waitcnt vmcnt(0)" ::: "memory")

#define XB_TMO      128
#define XB_XCNT(j)  (256  + 64 * (j))
#define XB_XSUB(j)  (1280 + 64 * (j))
#define XB_XGEN(j)  (2304 + 64 * (j))
#define XB_TOP      3328
#define XB_TOPGEN   3392
#define XCD_BAR_WORDS 3456
#define XB_SPIN_CAP (1u << 18)
__device__ __forceinline__ unsigned xb_ld(unsigned* p)              { return __hip_atomic_load(p, __ATOMIC_RELAXED, __HIP_MEMORY_SCOPE_AGENT); }
__device__ __forceinline__ unsigned xb_add(unsigned* p, unsigned v) { return __hip_atomic_fetch_add(p, v, __ATOMIC_RELAXED, __HIP_MEMORY_SCOPE_AGENT); }
__device__ __forceinline__ unsigned xb_xcc_id() { return (unsigned)__builtin_amdgcn_s_getreg((3 << 11) | 20) & 0xFu; }
#define XB_SPIN(cond, bar) do { unsigned _sp = 0; while (cond) { __builtin_amdgcn_s_sleep(1); \
    if ((++_sp & 255u) == 0u) { if (xb_ld(&(bar)[XB_TMO])) break; if (_sp > XB_SPIN_CAP) { atomicAdd(&(bar)[XB_TMO], 1u); break; } } } } while (0)
struct XcdBarrier { unsigned* bar; unsigned x; volatile LAS unsigned* st; int wave; };
#define XB_THREAD0(b) ((b).wave == 0 && lane_id() == 0)
__device__ __forceinline__ XcdBarrier xcd_barrier_post(unsigned* bar, volatile LAS unsigned* st, int wave) {
    XcdBarrier b; b.bar = bar; b.x = xb_xcc_id(); b.st = st; b.wave = wave;
    if (XB_THREAD0(b)) (void)xb_add(&bar[XB_XCNT(b.x)], 1u);
    return b;
}
__device__ __forceinline__ void xcd_barrier_complete(unsigned* bar, unsigned x, unsigned& nloc, unsigned& nx) {
    const unsigned G = gridDim.x * gridDim.y * gridDim.z;
    unsigned sum, cnt, mine, sp = 0u;
    for (;;) {
        sum = 0u; cnt = 0u; mine = 0u;
#pragma unroll
        for (unsigned j = 0; j < 16; ++j) { const unsigned c = xb_ld(&bar[XB_XCNT(j)]); sum += c; cnt += (c > 0u) ? 1u : 0u; mine = (j == x) ? c : mine; }
        if (sum == G) break;
        __builtin_amdgcn_s_sleep(1);
        if ((++sp & 255u) == 0u) { if (xb_ld(&bar[XB_TMO])) break; if (sp > XB_SPIN_CAP) { atomicAdd(&bar[XB_TMO], 1u); break; } }
    }
    nloc = mine > 0u ? mine : 1u; nx = cnt > 0u ? cnt : 1u;
}
__device__ __forceinline__ void xcd_barrier(const XcdBarrier& b) {
    asm volatile("s_waitcnt vmcnt(0)" ::: "memory");
    __syncthreads();
    if (XB_THREAD0(b)) {
        unsigned* bar = b.bar;
        __builtin_amdgcn_s_waitcnt(0);
        unsigned nloc = b.st[0], nx = b.st[1];
        if (nloc == 0u) { xcd_barrier_complete(bar, b.x, nloc, nx); b.st[0] = nloc; b.st[1] = nx; }
        const unsigned old = xb_add(&bar[XB_XSUB(b.x)], 1u);
        const unsigned gen = old / nloc;
        if (old + 1u == (gen + 1u) * nloc) {
            __builtin_amdgcn_fence(__ATOMIC_RELEASE, "agent");
            asm volatile("s_waitcnt vmcnt(0)" ::: "memory");
            const unsigned og = xb_add(&bar[XB_TOP], 1u);
            const unsigned tg = og / nx;
            if (og + 1u == (tg + 1u) * nx) xb_add(&bar[XB_TOPGEN], 1u);
            else XB_SPIN(xb_ld(&bar[XB_TOPGEN]) == tg, bar);
            __builtin_amdgcn_fence(__ATOMIC_ACQUIRE, "agent");
            xb_add(&bar[XB_XGEN(b.x)], 1u);
            asm volatile("s_waitcnt vmcnt(0)" ::: "memory");
        } else {
            XB_SPIN(xb_ld(&bar[XB_XGEN(b.x)]) == gen, bar);
            __builtin_amdgcn_fence(__ATOMIC_ACQUIRE, "agent");
            asm volatile("s_waitcnt vmcnt(0)" ::: "memory");
        }
    }
    __syncthreads();
}

namespace pg8 {
constexpr int BM = 256, BK = 64, HALF = 128, HTB = HALF * BK * 2, STAGE_BYTES = 8 * HTB, NXCD = 8, WGM = 8;
__host__ __device__ __forceinline__ int lds_byte(int r, int c) { return (r >> 3) * 1024 + (r & 7) * 128 + ((((c >> 3) ^ (r & 7)) & 7) << 4) + (c & 7) * 2; }
__host__ __device__ __forceinline__ void stage_rc(int b, int& R, int& C) { const int s = b >> 10, sb = b & 1023, ri = sb >> 7, p = (sb >> 4) & 7; R = s * 8 + ri; C = ((p ^ ri) << 3) + ((sb & 15) >> 1); }
__host__ __device__ __forceinline__ int perm32(int rho) { const int n = rho >> 4, i = rho & 15; return 8 * (i >> 2) + 4 * n + (i & 3); }

struct Unit { const char* A; const char* B; int orow, ocol, aux; };

template <class Epi, class Sched, bool GATHER, int ES = 2>
__device__ __forceinline__ void gemm_phase(LAS unsigned char* lds, const int wave_id, const int K, const int lda, const int ldb, const Sched& S, const Epi& E) {
    int lane_ = lane_id(); asm volatile("" : "+v"(lane_));
    const int wid = wave_id, lane = lane_, tid = wid * 64 + lane, wr = wid >> 2, wc = wid & 3, fr = lane & 15, fq = lane >> 4;
    const int nt = (K * ES) / (BK * 2);
    unsigned voffA, voffB; int Rr[2], Cb[2];
    { int R, C; stage_rc(tid * 16, R, C); const int Rb = (int)Epi::PERM == 2 ? (64 * (R >> 5) + 16 * ((R >> 2) & 3) + 4 * ((R >> 4) & 1) + (R & 3)) : (Epi::PERM ? ((R & ~31) + perm32(R & 31)) : R);
      voffA = (unsigned)(R * lda * ES + C * 2); voffB = (unsigned)(Rb * ldb * ES + C * 2); Rr[0] = R; Rr[1] = R + 64; Cb[0] = C * 2; Cb[1] = C * 2; }
    const size_t pstepA = (size_t)64 * lda * ES, pstepB = (size_t)((int)Epi::PERM == 2 ? 128 : 64) * ldb * ES;
    const size_t kstep = (size_t)(BK * 2);
    const size_t hstepA = GATHER ? 0 : (size_t)HALF * lda * ES, hstepB = (size_t)((int)Epi::PERM == 2 ? 8 : HALF) * ldb * ES;
    const unsigned ldsw = (unsigned)wid * 1024u;
    const int aoff0 = lds_byte(wr * 64 + fr, fq * 8), boff0 = lds_byte(wc * 32 + fr, fq * 8);
    unsigned oc[2][2], on[2][2], ox[2][2];
#define PG8_SA(b, h) (((b) * 2 + (h)) * HTB)
#define PG8_SB(b, h) ((4 + (b) * 2 + (h)) * HTB)
#define PG8_STAGE(bufoff, gbase, voff) do { _Pragma("unroll") for (int _i = 0; _i < 2; ++_i) \
        __builtin_amdgcn_global_load_lds((const unsigned*)((const char*)(gbase) + (voff)[_i]), (LAS unsigned*)(lds + (bufoff) + ldsw + _i * 8192), 16, 0, 0); } while (0)
#define PG8_STAGE1(bufoff, gbase, voff, pstep) do { _Pragma("unroll") for (int _i = 0; _i < 2; ++_i) \
        __builtin_amdgcn_global_load_lds((const unsigned*)((const char*)(gbase) + _i * (pstep) + (voff)), (LAS unsigned*)(lds + (bufoff) + ldsw + _i * 8192), 16, 0, 0); } while (0)
#define PG8_STAGE_A(bufoff, gbase, h, SET) do { if constexpr (GATHER) { PG8_STAGE(bufoff, gbase, SET[h]); } else { PG8_STAGE1(bufoff, (gbase) + (h) * hstepA, voffA, pstepA); } } while (0)
#define PG8_LDA(dst, b, h) do { int aoff1 = aoff0 ^ 64; asm volatile("" : "+v"(aoff1)); _Pragma("unroll") for (int m = 0; m < 4; ++m) { \
        if constexpr (ES == 2) { _Pragma("unroll") for (int k = 0; k < 2; ++k) dst[m][k] = *(const LAS bf16x8*)(lds + PG8_SA(b, h) + (k ? aoff1 : aoff0) + m * 2048); } \
        else { dst##8[m].lo = *(const LAS i4_t*)(lds + PG8_SA(b, h) + aoff0 + m * 2048); dst##8[m].hi = *(const LAS i4_t*)(lds + PG8_SA(b, h) + aoff1 + m * 2048); } } } while (0)
#define PG8_LDB(dst, b, h) do { int boff1 = boff0 ^ 64; asm volatile("" : "+v"(boff1)); _Pragma("unroll") for (int n = 0; n < 2; ++n) { \
        if constexpr (ES == 2) { _Pragma("unroll") for (int k = 0; k < 2; ++k) dst[n][k] = *(const LAS bf16x8*)(lds + PG8_SB(b, h) + (k ? boff1 : boff0) + n * 2048); } \
        else { dst##8[n].lo = *(const LAS i4_t*)(lds + PG8_SB(b, h) + boff0 + n * 2048); dst##8[n].hi = *(const LAS i4_t*)(lds + PG8_SB(b, h) + boff1 + n * 2048); } } } while (0)
#define PG8_MMA(ai, bj, At, Bt) do { __builtin_amdgcn_s_setprio(1); _Pragma("unroll") for (int m = 0; m < 4; ++m) _Pragma("unroll") for (int n = 0; n < 2; ++n) { \
        if constexpr (ES == 2) { _Pragma("unroll") for (int k = 0; k < 2; ++k) acc[ai][bj][m][n] = __builtin_amdgcn_mfma_f32_16x16x32_bf16(Bt[n][k], At[m][k], acc[ai][bj][m][n], 0, 0, 0); } \
        else asm volatile("v_mfma_scale_f32_16x16x128_f8f6f4 %0, %1, %2, %0, %3, %3 op_sel_hi:[0,0,0]" : "+v"(acc[ai][bj][m][n]) : "v"(Bt##8[n]), "v"(At##8[m]), "v"(mxs));     } \
        __builtin_amdgcn_s_setprio(0); } while (0)
#define PG8_WAIT_V(n) asm volatile("s_waitcnt vmcnt(" #n ")" ::: "memory")
#define PG8_WAIT_L(n) asm volatile("s_waitcnt lgkmcnt(" #n ")" ::: "memory")
#define PG8_BAR __builtin_amdgcn_s_barrier()
#define PG8_SCHED __builtin_amdgcn_sched_barrier(0)
    Unit cur, nxt; int ui = 0;
    if (!S.next(0, cur)) return;
    f32x4 acc[2][2][4][2];
#pragma unroll
    for (int a = 0; a < 2; ++a)
#pragma unroll
        for (int b = 0; b < 2; ++b)
#pragma unroll
            for (int m = 0; m < 4; ++m)
#pragma unroll
                for (int n = 0; n < 2; ++n) acc[a][b][m][n] = (f32x4){0.f, 0.f, 0.f, 0.f};
    typedef int i4_t __attribute__((ext_vector_type(4))); typedef int i8_t __attribute__((ext_vector_type(8)));
    const int mxs = 0x7f7f7f7f;
    bf16x8 At[4][2], B0[2][2], B1[2][2]; i8_t At8[4], B08[2], B18[2];
    const char* cA = cur.A; const char* cB = cur.B;
    if constexpr (GATHER) {
#pragma unroll
        for (int h = 0; h < 2; ++h)
#pragma unroll
            for (int i = 0; i < 2; ++i) oc[h][i] = S.rowoff(cur, h * HALF + Rr[i]) + (unsigned)Cb[i];
        asm volatile("s_waitcnt vmcnt(0)" : "+v"(oc[0][0]), "+v"(oc[0][1]), "+v"(oc[1][0]), "+v"(oc[1][1]) :: "memory");
    }
    PG8_STAGE1(PG8_SB(0, 0), cB, voffB, pstepB); PG8_STAGE1(PG8_SB(0, 1), cB + hstepB, voffB, pstepB); PG8_STAGE_A(PG8_SA(0, 0), cA, 0, oc); PG8_STAGE_A(PG8_SA(0, 1), cA, 1, oc);
    if (wr == 1) PG8_BAR;
    PG8_WAIT_V(2); PG8_BAR;
    PG8_STAGE1(PG8_SB(1, 0), cB + kstep, voffB, pstepB); PG8_STAGE_A(PG8_SA(1, 0), cA + kstep, 0, oc); PG8_STAGE1(PG8_SB(1, 1), cB + hstepB + kstep, voffB, pstepB);
    PG8_WAIT_V(6); PG8_BAR;
    for (;;) {
        const bool has_next = S.next(ui + 1, nxt);
        const char* nA = has_next ? nxt.A : cA; const char* nB = has_next ? nxt.B : cB;
        if constexpr (GATHER) {
            if (has_next) {
#pragma unroll
                for (int h = 0; h < 2; ++h)
#pragma unroll
                    for (int i = 0; i < 2; ++i) on[h][i] = S.rowoff(nxt, h * HALF + Rr[i]) + (unsigned)Cb[i];
                asm volatile("s_waitcnt vmcnt(0)" : "+v"(on[0][0]), "+v"(on[0][1]), "+v"(on[1][0]), "+v"(on[1][1]) :: "memory");
            } else {
#pragma unroll
                for (int h = 0; h < 2; ++h)
#pragma unroll
                    for (int i = 0; i < 2; ++i) on[h][i] = oc[h][i];
            }
        }
#pragma clang loop unroll(disable)
        for (int t = 0; t < nt; t += 2) {
            const bool last = (t == nt - 2);
            const char* a1 = cA + (size_t)(t + 1) * kstep;
            const char* a2 = last ? nA : cA + (size_t)(t + 2) * kstep; const char* b2 = last ? nB : cB + (size_t)(t + 2) * kstep;
            const char* a3 = a2 + kstep; const char* b3 = b2 + kstep;
            if constexpr (GATHER) {
#pragma unroll
                for (int h = 0; h < 2; ++h)
#pragma unroll
                    for (int i = 0; i < 2; ++i) ox[h][i] = last ? on[h][i] : oc[h][i];
            }
            PG8_LDB(B0, 0, 0); PG8_LDB(B1, 0, 1); PG8_SCHED; PG8_LDA(At, 0, 0); PG8_STAGE_A(PG8_SA(1, 1), a1, 1, oc);
            PG8_WAIT_V(8); PG8_WAIT_L(0); PG8_BAR; PG8_MMA(0, 0, At, B0); PG8_MMA(0, 1, At, B1); PG8_BAR; PG8_SCHED;
            PG8_LDA(At, 0, 1); PG8_STAGE1(PG8_SB(0, 0), b2, voffB, pstepB); PG8_STAGE1(PG8_SB(0, 1), b2 + hstepB, voffB, pstepB); PG8_STAGE_A(PG8_SA(0, 0), a2, 0, ox);
            PG8_WAIT_V(8); PG8_WAIT_L(0); PG8_BAR; PG8_MMA(1, 0, At, B0); PG8_MMA(1, 1, At, B1); PG8_BAR; PG8_SCHED;
            PG8_LDB(B0, 1, 0); PG8_LDB(B1, 1, 1); PG8_SCHED; PG8_LDA(At, 1, 0); PG8_STAGE_A(PG8_SA(0, 1), a2, 1, ox);
            PG8_WAIT_V(8); PG8_WAIT_L(0); PG8_BAR; PG8_MMA(0, 0, At, B0); PG8_MMA(0, 1, At, B1); PG8_BAR; PG8_SCHED;
            PG8_LDA(At, 1, 1); PG8_STAGE1(PG8_SB(1, 0), b3, voffB, pstepB); PG8_STAGE1(PG8_SB(1, 1), b3 + hstepB, voffB, pstepB); PG8_STAGE_A(PG8_SA(1, 0), a3, 0, ox);
            PG8_WAIT_V(8); PG8_WAIT_L(0); PG8_BAR; PG8_MMA(1, 0, At, B0); PG8_MMA(1, 1, At, B1); PG8_BAR; PG8_SCHED;
        }
        if (wr == 0) PG8_BAR;
        if constexpr (ES == 1) asm volatile("s_nop 15\n\ts_nop 15" ::: "memory");
        { int fr_e = fr, fq_e = fq; asm volatile("" : "+v"(fr_e), "+v"(fq_e));
          E(acc, cur, wr, wc, fr_e, fq_e); }
        if (!has_next) break;
#pragma unroll
        for (int a = 0; a < 2; ++a)
#pragma unroll
            for (int b = 0; b < 2; ++b)
#pragma unroll
                for (int m = 0; m < 4; ++m)
#pragma unroll
                    for (int n = 0; n < 2; ++n) acc[a][b][m][n] = (f32x4){0.f, 0.f, 0.f, 0.f};
        cur = nxt; cA = nA; cB = nB; ++ui;
        if constexpr (GATHER) {
#pragma unroll
            for (int h = 0; h < 2; ++h)
#pragma unroll
                for (int i = 0; i < 2; ++i) oc[h][i] = on[h][i];
        }
        if (wr == 1) PG8_BAR;
    }
    PG8_WAIT_V(0);
    PG8_BAR;
#undef PG8_SA
#undef PG8_SB
#undef PG8_STAGE
#undef PG8_STAGE1
#undef PG8_STAGE_A
#undef PG8_LDA
#undef PG8_LDB
#undef PG8_MMA
#undef PG8_WAIT_V
#undef PG8_WAIT_L
#undef PG8_BAR
#undef PG8_SCHED
}

struct DenseSched {
    const char* A; const char* B; int lda, ldb, nM, nN, nwg, G, c, first, last, es = 2;
    __device__ void init(const void* A_, const void* B_, int lda_, int ldb_, int M, int N, int G_, int c_, int first_ = 0, int count_ = -1) { A = (const char*)A_; B = (const char*)B_; lda = lda_; ldb = ldb_; nM = M / BM; nN = N / BM; nwg = nM * nN; G = G_; c = c_;
        first = first_; last = (count_ < 0) ? nwg : first_ + count_; }
    __device__ __forceinline__ bool next(int i, Unit& u) const {
        const long L = (long)first + (long)i * G + c; if (L >= last) return false;
        int wgid = (int)L; { const int q = nwg / NXCD, r = nwg % NXCD, xcd = wgid % NXCD, off = wgid / NXCD; wgid = (xcd < r ? xcd * (q + 1) : r * (q + 1) + (xcd - r) * q) + off; }
        const int nig = WGM * nN, gid = wgid / nig, fm = gid * WGM, gsz = (nM - fm) < WGM ? (nM - fm) : WGM;
        const int pm = fm + ((wgid % nig) % gsz), pn = (wgid % nig) / gsz;
        u.A = A + (size_t)pm * BM * lda * es; u.B = B + (size_t)pn * BM * ldb * es; u.orow = pm * BM; u.ocol = pn * BM; u.aux = 0; return true;
    }
    __device__ __forceinline__ unsigned rowoff(const Unit&, int) const { return 0u; }
};
}

template <int MODE> struct EpiBf16 {
    static constexpr bool PERM = true;
    bf16_t* O; int ldc; const float* sv; float inv_dim, mul;
    __device__ __forceinline__ void operator()(const f32x4 (&acc)[2][2][4][2], const pg8::Unit& u, int wr, int wc, int fr, int fq) const {
        const int row0 = u.orow + wr * 64 + fr, col0 = u.ocol + wc * 32 + 8 * fq;
#pragma unroll
        for (int ai = 0; ai < 2; ++ai)
#pragma unroll
            for (int m = 0; m < 4; ++m) { const int row = row0 + ai * 128 + m * 16;
                float s = mul; if (MODE == 1) s = mul / sqrtf(sv[row] * inv_dim + EPS); if (MODE == 2) s = mul * sv[row]; if (MODE == 3) s = mul / sqrtf(fx_get((const fx64*)sv + row) * inv_dim + EPS);
                bf16_t* rowp = O + (size_t)row * ldc + col0;
#pragma unroll
                for (int bj = 0; bj < 2; ++bj) { const f32x4 v0 = acc[ai][bj][m][0] * s, v1 = acc[ai][bj][m][1] * s;
                    u32x4 w; w.x = cvt_pk_bf16(v0[0], v0[1]); w.y = cvt_pk_bf16(v0[2], v0[3]); w.z = cvt_pk_bf16(v1[0], v1[1]); w.w = cvt_pk_bf16(v1[2], v1[3]);
                    *(u32x4*)(rowp + bj * 128) = w; } }
    }
};
struct EpiF8Rms {
    static constexpr int PERM = 2;
    unsigned char* O; int ldc; const float* ssq; float inv_dim, mul;
    __device__ __forceinline__ void operator()(const f32x4 (&acc)[2][2][4][2], const pg8::Unit& u, int wr, int wc, int fr, int fq) const {
        const int row0 = u.orow + wr * 64 + fr, col0 = u.ocol + wc * 64 + 16 * fq;
#pragma unroll
        for (int ai = 0; ai < 2; ++ai)
#pragma unroll
            for (int m = 0; m < 4; ++m) { const int row = row0 + ai * 128 + m * 16; const float s = mul / sqrtf(ssq[row] * inv_dim + EPS);
                u32x4 w;
#pragma unroll
                for (int bj = 0; bj < 2; ++bj) { const f32x4 v0 = acc[ai][bj][m][0] * s, v1 = acc[ai][bj][m][1] * s;
                    w[2 * bj] = pk4_fp8(v0[0], v0[1], v0[2], v0[3]); w[2 * bj + 1] = pk4_fp8(v1[0], v1[1], v1[2], v1[3]); }
                *(u32x4*)(O + (size_t)row * ldc + col0) = w; }
    }
};
struct EpiF8 {
    static constexpr int PERM = 2;
    unsigned char* O; int ldc; float mul;
    __device__ __forceinline__ void operator()(const f32x4 (&acc)[2][2][4][2], const pg8::Unit& u, int wr, int wc, int fr, int fq) const {
        const int row0 = u.orow + wr * 64 + fr, col0 = u.ocol + wc * 64 + 16 * fq;
#pragma unroll
        for (int ai = 0; ai < 2; ++ai)
#pragma unroll
            for (int m = 0; m < 4; ++m) { u32x4 w;
#pragma unroll
                for (int bj = 0; bj < 2; ++bj) { const f32x4 v0 = acc[ai][bj][m][0] * mul, v1 = acc[ai][bj][m][1] * mul;
                    w[2 * bj] = pk4_fp8(v0[0], v0[1], v0[2], v0[3]); w[2 * bj + 1] = pk4_fp8(v1[0], v1[1], v1[2], v1[3]); }
                *(u32x4*)(O + (size_t)(row0 + ai * 128 + m * 16) * ldc + col0) = w; }
    }
};
__device__ __forceinline__ void rope8(f32x4& v0, f32x4& v1, const f32x2* cs) {
    const f32x4 c01 = *(const f32x4*)cs, c23 = *(const f32x4*)(cs + 2);
    f32x4 a = v0, b = v1;
    v0[0] = a[0] * c01[0] - a[1] * c01[1]; v0[1] = a[1] * c01[0] + a[0] * c01[1];
    v0[2] = a[2] * c01[2] - a[3] * c01[3]; v0[3] = a[3] * c01[2] + a[2] * c01[3];
    v1[0] = b[0] * c23[0] - b[1] * c23[1]; v1[1] = b[1] * c23[0] + b[0] * c23[1];
    v1[2] = b[2] * c23[2] - b[3] * c23[3]; v1[3] = b[3] * c23[2] + b[2] * c23[3];
}
__device__ __forceinline__ void rope8v(f32x4& v0, f32x4& v1, const f32x4 c01, const f32x4 c23) {
    f32x4 a = v0, b = v1;
    v0[0] = a[0] * c01[0] - a[1] * c01[1]; v0[1] = a[1] * c01[0] + a[0] * c01[1];
    v0[2] = a[2] * c01[2] - a[3] * c01[3]; v0[3] = a[3] * c01[2] + a[2] * c01[3];
    v1[0] = b[0] * c23[0] - b[1] * c23[1]; v1[1] = b[1] * c23[0] + b[0] * c23[1];
    v1[2] = b[2] * c23[2] - b[3] * c23[3]; v1[3] = b[3] * c23[2] + b[2] * c23[3];
}
struct EpiZ {
    static constexpr bool PERM = true;
    bf16_t* zb; bf16_t* krope; const float* ssq_x; fx64* ssq_q; fx64* ssq_kv; const f32x2* tab;
    __device__ __forceinline__ void operator()(const f32x4 (&acc)[2][2][4][2], const pg8::Unit& u, int wr, int wc, int fr, int fq) const {
        const int row0 = u.orow + wr * 64 + fr, col0 = u.ocol + wc * 32 + 8 * fq;
        fx64* ssq = (u.ocol == C_Q || u.ocol == C_Q + 256) ? ssq_q : (u.ocol == C_KV ? ssq_kv : nullptr);
        const bool isrope = (u.ocol == C_KR) && (wc < 2);
        float sx[2][4];
#pragma unroll
        for (int ai = 0; ai < 2; ++ai)
#pragma unroll
            for (int m = 0; m < 4; ++m) sx[ai][m] = ssq_x[row0 + ai * 128 + m * 16];
#pragma unroll
        for (int ai = 0; ai < 2; ++ai)
#pragma unroll
            for (int m = 0; m < 4; ++m) { const int row = row0 + ai * 128 + m * 16;
                const float s = 1.0f / sqrtf(sx[ai][m] * (1.0f / DM) + EPS);
                bf16_t* rowp = zb + (size_t)row * ZC + col0; float q = 0.f;
#pragma unroll
                for (int bj = 0; bj < 2; ++bj) { f32x4 v0 = acc[ai][bj][m][0] * s, v1 = acc[ai][bj][m][1] * s;
                    q += (v0[0] * v0[0] + v0[1] * v0[1]) + (v0[2] * v0[2] + v0[3] * v0[3]) + (v1[0] * v1[0] + v1[1] * v1[1]) + (v1[2] * v1[2] + v1[3] * v1[3]);
                    u32x4 w; w.x = cvt_pk_bf16(v0[0], v0[1]); w.y = cvt_pk_bf16(v0[2], v0[3]); w.z = cvt_pk_bf16(v1[0], v1[1]); w.w = cvt_pk_bf16(v1[2], v1[3]);
                    *(u32x4*)(rowp + bj * 128) = w;
                    if (bj == 0 && isrope) { const int c = wc * 32 + 8 * fq;
                        rope8(v0, v1, tab + (size_t)row * 32 + (c >> 1));
                        u32x4 w2; w2.x = cvt_pk_bf16(v0[0], v0[1]); w2.y = cvt_pk_bf16(v0[2], v0[3]); w2.z = cvt_pk_bf16(v1[0], v1[1]); w2.w = cvt_pk_bf16(v1[2], v1[3]);
                        *(u32x4*)(krope + (size_t)row * DR + c) = w2; } }
                if (ssq) { q += __shfl_xor(q, 16); q += __shfl_xor(q, 32); if (fq == 0) fx_add(ssq + row, q); } }
    }
};
struct EpiQ {
    static constexpr bool PERM = true;
    bf16_t* qb; const fx64* ssq_q; const f32x2* tab;
    __device__ __forceinline__ void operator()(const f32x4 (&acc)[2][2][4][2], const pg8::Unit& u, int wr, int wc, int fr, int fq) const {
        const int row0 = u.orow + wr * 64 + fr, col0 = u.ocol + wc * 32 + 8 * fq;
        const float qs = LOG2E * 0.07216878364870322f;
        float sq[2][4];
#pragma unroll
        for (int ai = 0; ai < 2; ++ai)
#pragma unroll
            for (int m = 0; m < 4; ++m) sq[ai][m] = fx_get(ssq_q + row0 + ai * 128 + m * 16);
#pragma unroll
        for (int bj = 0; bj < 2; ++bj) {
            const int d = (col0 + bj * 128) % DQK;
            const bool rp = ((u.ocol + wc * 32 + bj * 128) % DQK) >= DN;
            if (rp) {
#pragma unroll
                for (int ai = 0; ai < 2; ++ai) {
                    f32x4 t0[4], t1[4];
#pragma unroll
                    for (int m = 0; m < 4; ++m) { const f32x2* tp = tab + (size_t)(row0 + ai * 128 + m * 16) * 32 + ((d - DN) >> 1); t0[m] = *(const f32x4*)tp; t1[m] = *(const f32x4*)(tp + 2); }
#pragma unroll
                    for (int m = 0; m < 4; ++m) { const int row = row0 + ai * 128 + m * 16; const float s = 1.0f / sqrtf(sq[ai][m] * (1.0f / QL) + EPS);
                        f32x4 v0 = acc[ai][bj][m][0] * s, v1 = acc[ai][bj][m][1] * s;
                        rope8v(v0, v1, t0[m], t1[m]);
                        v0 = v0 * qs; v1 = v1 * qs;
                        u32x4 w; w.x = cvt_pk_bf16(v0[0], v0[1]); w.y = cvt_pk_bf16(v0[2], v0[3]); w.z = cvt_pk_bf16(v1[0], v1[1]); w.w = cvt_pk_bf16(v1[2], v1[3]);
                        *(u32x4*)(qb + (size_t)row * (NH * DQK) + col0 + bj * 128) = w; }
                }
            } else {
#pragma unroll
                for (int ai = 0; ai < 2; ++ai)
#pragma unroll
                    for (int m = 0; m < 4; ++m) { const int row = row0 + ai * 128 + m * 16; const float s = qs / sqrtf(sq[ai][m] * (1.0f / QL) + EPS);
                        const f32x4 v0 = acc[ai][bj][m][0] * s, v1 = acc[ai][bj][m][1] * s;
                        u32x4 w; w.x = cvt_pk_bf16(v0[0], v0[1]); w.y = cvt_pk_bf16(v0[2], v0[3]); w.z = cvt_pk_bf16(v1[0], v1[1]); w.w = cvt_pk_bf16(v1[2], v1[3]);
                        *(u32x4*)(qb + (size_t)row * (NH * DQK) + col0 + bj * 128) = w; }
            }
        }
    }
};
template <bool KPERM> struct EpiColScale {
    static constexpr bool PERM = false;
    bf16_t* O; int ldc; const fx64* ssq; float inv_dim;
    __device__ __forceinline__ void operator()(const f32x4 (&acc)[2][2][4][2], const pg8::Unit& u, int wr, int wc, int fr, int fq) const {
        const int row0 = u.orow + wr * 64 + fr, colb = u.ocol + wc * 32;
        const int fqp = KPERM ? (((fq & 1) << 1) | (fq >> 1)) : fq;
#pragma unroll
        for (int bj = 0; bj < 2; ++bj)
#pragma unroll
            for (int n = 0; n < 2; ++n) { const fx64* qp = ssq + colb + bj * 128 + n * 16 + 4 * fq; f32x4 sc;
#pragma unroll
                for (int e = 0; e < 4; ++e) sc[e] = 1.0f / sqrtf(fx_get(qp + e) * inv_dim + EPS);
#pragma unroll
                for (int ai = 0; ai < 2; ++ai)
#pragma unroll
                    for (int m = 0; m < 4; ++m) { bf16_t* rowp = O + (size_t)(row0 + ai * 128 + m * 16) * ldc + colb + 4 * fqp; const f32x4 v = acc[ai][bj][m][n] * sc;
                        u32x2 w; w.x = cvt_pk_bf16(v[0], v[1]); w.y = cvt_pk_bf16(v[2], v[3]); *(u32x2*)(rowp + bj * 128 + n * 16) = w; } }
    }
};
template <bool FROM_F32, bool LO_IN, bool LO_OUT> struct EpiResidHL {
    static constexpr bool PERM = true;
    const float* xf; const bf16_t* xih; const bf16_t* xil; bf16_t* xh; bf16_t* xl; fx64* ssq; unsigned char* x8; float amul;
    __device__ __forceinline__ void operator()(const f32x4 (&acc)[2][2][4][2], const pg8::Unit& u, int wr, int wc, int fr, int fq) const {
        const int row0 = u.orow + wr * 64 + fr, col0 = u.ocol + wc * 32 + 8 * fq;
#pragma unroll
        for (int ai = 0; ai < 2; ++ai) {
            f32x4 xv[4][2][2];
#pragma unroll
            for (int m = 0; m < 4; ++m)
#pragma unroll
                for (int bj = 0; bj < 2; ++bj) { const size_t off = (size_t)(row0 + ai * 128 + m * 16) * DM + col0 + bj * 128;
                    if (FROM_F32) { xv[m][bj][0] = NTL((const f32x4*)(xf + off)); xv[m][bj][1] = NTL((const f32x4*)(xf + off + 4)); }
                    else if (LO_IN) { const u32x4 h = NTL((const u32x4*)(xih + off)), l = NTL((const u32x4*)(xil + off));
                        xv[m][bj][0] = (f32x4){bf_lo(h.x) + bf_lo(l.x), bf_hi(h.x) + bf_hi(l.x), bf_lo(h.y) + bf_lo(l.y), bf_hi(h.y) + bf_hi(l.y)};
                        xv[m][bj][1] = (f32x4){bf_lo(h.z) + bf_lo(l.z), bf_hi(h.z) + bf_hi(l.z), bf_lo(h.w) + bf_lo(l.w), bf_hi(h.w) + bf_hi(l.w)}; }
                    else { const u32x4 h = NTL((const u32x4*)(xih + off));
                        xv[m][bj][0] = (f32x4){bf_lo(h.x), bf_hi(h.x), bf_lo(h.y), bf_hi(h.y)}; xv[m][bj][1] = (f32x4){bf_lo(h.z), bf_hi(h.z), bf_lo(h.w), bf_hi(h.w)}; } }
#pragma unroll
            for (int m = 0; m < 4; ++m) { const int row = row0 + ai * 128 + m * 16; float q = 0.f;
#pragma unroll
                for (int bj = 0; bj < 2; ++bj) { const size_t off = (size_t)row * DM + col0 + bj * 128;
                    const f32x4 v0 = xv[m][bj][0] + acc[ai][bj][m][0] * amul, v1 = xv[m][bj][1] + acc[ai][bj][m][1] * amul;
                    q += ((v0[0] * v0[0] + v0[1] * v0[1]) + (v0[2] * v0[2] + v0[3] * v0[3])) + ((v1[0] * v1[0] + v1[1] * v1[1]) + (v1[2] * v1[2] + v1[3] * v1[3]));
                    u32x4 h; h.x = cvt_pk_bf16(v0[0], v0[1]); h.y = cvt_pk_bf16(v0[2], v0[3]); h.z = cvt_pk_bf16(v1[0], v1[1]); h.w = cvt_pk_bf16(v1[2], v1[3]); *(u32x4*)(xh + off) = h;
                    if (LO_OUT) { u32x4 l; l.x = cvt_pk_bf16(v0[0] - bf_lo(h.x), v0[1] - bf_hi(h.x)); l.y = cvt_pk_bf16(v0[2] - bf_lo(h.y), v0[3] - bf_hi(h.y));
                        l.z = cvt_pk_bf16(v1[0] - bf_lo(h.z), v1[1] - bf_hi(h.z)); l.w = cvt_pk_bf16(v1[2] - bf_lo(h.w), v1[3] - bf_hi(h.w)); *(u32x4*)(xl + off) = l; }
                    if (x8) { u32x2 w; w.x = pk4_fp8(v0[0], v0[1], v0[2], v0[3]); w.y = pk4_fp8(v1[0], v1[1], v1[2], v1[3]); *(u32x2*)(x8 + off) = w; } }
                q += __shfl_xor(q, 16); q += __shfl_xor(q, 32); if (fq == 0) fx_add(ssq + row, q); }
        }
    }
};
struct EpiSoftmax {
    static constexpr int PERM = 2;
    bf16_t* P; int ldc; LAS float* tmax; LAS float* tsum; const fx64* ssq; float inv_dim; float smul; unsigned char* P8;
    __device__ __forceinline__ void operator()(f32x4 (&acc)[2][2][4][2], const pg8::Unit& u, int wr, int wc, int fr, int fq) const {
        const int col0 = u.ocol + wc * 64 + 16 * fq;
#pragma unroll
        for (int ai = 0; ai < 2; ++ai)
#pragma unroll
            for (int m = 0; m < 4; ++m) { float v = -3.0e38f; const float rs = smul / sqrtf(fx_get(ssq + u.orow + ai * 128 + wr * 64 + m * 16 + fr) * inv_dim + EPS);
#pragma unroll
                for (int bj = 0; bj < 2; ++bj)
#pragma unroll
                    for (int n = 0; n < 2; ++n) { const f32x4 x = acc[ai][bj][m][n] * rs; acc[ai][bj][m][n] = x; v = fmaxf(fmaxf(fmaxf(v, x[0]), fmaxf(x[1], x[2])), x[3]); }
                v = fmaxf(v, __shfl_xor(v, 16)); v = fmaxf(v, __shfl_xor(v, 32));
                if (fq == 0) tmax[(ai * 128 + wr * 64 + m * 16 + fr) * 4 + wc] = v; }
        LDS_WAIT(); __builtin_amdgcn_s_barrier(); asm volatile("" ::: "memory");
#pragma unroll
        for (int ai = 0; ai < 2; ++ai)
#pragma unroll
            for (int m = 0; m < 4; ++m) { const f32x4 t = *(const LAS f32x4*)(tmax + (ai * 128 + wr * 64 + m * 16 + fr) * 4);
                const float rm = fmaxf(fmaxf(t[0], t[1]), fmaxf(t[2], t[3])); float s = 0.f;
#pragma unroll
                for (int bj = 0; bj < 2; ++bj)
#pragma unroll
                    for (int n = 0; n < 2; ++n) { f32x4 x = acc[ai][bj][m][n] - rm;
#pragma unroll
                        for (int e = 0; e < 4; ++e) x[e] = __builtin_amdgcn_exp2f(x[e]);
                        s += (x[0] + x[1]) + (x[2] + x[3]); acc[ai][bj][m][n] = x; }
                s += __shfl_xor(s, 16); s += __shfl_xor(s, 32);
                if (fq == 0) tsum[(ai * 128 + wr * 64 + m * 16 + fr) * 4 + wc] = s; }
        LDS_WAIT(); __builtin_amdgcn_s_barrier(); asm volatile("" ::: "memory");
#pragma unroll
        for (int ai = 0; ai < 2; ++ai)
#pragma unroll
            for (int m = 0; m < 4; ++m) { const int rl = ai * 128 + wr * 64 + m * 16 + fr; const f32x4 t = *(const LAS f32x4*)(tsum + rl * 4);
                const float inv = 1.0f / ((t[0] + t[1]) + (t[2] + t[3]));
                bf16_t* rowp = P + (size_t)(u.orow + rl) * ldc + col0; unsigned char* rowp8 = P8 + (size_t)(u.orow + rl) * ldc + col0;
                u32x4 w8;
#pragma unroll
                for (int bj = 0; bj < 2; ++bj) { const f32x4 v0 = acc[ai][bj][m][0] * inv, v1 = acc[ai][bj][m][1] * inv;
                    if (P8) { const f32x4 a0 = v0 * F8_SP, a1 = v1 * F8_SP; w8[2 * bj] = pk4_fp8(a0[0], a0[1], a0[2], a0[3]); w8[2 * bj + 1] = pk4_fp8(a1[0], a1[1], a1[2], a1[3]); }
                    else { u32x4 w; w.x = cvt_pk_bf16(v0[0], v0[1]); w.y = cvt_pk_bf16(v0[2], v0[3]); w.z = cvt_pk_bf16(v1[0], v1[1]); w.w = cvt_pk_bf16(v1[2], v1[3]);
                    *(u32x4*)(rowp + bj * 8) = w; } }
                if (P8) *(u32x4*)rowp8 = w8; }
    }
};
struct EpiF8Row {
    static constexpr int PERM = 2;
    unsigned char* O; int ldc; const float* sv; float mul;
    __device__ __forceinline__ void operator()(const f32x4 (&acc)[2][2][4][2], const pg8::Unit& u, int wr, int wc, int fr, int fq) const {
        const int row0 = u.orow + wr * 64 + fr, col0 = u.ocol + wc * 64 + 16 * fq;
#pragma unroll
        for (int ai = 0; ai < 2; ++ai)
#pragma unroll
            for (int m = 0; m < 4; ++m) { const int row = row0 + ai * 128 + m * 16; const float s = sv[row] * mul;
                u32x4 w;
#pragma unroll
                for (int bj = 0; bj < 2; ++bj) { const f32x4 v0 = acc[ai][bj][m][0] * s, v1 = acc[ai][bj][m][1] * s;
                    w[2 * bj] = pk4_fp8(v0[0], v0[1], v0[2], v0[3]); w[2 * bj + 1] = pk4_fp8(v1[0], v1[1], v1[2], v1[3]); }
                *(u32x4*)(O + (size_t)row * ldc + col0) = w; }
    }
};
struct EpiGateUp8 {
    static constexpr bool PERM = true;
    unsigned char* act; const float* row_rs;
    __device__ __forceinline__ void operator()(const f32x4 (&acc)[2][2][4][2], const pg8::Unit& u, int wr, int wc, int fr, int fq) const {
        const int row0 = u.orow + wr * 64 + fr, col0 = u.ocol + wc * 32 + 8 * fq;
#pragma unroll
        for (int ai = 0; ai < 2; ++ai)
#pragma unroll
            for (int m = 0; m < 4; ++m) { const int row = row0 + ai * 128 + m * 16; const float s = row_rs[row] * (1.0f / F8_SW);
                float o[8];
#pragma unroll
                for (int n = 0; n < 2; ++n)
#pragma unroll
                    for (int e = 0; e < 4; ++e) { const float g = acc[ai][0][m][n][e] * s, up = acc[ai][1][m][n][e] * s; o[n * 4 + e] = g / (1.0f + __expf(-g)) * up * F8_SACT; }
                u32x2 w; w.x = pk4_fp8(o[0], o[1], o[2], o[3]); w.y = pk4_fp8(o[4], o[5], o[6], o[7]);
                *(u32x2*)(act + (size_t)row * DE + col0) = w; }
    }
};
struct EpiGateUp {
    static constexpr bool PERM = true;
    bf16_t* act; const float* row_rs;
    __device__ __forceinline__ void operator()(const f32x4 (&acc)[2][2][4][2], const pg8::Unit& u, int wr, int wc, int fr, int fq) const {
        const int row0 = u.orow + wr * 64 + fr, col0 = u.ocol + wc * 32 + 8 * fq;
#pragma unroll
        for (int ai = 0; ai < 2; ++ai)
#pragma unroll
            for (int m = 0; m < 4; ++m) { const int row = row0 + ai * 128 + m * 16; const float s = row_rs[row];
                float o[8];
#pragma unroll
                for (int n = 0; n < 2; ++n)
#pragma unroll
                    for (int e = 0; e < 4; ++e) { const float g = acc[ai][0][m][n][e] * s, up = acc[ai][1][m][n][e] * s; o[n * 4 + e] = g / (1.0f + __expf(-g)) * up; }
                u32x4 w; w.x = cvt_pk_bf16(o[0], o[1]); w.y = cvt_pk_bf16(o[2], o[3]); w.z = cvt_pk_bf16(o[4], o[5]); w.w = cvt_pk_bf16(o[6], o[7]);
                *(u32x4*)(act + (size_t)row * DE + col0) = w; }
    }
};

struct EpiRouter {
    static constexpr bool PERM = false;
    float* slab;
    __device__ __forceinline__ void operator()(const f32x4 (&acc)[2][2][4][2], const pg8::Unit& u, int wr, int wc, int fr, int fq) const {
        if (wc < 3) {
            const int row0 = u.orow + wr * 64 + fr, col0 = wc * 32 + 4 * fq;
#pragma unroll
            for (int ai = 0; ai < 2; ++ai)
#pragma unroll
                for (int m = 0; m < 4; ++m) { float* rowp = slab + ((size_t)u.aux * NTOK + row0 + ai * 128 + m * 16) * 96 + col0;
#pragma unroll
                    for (int n = 0; n < 2; ++n) *(f32x4*)(rowp + n * 16) = acc[ai][0][m][n] + acc[ai][1][m][n]; }
        }
    }
};

struct MtSched {
    const char* kx_; const char* wq; int G, c, es;
    __device__ __forceinline__ bool next(int i, pg8::Unit& u) const { const int L = i * G + c; if (L >= NB * XH * 8) return false;
        const int bh = L >> 3, pn = L & 7, b = bh >> 2, h = bh & 3;
        u.A = kx_ + ((size_t)(b * MEM) * DM + h * XD) * es; u.B = wq + ((size_t)(pn * 256) * DM + h * XD) * es; u.orow = bh * MEM; u.ocol = pn * 256; u.aux = 0; return true; }
    __device__ __forceinline__ unsigned rowoff(const pg8::Unit&, int) const { return 0u; }
};
struct VWtSched {
    const char* wo; const char* vx_; int G, c, es;
    __device__ __forceinline__ bool next(int i, pg8::Unit& u) const { const int L = i * G + c; if (L >= NB * XH * 8) return false;
        const int bh = L >> 3, pm = L & 7, b = bh >> 2, h = bh & 3;
        u.A = wo + ((size_t)(pm * 256) * DM + h * XD) * es; u.B = vx_ + ((size_t)(b * MEM) * DM + h * XD) * es; u.orow = b * DM + pm * 256; u.ocol = h * MEM; u.aux = 0; return true; }
    __device__ __forceinline__ unsigned rowoff(const pg8::Unit&, int) const { return 0u; }
};
struct CrossSSched {
    const char* xa; const char* mt; int G, c, es;
    __device__ __forceinline__ bool next(int i, pg8::Unit& u) const { const int L = i * G + c; if (L >= NB * XH * 8) return false;
        const int b = L >> 5, h = (L >> 3) & 3, qb = L & 7;
        u.A = xa + (size_t)(b * T + qb * 256) * DM * es; u.B = mt + (size_t)((b * XH + h) * MEM) * DM * es; u.orow = b * T + qb * 256; u.ocol = h * MEM; u.aux = 0; return true; }
    __device__ __forceinline__ unsigned rowoff(const pg8::Unit&, int) const { return 0u; }
};
struct CrossOSched {
    const char* pb; const char* vwt; int G, c, es;
    __device__ __forceinline__ bool next(int i, pg8::Unit& u) const { const int L = i * G + c; if (L >= NB * 8 * 8) return false;
        const int b = L >> 6, qb = (L >> 3) & 7, pn = L & 7;
        u.A = pb + (size_t)(b * T + qb * 256) * (XH * MEM) * es; u.B = vwt + (size_t)(b * DM + pn * 256) * (XH * MEM) * es; u.orow = b * T + qb * 256; u.ocol = pn * 256; u.aux = 0; return true; }
    __device__ __forceinline__ unsigned rowoff(const pg8::Unit&, int) const { return 0u; }
};
struct RouterSched {
    const char* xh; const char* xl; const char* wrt; int G, c;
    __device__ __forceinline__ bool next(int i, pg8::Unit& u) const { const int L = i * G + c; if (L >= (NTOK / 256) * 4) return false;
        const int pm = L >> 2, kq = L & 3;
#if X2_LO
        u.A = (kq < 2 ? xh : xl) + ((size_t)pm * 256 * DM + (kq & 1) * 1024) * 2; u.B = wrt + (size_t)kq * 1024 * 2;
#else
        u.A = xh + ((size_t)pm * 256 * DM + kq * 512) * 2; u.B = wrt + (size_t)kq * 512 * 2;
#endif
        u.orow = pm * 256; u.ocol = 0; u.aux = kq; return true; }
    __device__ __forceinline__ unsigned rowoff(const pg8::Unit&, int) const { return 0u; }
};
struct MoeSched {
    const char* A; const char* B; const int* row_tok; const LAS int* blk_e; int nunits, ntl2, G, c; size_t a_blk_stride, b_exp_stride, b_tile_stride; int ocol_step; unsigned rowbytes;
    __device__ __forceinline__ bool next(int i, pg8::Unit& u) const { const int L = i * G + c; if (L >= nunits) return false;
        const int blk = L >> ntl2, nt = L & ((1 << ntl2) - 1), e = blk_e[blk];
        u.A = A + (size_t)blk * a_blk_stride; u.B = B + (size_t)e * b_exp_stride + (size_t)nt * b_tile_stride; u.orow = blk * 256; u.ocol = nt * ocol_step; u.aux = e; return true; }
    __device__ __forceinline__ unsigned rowoff(const pg8::Unit& u, int r) const { return (unsigned)row_tok[u.orow + r] * rowbytes; }
};

struct Args {
    const float* x; const float* mem; const int* pos; const float* g_mix; const float* w_in; const float* w_conv; const float* g_q_a; const float* w_q_up; const float* g_kv_a; const float* w_kv_up;
    const float* g_conv_out; const float* g_attn_out; const float* w_out; const float* g_xattn; const float* g_mem; const float* w_xq; const float* w_xk; const float* w_xv; const float* w_xo;
    const float* g_moe; const float* w_group; const float* b_group; const float* w_router; const float* b_router; const float* w_gate; const float* w_up; const float* w_down; const float* g_final;
    float* out; unsigned char* ws; unsigned mask; unsigned flags;
};

template <int MAP> __device__ __forceinline__ int map_row(int n) {
    if (MAP == 1) { if (n < C_KR) return n; const int r = n - C_KR; return C_KR + (r < 32 ? 2 * r : 2 * (r - 32) + 1); }
    if (MAP == 2) { const int h = n / DQK, d = n % DQK; if (d < DN) return n; const int r = d - DN; return h * DQK + DN + (r < 32 ? 2 * r : 2 * (r - 32) + 1); }
    if (MAP == 3) { const int h = n >> 8, d = n & 255; return d < DN ? h * DN + d : NH * DN + h * DV + (d - DN); }
    if (MAP == 4) { return ((n >> 7) << 8) + (n & 127); }
    if (MAP == 5) { return ((n >> 7) << 8) + 128 + (n & 127); }
    return n;
}
template <int MAP, bool HAS_GAIN>
__device__ __forceinline__ void transpose_item(const float* W, int ldw, const float* gain, const float* gain2, int gsplit, bf16_t* WT, int ldo, LAS float* scr, int k0, int n0, int lane) {
    float gv = 1.0f;
    if (HAS_GAIN) { const float* gp = (k0 < gsplit) ? gain + k0 : gain2 + (k0 - gsplit); gv = gp[lane]; }
    const int kr = lane >> 3, nc = (lane & 7) * 4;
    f32x4 v[8];
#pragma unroll
    for (int i = 0; i < 8; ++i) v[i] = NTL((const f32x4*)(W + (size_t)(k0 + 8 * i + kr) * ldw + n0 + nc));
#pragma unroll
    for (int i = 0; i < 8; ++i) { const int kk = 8 * i + kr; float g = 1.0f;
        if (HAS_GAIN) g = __shfl(gv, kk);
        LAS float* d = scr + kk * 33 + nc; d[0] = v[i][0] * g; d[1] = v[i][1] * g; d[2] = v[i][2] * g; d[3] = v[i][3] * g; }
    LDS_WAIT(); asm volatile("" ::: "memory");
    const int c = lane & 7;
#pragma unroll
    for (int j = 0; j < 4; ++j) { const int n = (lane >> 3) + 8 * j; const LAS float* s = scr + (8 * c) * 33 + n;
        u32x4 o; o.x = cvt_pk_bf16(s[0 * 33], s[1 * 33]); o.y = cvt_pk_bf16(s[2 * 33], s[3 * 33]); o.z = cvt_pk_bf16(s[4 * 33], s[5 * 33]); o.w = cvt_pk_bf16(s[6 * 33], s[7 * 33]);
        *(u32x4*)(WT + (size_t)map_row<MAP>(n0 + n) * ldo + k0 + 8 * c) = o; }
    LDS_WAIT(); asm volatile("" ::: "memory");
}
template <int MAP, bool HAS_GAIN>
__device__ __forceinline__ void transpose_item8(const float* W, int ldw, const float* gain, float scale, unsigned char* WT, int ldo, LAS float* scr, int k0, int n0, int lane) {
    float gv = scale;
    if (HAS_GAIN) gv = gain[k0 + lane] * scale;
    const int kr = lane >> 3, nc = (lane & 7) * 4;
    f32x4 v[8];
#pragma unroll
    for (int i = 0; i < 8; ++i) v[i] = NTL((const f32x4*)(W + (size_t)(k0 + 8 * i + kr) * ldw + n0 + nc));
#pragma unroll
    for (int i = 0; i < 8; ++i) { const int kk = 8 * i + kr; const float g = __shfl(gv, kk);
        LAS float* d = scr + kk * 33 + nc; d[0] = v[i][0] * g; d[1] = v[i][1] * g; d[2] = v[i][2] * g; d[3] = v[i][3] * g; }
    LDS_WAIT(); asm volatile("" ::: "memory");
    const int c = lane & 7;
#pragma unroll
    for (int j = 0; j < 4; ++j) { const int n = (lane >> 3) + 8 * j; const LAS float* s = scr + (8 * c) * 33 + n;
        u32x2 o; o.x = pk4_fp8(s[0 * 33], s[1 * 33], s[2 * 33], s[3 * 33]); o.y = pk4_fp8(s[4 * 33], s[5 * 33], s[6 * 33], s[7 * 33]);
        *(u32x2*)(WT + (size_t)map_row<MAP>(n0 + n) * ldo + k0 + 8 * c) = o; }
    LDS_WAIT(); asm volatile("" ::: "memory");
}

struct XItem { const float* W; const float* gain; unsigned char* WT; int ldw, ldo, k0, n0, gu, upoff; float scale; };
constexpr int XP_PITCH = 528, XP_BUF = 128 * XP_PITCH;
static_assert(2 * XP_BUF <= TAB_OFF, "transposer LDS");
__device__ __forceinline__ void xp_load(f32x4 (&v)[8][4], f32x4 (&g)[8], const XItem& x, int wave, int lane) {
    const int nq = (wave & 1) * 64 + lane, kg = wave >> 1;
    if (x.gain) { const float* gp = x.gain + x.k0 + 4 * kg;
#pragma unroll
        for (int j = 0; j < 8; ++j) g[j] = *(const f32x4*)(gp + 16 * j); }
    else {
#pragma unroll
        for (int j = 0; j < 8; ++j) g[j] = (f32x4){1.f, 1.f, 1.f, 1.f}; }
    const float* p = x.W + (size_t)(x.k0 + 4 * kg) * x.ldw + x.n0 + 4 * nq;
#pragma unroll
    for (int j = 0; j < 8; ++j)
#pragma unroll
        for (int r = 0; r < 4; ++r) v[j][r] = __builtin_nontemporal_load((const f32x4*)(p + (size_t)(16 * j + r) * x.ldw));
}
__device__ __forceinline__ void xp_pack(const f32x4 (&v)[8][4], const f32x4 (&g)[8], const XItem& x, LAS unsigned char* buf, int wave, int lane) {
    const int nq = (wave & 1) * 64 + lane, kg = wave >> 1;
    LAS unsigned char* d = buf + nq * XP_PITCH + kg * 128;
#pragma unroll
    for (int j = 0; j < 8; ++j) {
        const f32x4 gs = g[j] * x.scale;
        u32x4 o;
#pragma unroll
        for (int i = 0; i < 4; ++i) o[i] = pk4_fp8(v[j][0][i] * gs[0], v[j][1][i] * gs[1], v[j][2][i] * gs[2], v[j][3][i] * gs[3]);
        *(LAS u32x4*)(d + j * 16) = o;
    }
}
__device__ __forceinline__ void xp_store(const XItem& x, const LAS unsigned char* buf, int wave, int lane) {
    const int c = lane & 7;
#pragma unroll
    for (int u = 0; u < 2; ++u) {
        const int nq = (wave * 2 + u) * 8 + (lane >> 3);
        const LAS unsigned char* s = buf + nq * XP_PITCH + c * 16;
        u32x4 r[4];
#pragma unroll
        for (int q = 0; q < 4; ++q) r[q] = *(const LAS u32x4*)(s + q * 128);
#pragma unroll
        for (int i = 0; i < 4; ++i) { const int n = x.n0 + 4 * nq + i; const int row = x.gu ? ((n >> 7) << 8) + (n & 127) + x.upoff : n;
            __builtin_nontemporal_store((u32x4){r[0][i], r[1][i], r[2][i], r[3][i]}, (u32x4*)(x.WT + (size_t)row * x.ldo + x.k0 + 16 * c)); }
    }
}
__device__ __forceinline__ void row_to_bf16(const float* xrow, bf16_t* orow, float* ssq_out, int lane) {
    const f32x4* xr = (const f32x4*)xrow + lane; f32x4 v[8]; float s = 0.f;
#pragma unroll
    for (int j = 0; j < 8; ++j) { v[j] = NTL(xr + 64 * j); s += (v[j][0] * v[j][0] + v[j][1] * v[j][1]) + (v[j][2] * v[j][2] + v[j][3] * v[j][3]); }
    s = wave_sum(s);
    u32x2* o8 = (u32x2*)orow + lane;
#pragma unroll
    for (int j = 0; j < 8; ++j) { u32x2 w; w.x = cvt_pk_bf16(v[j][0], v[j][1]); w.y = cvt_pk_bf16(v[j][2], v[j][3]); o8[64 * j] = w; }
    if (lane == 0) *ssq_out = s;
}

__device__ __forceinline__ void row_to_f8(const float* xrow, unsigned char* orow, float* ssq_out, int lane) {
    const f32x4* xr = (const f32x4*)xrow + lane; f32x4 v[8]; float s = 0.f;
#pragma unroll
    for (int j = 0; j < 8; ++j) { v[j] = NTL(xr + 64 * j); s += (v[j][0] * v[j][0] + v[j][1] * v[j][1]) + (v[j][2] * v[j][2] + v[j][3] * v[j][3]); }
    s = wave_sum(s);
    unsigned* o4 = (unsigned*)orow + lane;
#pragma unroll
    for (int j = 0; j < 8; ++j) o4[64 * j] = pk4_fp8(v[j][0], v[j][1], v[j][2], v[j][3]);
    if (lane == 0) *ssq_out = s;
}

constexpr int KROW = 400, VROW = 144;
constexpr int KBUF = 64 * KROW, VBUF = 128 * VROW;
constexpr int ATT_K0 = 0, ATT_V0 = 2 * KBUF;
static_assert(2 * KBUF + 2 * VBUF <= RING_BYTES, "attention LDS");
__device__ __forceinline__ void mla_attn_unit(LAS unsigned char* lds, const int wave_id, const bf16_t* qb, const bf16_t* kb, const bf16_t* kr, const bf16_t* vT, bf16_t* oatt, fx64* ssq_att, int b, int h, int qblk) {
    int lane_ = lane_id(); asm volatile("" : "+v"(lane_));
    const int wid = wave_id, lane = lane_, tid = wid * 64 + lane, r32 = lane & 31, hi = lane >> 5;
    const int q0 = qblk * 256 + wid * 32;
    const size_t tok0 = (size_t)b * T;
    bf16x8 qf[12];
    { const bf16_t* qrow = qb + (tok0 + q0 + r32) * (NH * DQK) + h * DQK + hi * 8;
#pragma unroll
      for (int ks = 0; ks < 12; ++ks) qf[ks] = *(const bf16x8*)(qrow + ks * 16); }
    const int kn_r0 = tid >> 4, kn_c = tid & 15;
    const int kr_r = tid >> 3, kr_c = tid & 7;
    const int v_r0 = tid >> 3, v_c = tid & 7;
    const bf16_t* gkn = kb + (tok0 + kn_r0) * (NH * DN) + h * DN + kn_c * 8;
    const bf16_t* gkr = kr + (tok0 + kr_r) * DR + kr_c * 8;
    const bf16_t* gv = vT + (size_t)(h * DV + v_r0) * NTOK + tok0 + v_c * 8;
    const int lkn = kn_r0 * KROW + kn_c * 16, lkr = kr_r * KROW + 256 + kr_c * 16, lv = v_r0 * VROW + v_c * 16;
    const int ntiles = 4 * (qblk + 1);
    u32x4 sk0, sk1, skr, sv0, sv1;
#define ATT_LOAD(j) do { const size_t ko = (size_t)(j) * 64; sk0 = *(const u32x4*)(gkn + ko * (NH * DN)); sk1 = *(const u32x4*)(gkn + (ko + 32) * (NH * DN)); \
        skr = *(const u32x4*)(gkr + ko * DR); sv0 = *(const u32x4*)(gv + ko); sv1 = *(const u32x4*)(gv + ko + (size_t)64 * NTOK); } while (0)
#define ATT_WRITE(bufi) do { LAS unsigned char* kbp = lds + ATT_K0 + (bufi) * KBUF; LAS unsigned char* vbp = lds + ATT_V0 + (bufi) * VBUF; \
        *(LAS u32x4*)(kbp + lkn) = sk0; *(LAS u32x4*)(kbp + lkn + 32 * KROW) = sk1; *(LAS u32x4*)(kbp + lkr) = skr; \
        *(LAS u32x4*)(vbp + lv) = sv0; *(LAS u32x4*)(vbp + lv + 64 * VROW) = sv1; } while (0)
    f32x16 o[4];
#pragma unroll
    for (int d = 0; d < 4; ++d)
#pragma unroll
        for (int r = 0; r < 16; ++r) o[d][r] = 0.f;
    float m_run = -1.0e30f, l_run = 0.f;
    ATT_LOAD(0); ATT_WRITE(0);
    __syncthreads();
    for (int j = 0; j < ntiles; ++j) {
        const int buf = j & 1;
        if (j + 1 < ntiles) ATT_LOAD(j + 1);
        const int jrel = j - 4 * qblk;
        if (jrel <= (wid >> 1)) {
            const LAS unsigned char* kp = lds + ATT_K0 + buf * KBUF + r32 * KROW + hi * 16;
            const LAS unsigned char* vp = lds + ATT_V0 + buf * VBUF + r32 * VROW + hi * 16;
            f32x16 s0, s1;
#pragma unroll
            for (int r = 0; r < 16; ++r) { s0[r] = 0.f; s1[r] = 0.f; }
#pragma unroll
            for (int ks = 0; ks < 12; ++ks) { const bf16x8 a0 = *(const LAS bf16x8*)(kp + ks * 32), a1 = *(const LAS bf16x8*)(kp + 32 * KROW + ks * 32);
                s0 = __builtin_amdgcn_mfma_f32_32x32x16_bf16(a0, qf[ks], s0, 0, 0, 0);
                s1 = __builtin_amdgcn_mfma_f32_32x32x16_bf16(a1, qf[ks], s1, 0, 0, 0); }
            if (jrel == (wid >> 1)) {
                const int qrel = (wid & 1) * 32 + r32;
#pragma unroll
                for (int r = 0; r < 16; ++r) { const int kk = (r & 3) + 8 * (r >> 2) + 4 * hi;
                    if (kk > qrel) s0[r] = -1.0e30f; if (kk + 32 > qrel) s1[r] = -1.0e30f; }
            }
            float mx = s0[0];
#pragma unroll
            for (int r = 1; r < 16; ++r) mx = fmaxf(mx, s0[r]);
#pragma unroll
            for (int r = 0; r < 16; ++r) mx = fmaxf(mx, s1[r]);
            mx = fmaxf(mx, __shfl_xor(mx, 32));
            const float mn = fmaxf(m_run, mx), alpha = __builtin_amdgcn_exp2f(m_run - mn); m_run = mn;
            float ps = 0.f;
#pragma unroll
            for (int r = 0; r < 16; ++r) { s0[r] = __builtin_amdgcn_exp2f(s0[r] - mn); s1[r] = __builtin_amdgcn_exp2f(s1[r] - mn); ps += s0[r] + s1[r]; }
            l_run = l_run * alpha + ps;
#pragma unroll
            for (int d = 0; d < 4; ++d)
#pragma unroll
                for (int r = 0; r < 16; ++r) o[d][r] *= alpha;
            bf16x8 pf[4];
#pragma unroll
            for (int s = 0; s < 4; ++s) { const int base = (s & 1) * 8; u32x4 w;
                if (s < 2) { w.x = cvt_pk_bf16(s0[base + 0], s0[base + 1]); w.y = cvt_pk_bf16(s0[base + 2], s0[base + 3]); w.z = cvt_pk_bf16(s0[base + 4], s0[base + 5]); w.w = cvt_pk_bf16(s0[base + 6], s0[base + 7]); }
                else       { w.x = cvt_pk_bf16(s1[base + 0], s1[base + 1]); w.y = cvt_pk_bf16(s1[base + 2], s1[base + 3]); w.z = cvt_pk_bf16(s1[base + 4], s1[base + 5]); w.w = cvt_pk_bf16(s1[base + 6], s1[base + 7]); }
                pf[s] = *(bf16x8*)&w; }
#pragma unroll
            for (int d = 0; d < 4; ++d)
#pragma unroll
                for (int s = 0; s < 4; ++s) { const bf16x8 vf = *(const LAS bf16x8*)(vp + d * 32 * VROW + s * 32);
                    o[d] = __builtin_amdgcn_mfma_f32_32x32x16_bf16(vf, pf[s], o[d], 0, 0, 0); }
        }
        if (j + 1 < ntiles) ATT_WRITE(buf ^ 1);
        __syncthreads();
    }
#undef ATT_LOAD
#undef ATT_WRITE
    const float l = l_run + __shfl_xor(l_run, 32), inv = 1.0f / l;
    float q = 0.f;
    bf16_t* orow = oatt + (tok0 + q0 + r32) * (NH * DV) + h * DV + 4 * hi;
#pragma unroll
    for (int d = 0; d < 4; ++d)
#pragma unroll
        for (int g = 0; g < 4; ++g) { const float a0 = o[d][4 * g] * inv, a1 = o[d][4 * g + 1] * inv, a2 = o[d][4 * g + 2] * inv, a3 = o[d][4 * g + 3] * inv;
            q += (a0 * a0 + a1 * a1) + (a2 * a2 + a3 * a3);
            u32x2 w; w.x = cvt_pk_bf16(a0, a1); w.y = cvt_pk_bf16(a2, a3); *(u32x2*)(orow + d * 32 + g * 8) = w; }
    q += __shfl_xor(q, 32);
    if (hi == 0) fx_add(ssq_att + tok0 + q0 + r32, q);
}

#define ssq_x ((float*)(ws + CTL_SSQ_X))
#define ssq_q ((fx64*)(ws + CTL_SSQ_Q))
#define ssq_kv ((fx64*)(ws + CTL_SSQ_KV))
#define ssq_att ((fx64*)(ws + CTL_SSQ_ATT))
#define ssq_1 ((fx64*)(ws + CTL_SSQ_1))
#define ssq_mem ((float*)(ws + CTL_SSQ_MEM))
#define cnt ((int*)(ws + CTL_CNT))
#define tab ((f32x2*)(ws + WS_TAB))
#define Wrt ((bf16_t*)(ws + WS_WRT))
#define ssq_2 ((fx64*)(ws + CTL_SSQ_2))
#define x2l ((bf16_t*)(ws + A_X2L))
#define x1l ((bf16_t*)(ws + A_X2L))
#define rslab ((float*)(ws + A_SLAB))
#define tok_eid ((int*)(ws + TOK_EID))
#define tok_gw ((float*)(ws + TOK_GW))
#define tok_rank ((int*)(ws + TOK_RANK))
#define tok_dest ((int*)(ws + TOK_DEST))
#define tok_rstd ((float*)(ws + TOK_RSTD))
#define row_tok ((int*)(ws + ROW_TOK))
#define row_rs ((float*)(ws + ROW_RS))
#define row_w ((float*)(ws + ROW_W))
#define Win_t ((bf16_t*)(ws + WS_WIN))
#define Wq_t ((bf16_t*)(ws + WS_WQ))
#define Wkv_t ((bf16_t*)(ws + WS_WKV))
#define Wout_t ((bf16_t*)(ws + WS_WOUT))
#define Wxq_n ((bf16_t*)(ws + WS_WXQ))
#define Wxk_t ((bf16_t*)(ws + WS_WXK))
#define Wxv_t ((bf16_t*)(ws + WS_WXV))
#define Wxo_t ((bf16_t*)(ws + WS_WXO))
#define Wgu_t ((bf16_t*)(ws + WS_WGU))
#define Wd_t ((bf16_t*)(ws + WS_WD))
#define zb ((bf16_t*)(ws + A_ZB))
#define x1b ((bf16_t*)(ws + A_X1B))
#define qx ((bf16_t*)(ws + A_QX))
#define x2b ((bf16_t*)(ws + A_X2B))
#define actb ((bf16_t*)(ws + A_ACT))
#define xb ((bf16_t*)(ws + A_XB))
#define qb ((bf16_t*)(ws + A_QB))
#define ycat ((bf16_t*)(ws + A_YCAT))
#define pbuf ((bf16_t*)(ws + A_PBUF))
#define kb ((bf16_t*)(ws + A_KB))
#define ox ((bf16_t*)(ws + A_OX))
#define vT ((bf16_t*)(ws + A_VT))
#define oatt ((bf16_t*)(ws + A_OATT))
#define memb ((bf16_t*)(ws + A_MEMB))
#define kx ((bf16_t*)(ws + A_KX))
#define vx ((bf16_t*)(ws + A_VXT))
#define Mt ((bf16_t*)(ws + A_MT))
#define VWt ((bf16_t*)(ws + A_VWT))
#define krope ((bf16_t*)(ws + A_KROPE))
#define ybuf ((bf16_t*)(ws + A_YBUF))
#define x2f8 ((unsigned char*)(ws + ARENA + 90 * MiB))
#define x1f8 x2f8
#define Mt8 ((unsigned char*)(ws + A_MT))
#define VWt8 ((unsigned char*)(ws + A_VWT))
#define P8b ((unsigned char*)(ws + A_PBUF))
#define act8 ((unsigned char*)(ws + A_ACT))
#define Wgu8 ((unsigned char*)(ws + WS_WGU))
#define Wd8 ((unsigned char*)(ws + WS_WD))
typedef const __attribute__((address_space(4))) Args* KArgs;
#define PHASE_ARGS() KArgs ka = (KArgs)__builtin_amdgcn_kernarg_segment_ptr(); asm volatile("" : "+s"(ka)); unsigned char* ws = ka->ws
#define PHASE_IDS() int lane_ = lane_id(); asm volatile("" : "+v"(lane_)); const int lane = lane_, wave = wave_id, tid = wave * 64 + lane; \
    const int gw = vcu * NWAVES + wave, NGW = G * NWAVES, gt = vcu * (NWAVES * 64) + tid, NGT = G * NWAVES * 64; (void)lane; (void)gw; (void)NGW; (void)gt; (void)NGT
__global__ void __launch_bounds__(NWAVES * 64, 2) hymba_fwd(Args a_unused) {
    extern __shared__ __attribute__((aligned(16))) unsigned char lds_raw[];
    LAS unsigned char* lds = (LAS unsigned char*)lds_raw;
    volatile LAS unsigned* MISC = (volatile LAS unsigned*)(lds + MISC_OFF);
    const int wave_id = __builtin_amdgcn_readfirstlane(threadIdx.x >> 6);
    const int G = gridDim.x, bx = blockIdx.x;
    const int vcu = (G % 8 == 0) ? (bx % 8) * (G / 8) + bx / 8 : bx;
    unsigned mask; XcdBarrier bar;
    { PHASE_ARGS(); mask = ka->mask; bar.bar = (unsigned*)(ws + WS_CTL); bar.x = 0; bar.st = nullptr; bar.wave = 0; }
    for (int u = wave_id * 64 + lane_id(); u < (LDS_BYTES - TAB_OFF) / 4; u += NWAVES * 64) ((LAS unsigned*)(lds + TAB_OFF))[u] = 0u;
    __syncthreads();
    const bool one_launch = (mask & (mask - 1u)) != 0u;
    if (one_launch) bar = xcd_barrier_post(bar.bar, MISC, wave_id);
#ifndef CT_MASK
#define CT_MASK 0xffffu
#endif
#define IN(k) ((((CT_MASK) >> (k)) & 1u) != 0u && ((mask >> (k)) & 1u) != 0u)
#define SEL(real, dummy) ((ka->flags & 2u) ? (dummy) : (real))
#define DUMMYF ((float*)(ws + WS_DUMMY))
#define SEAM(k) do { if (IN(k) && (mask >> ((k) + 1)) != 0u) xcd_barrier(bar); } while (0)

    if (IN(0)) {
        PHASE_ARGS();
        PHASE_IDS();
        LAS float* scr = (LAS float*)(lds + wave * 16384);
        constexpr int I_IN = 32 * (IN_COLS / 32);
        for (int it = gw; it < I_IN; it += NGW) { const int nb = it % (IN_COLS / 32), kb_ = it / (IN_COLS / 32); transpose_item<1, true>(ka->w_in, IN_COLS, ka->g_mix, ka->g_mix, DM, Win_t, DM, scr, kb_ * 64, nb * 32, lane); }
        for (int m = gw; m < NTOK; m += NGW) row_to_bf16(ka->x + (size_t)m * DM, xb + (size_t)m * DM, ssq_x + m, lane);
        for (int i = gt; i < NTOK * 32; i += NGT) { const int tok = i >> 5, p = i & 31;
            const float inv_freq = 1.0f / powf(10000.0f, (float)(2 * p) / 64.0f), ang = (float)ka->pos[tok] * inv_freq;
            tab[i] = (f32x2){cosf(ang), sinf(ang)}; }
        for (int i = gt; i < (ZC - IN_COLS) * DM / 8; i += NGT) ((u32x4*)(Win_t + (size_t)IN_COLS * DM))[i] = (u32x4){0u, 0u, 0u, 0u};
    }
    SEAM(0);

    if (IN(1)) {
        PHASE_ARGS();
        PHASE_IDS();
        auto xp_all = [&]() {
            constexpr int NX = 2048 + 192;
            auto xitem = [&](int it) -> XItem { XItem x; if (it >= 2048) it += 1024;
                if (it < 2048) { const int e = it >> 5, up = (it >> 4) & 1, kb_ = it & 15;
                    x.W = (up ? ka->w_up : ka->w_gate) + (size_t)e * DM * DE; x.gain = ka->g_moe; x.WT = Wgu8 + (size_t)e * 1024 * DM; x.ldw = DE; x.ldo = DM; x.k0 = kb_ * 128; x.n0 = 0; x.gu = 1; x.upoff = up * 128; x.scale = F8_SW; }
                else if (it < 3072) { const int r = it - 2048, e = r >> 4, kb_ = (r >> 2) & 3, nb = r & 3;
                    x.W = ka->w_down + (size_t)e * DE * DM; x.gain = nullptr; x.WT = Wd8 + (size_t)e * DM * DE; x.ldw = DM; x.ldo = DE; x.k0 = kb_ * 128; x.n0 = nb * 512; x.gu = 0; x.upoff = 0; x.scale = F8_SD; }
                else { const int r = it - 3072, which = r >> 6, kb_ = (r >> 2) & 15, nb = r & 3;
                    x.W = which == 0 ? ka->w_xk : (which == 1 ? ka->w_xv : ka->w_xo); x.gain = which < 2 ? ka->g_mem : nullptr;
                    x.WT = which == 0 ? (unsigned char*)Wxk_t : (which == 1 ? (unsigned char*)Wxv_t : (unsigned char*)Wxo_t); x.ldw = DM; x.ldo = DM; x.k0 = kb_ * 128; x.n0 = nb * 512; x.gu = 0; x.upoff = 0; x.scale = F8_SX; }
                return x; };
            f32x4 v[8][4], gq[8];
            int it = vcu, b = 0;
            XItem cur = xitem(it < NX ? it : 0);
            if (it < NX) xp_load(v, gq, cur, wave, lane);
            while (it < NX) {
                LAS unsigned char* buf = lds + b * XP_BUF;
                xp_pack(v, gq, cur, buf, wave, lane);
                const int nit = it + G;
                XItem nxt = xitem(nit < NX ? nit : 0);
                if (nit < NX) xp_load(v, gq, nxt, wave, lane);
                __syncthreads();
                xp_store(cur, buf, wave, lane);
                cur = nxt; it = nit; b ^= 1;
            }
            __syncthreads();
            { LAS float* scr = (LAS float*)(lds + wave * 16384);
              constexpr int I_Q = 8 * 48, I_KV = 4 * 64, I_SQ = 32 * 64;
              for (int it = gw; it < I_Q + I_KV + I_SQ; it += NGW) {
                  int r = it;
                if (r < I_Q) { const int nb = r % 48, kb_ = r / 48; transpose_item<2, true>(ka->w_q_up, NH * DQK, ka->g_q_a, ka->g_q_a, QL, Wq_t, QL, scr, kb_ * 64, nb * 32, lane); continue; } r -= I_Q;
                if (r < I_KV) { const int nb = r % 64, kb_ = r / 64; transpose_item<3, true>(ka->w_kv_up, NH * (DN + DV), ka->g_kv_a, ka->g_kv_a, KVL, Wkv_t, KVL, scr, kb_ * 64, nb * 32, lane); continue; } r -= I_KV;
                { const int nb = r % 64, kb_ = r / 64; transpose_item<0, true>(ka->w_out, DM, ka->g_conv_out, ka->g_attn_out, CW, Wout_t, DM, scr, kb_ * 64, nb * 32, lane); }
              }
            for (int m = gw; m < NMEM; m += NGW) row_to_f8(ka->mem + (size_t)m * DM, (unsigned char*)memb + (size_t)m * DM, ssq_mem + m, lane);
            for (int i0 = gt; i0 < DM * DM / 8; i0 += 4 * NGT) {
                f32x4 p0[4], p1[4]; float g[4];
#pragma unroll
                for (int j = 0; j < 4; ++j) { const int i = min(i0 + j * NGT, DM * DM / 8 - 1); g[j] = ka->g_xattn[i / (DM / 8)]; p0[j] = NTL((const f32x4*)ka->w_xq + 2 * i); p1[j] = NTL((const f32x4*)ka->w_xq + 2 * i + 1); }
#pragma unroll
                for (int j = 0; j < 4; ++j) { const int i = i0 + j * NGT; const f32x4 q0 = p0[j] * (g[j] * F8_SX), q1 = p1[j] * (g[j] * F8_SX);
                    u32x2 w; w.x = pk4_fp8(q0[0], q0[1], q0[2], q0[3]); w.y = pk4_fp8(q1[0], q1[1], q1[2], q1[3]); if (i < DM * DM / 8) ((u32x2*)Wxq_n)[i] = w; }
            }
            for (int i0 = gt; i0 < 256 * DM; i0 += 4 * NGT) {
                float wv[4];
#pragma unroll
                for (int j = 0; j < 4; ++j) { const int i = min(i0 + j * NGT, 256 * DM - 1), n = i / DM, k = i % DM;
                    const int c = (n < NRT) ? n : ((n >= 128 && n < 128 + NRT) ? n - 128 : 0);
                    wv[j] = ka->g_moe[k] * (c < NG ? ka->w_group[(size_t)k * NG + c] : ka->w_router[(size_t)k * NE + (c - NG)]); }
#pragma unroll
                for (int j = 0; j < 4; ++j) { const int i = i0 + j * NGT, n = i / DM, k = i % DM; unsigned a0 = 0u, a1 = 0u;
                    const bool used = (n < NRT) || (n >= 128 && n < 128 + NRT);
                    if (used) { const unsigned hb = cvt_pk_bf16(wv[j], 0.f) & 0xffffu;
                        if (n < 128) { a0 = hb; a1 = hb; } else { a0 = cvt_pk_bf16(wv[j] - bf_lo(hb), 0.f) & 0xffffu; } }
                    if (i < 256 * DM) { Wrt[(size_t)n * (2 * DM) + k] = (bf16_t)a0; Wrt[(size_t)n * (2 * DM) + DM + k] = (bf16_t)a1; } }
            }
            }
            __syncthreads();
        };
        const bool late = ((bx >> 3) & 1) != 0;
        if (!late) xp_all();
        {
            pg8::DenseSched S; S.init(xb, Win_t, DM, DM, NTOK, ZC, G, bx);
            EpiZ E{zb, krope, ssq_x, SEL(ssq_q, (fx64*)DUMMYF), SEL(ssq_kv, (fx64*)DUMMYF + NTOK), tab};
            pg8::gemm_phase<EpiZ, pg8::DenseSched, false>(lds, wave_id, DM, DM, DM, S, E);
        }
        if (late) { __syncthreads(); xp_all(); }
    }
    SEAM(1);

    if (IN(2)) {
        PHASE_ARGS();
        const bool deal = (G == 256);
        const int grp = deal ? (bx >> 6) : -1, c6 = deal ? (bx & 63) : bx, g6 = deal ? 64 : G, gL = g6, cL = c6;
        if (!deal || grp == 0) { pg8::DenseSched S; S.init(memb, Wxk_t, DM, DM, NMEM, DM, gL, cL); S.es = 1; EpiF8Rms E{(unsigned char*)kx, DM, ssq_mem, 1.0f / DM, 1.0f / F8_SX};
          pg8::gemm_phase<EpiF8Rms, pg8::DenseSched, false, 1>(lds, wave_id, DM, DM, DM, S, E); }
        if (!deal || grp == 1) { pg8::DenseSched S; S.init(memb, Wxv_t, DM, DM, NMEM, DM, gL, cL); S.es = 1; EpiF8Rms E{(unsigned char*)vx, DM, ssq_mem, 1.0f / DM, 1.0f / F8_SX};
          pg8::gemm_phase<EpiF8Rms, pg8::DenseSched, false, 1>(lds, wave_id, DM, DM, DM, S, E); }
        { pg8::DenseSched S; S.init(zb + C_Q, Wq_t, ZC, QL, NTOK, NH * DQK, deal ? 128 : G, deal ? (bx & 127) : bx, 0, deal ? (grp >= 2 ? 384 : 0) : -1); EpiQ E{qb, ssq_q, tab};
          pg8::gemm_phase<EpiQ, pg8::DenseSched, false>(lds, wave_id, QL, ZC, QL, S, E); }
        { const int f = grp == 1 ? 128 : (grp == 2 ? 192 : 0), n = grp == 0 ? 128 : ((grp == 1 || grp == 2) ? 64 : 0);
          pg8::DenseSched S; S.init(zb + C_KV, Wkv_t, ZC, KVL, NTOK, NH * DN, g6, c6, deal ? f : 0, deal ? n : -1); EpiBf16<3> E{kb, NH * DN, (const float*)ssq_kv, 1.0f / KVL, 1.0f};
          pg8::gemm_phase<EpiBf16<3>, pg8::DenseSched, false>(lds, wave_id, KVL, ZC, KVL, S, E); }
        { const int f = grp == 1 ? 64 : (grp == 3 ? 192 : 0), n = grp == 0 ? 64 : (grp == 1 ? 128 : (grp == 3 ? 64 : 0));
          pg8::DenseSched S; S.init(Wkv_t + (size_t)NH * DN * KVL, zb + C_KV, KVL, ZC, NH * DV, NTOK, g6, c6, deal ? f : 0, deal ? n : -1); EpiColScale<true> E{vT, NTOK, ssq_kv, 1.0f / KVL};
          pg8::gemm_phase<EpiColScale<true>, pg8::DenseSched, false>(lds, wave_id, KVL, KVL, ZC, S, E); }
    }
    SEAM(2);

    if (IN(3)) {
        PHASE_ARGS();
        PHASE_IDS();
        auto conv_rows = [&]() {
            float wc0[2][8], wc1[2][8], wc2[2][8];
#pragma unroll
            for (int g = 0; g < 2; ++g)
#pragma unroll
                for (int e = 0; e < 8; ++e) { const int c = g * 512 + lane * 8 + e; wc0[g][e] = ka->w_conv[c]; wc1[g][e] = ka->w_conv[CW + c]; wc2[g][e] = ka->w_conv[2 * CW + c]; }
            for (int ch = gw; ch < NTOK / 8; ch += NGW) {
                const int t0 = ch * 8, tl = t0 & (T - 1);
                float u1[2][8], u2[2][8];
#pragma unroll
                for (int g = 0; g < 2; ++g) { const int c = g * 512 + lane * 8;
                    if (tl >= 1) { const u32x4 cg = *(const u32x4*)(zb + (size_t)(t0 - 1) * ZC + CW + c), hg = *(const u32x4*)(zb + (size_t)(t0 - 1) * ZC + 2 * CW + c);
#pragma unroll
                        for (int e = 0; e < 4; ++e) { u1[g][2 * e] = bf_lo(cg[e]) * bf_lo(hg[e]); u1[g][2 * e + 1] = bf_hi(cg[e]) * bf_hi(hg[e]); } }
                    else {
#pragma unroll
                        for (int e = 0; e < 8; ++e) u1[g][e] = 0.f; }
                    if (tl >= 2) { const u32x4 cg = *(const u32x4*)(zb + (size_t)(t0 - 2) * ZC + CW + c), hg = *(const u32x4*)(zb + (size_t)(t0 - 2) * ZC + 2 * CW + c);
#pragma unroll
                        for (int e = 0; e < 4; ++e) { u2[g][2 * e] = bf_lo(cg[e]) * bf_lo(hg[e]); u2[g][2 * e + 1] = bf_hi(cg[e]) * bf_hi(hg[e]); } }
                    else {
#pragma unroll
                        for (int e = 0; e < 8; ++e) u2[g][e] = 0.f; } }
                for (int rp = 0; rp < 8; rp += 2) {
                    u32x4 bg[2][2], cg[2][2], hg[2][2];
#pragma unroll
                    for (int rr = 0; rr < 2; ++rr)
#pragma unroll
                        for (int g = 0; g < 2; ++g) { const size_t row = (size_t)(t0 + rp + rr); const int c = g * 512 + lane * 8;
                            bg[rr][g] = NTL((const u32x4*)(zb + row * ZC + c)); cg[rr][g] = NTL((const u32x4*)(zb + row * ZC + CW + c)); hg[rr][g] = NTL((const u32x4*)(zb + row * ZC + 2 * CW + c)); }
#pragma unroll
                    for (int rr = 0; rr < 2; ++rr) { const size_t row = (size_t)(t0 + rp + rr);
                        float y[2][8]; float q = 0.f;
#pragma unroll
                        for (int g = 0; g < 2; ++g) {
#pragma unroll
                            for (int e = 0; e < 8; ++e) { const float bb = (e & 1) ? bf_hi(bg[rr][g][e >> 1]) : bf_lo(bg[rr][g][e >> 1]), cc = (e & 1) ? bf_hi(cg[rr][g][e >> 1]) : bf_lo(cg[rr][g][e >> 1]), hh = (e & 1) ? bf_hi(hg[rr][g][e >> 1]) : bf_lo(hg[rr][g][e >> 1]);
                                const float u0 = cc * hh, cv = wc0[g][e] * u2[g][e] + wc1[g][e] * u1[g][e] + wc2[g][e] * u0;
                                y[g][e] = bb * cv; q += y[g][e] * y[g][e]; u2[g][e] = u1[g][e]; u1[g][e] = u0; } }
                        q = wave_sum(q);
                        const float rs = 1.0f / sqrtf(q * (1.0f / CW) + EPS);
#pragma unroll
                        for (int g = 0; g < 2; ++g) { const int c = g * 512 + lane * 8;
                            u32x4 w; w.x = cvt_pk_bf16(y[g][0] * rs, y[g][1] * rs); w.y = cvt_pk_bf16(y[g][2] * rs, y[g][3] * rs); w.z = cvt_pk_bf16(y[g][4] * rs, y[g][5] * rs); w.w = cvt_pk_bf16(y[g][6] * rs, y[g][7] * rs);
                            *(u32x4*)(ycat + row * DM + c) = w; } }
                }
            }
        };
        const bool late = ((bx >> 3) & 1) != 0;
        if (!late) conv_rows();
        for (int pp = vcu; pp < NB * NH * 4; pp += G) { const int b = pp >> 5, h = (pp >> 2) & 7, ip = pp & 3;
            mla_attn_unit(lds, wave_id, qb, kb, krope, vT, oatt, SEL(ssq_att, (fx64*)DUMMYF), b, h, 7 - ip);
            mla_attn_unit(lds, wave_id, qb, kb, krope, vT, oatt, SEL(ssq_att, (fx64*)DUMMYF), b, h, ip); }
        if (late) conv_rows();
    }
    SEAM(3);

    if (IN(4)) {
        PHASE_ARGS();
        PHASE_IDS();
        for (int ch = gw; ch < NTOK / 4; ch += NGW) {
            u32x4 og[4][2]; float ra[4];
#pragma unroll
            for (int rr = 0; rr < 4; ++rr) { const size_t row = (size_t)ch * 4 + rr;
#pragma unroll
                for (int g = 0; g < 2; ++g) og[rr][g] = NTL((const u32x4*)(oatt + row * (NH * DV) + g * 512 + lane * 8));
                ra[rr] = 1.0f / sqrtf(fx_get(ssq_att + row) * (1.0f / (NH * DV)) + EPS); }
#pragma unroll
            for (int rr = 0; rr < 4; ++rr) { const size_t row = (size_t)ch * 4 + rr;
#pragma unroll
                for (int g = 0; g < 2; ++g) { u32x4 w2;
#pragma unroll
                    for (int e = 0; e < 4; ++e) w2[e] = cvt_pk_bf16(bf_lo(og[rr][g][e]) * ra[rr], bf_hi(og[rr][g][e]) * ra[rr]);
                    *(u32x4*)(ycat + row * DM + CW + g * 512 + lane * 8) = w2; } }
        }
    }
    SEAM(4);

    if (IN(5)) {
        PHASE_ARGS();
        const bool late = ((bx >> 3) & 1) != 0;
        if (late) {
    #if XATT_FP8
            { MtSched S{(const char*)kx, (const char*)Wxq_n, G, vcu, 1}; EpiF8 E{Mt8, DM, F8_SM * LOG2E * 0.04419417382415922f / F8_SX};
              pg8::gemm_phase<EpiF8, MtSched, false, 1>(lds, wave_id, XD, DM, DM, S, E); }
            { VWtSched S{(const char*)Wxo_t, (const char*)vx, G, vcu, 1}; EpiF8 E{VWt8, XH * MEM, F8_SV / F8_SX};
              pg8::gemm_phase<EpiF8, VWtSched, false, 1>(lds, wave_id, XD, DM, DM, S, E); }
    #else
            { MtSched S{(const char*)kx, (const char*)Wxq_n, G, vcu, 2}; EpiBf16<0> E{Mt, DM, nullptr, 0.f, LOG2E * 0.04419417382415922f};
              pg8::gemm_phase<EpiBf16<0>, MtSched, false>(lds, wave_id, XD, DM, DM, S, E); }
            { VWtSched S{(const char*)Wxo_t, (const char*)vx, G, vcu, 2}; EpiBf16<0> E{VWt, XH * MEM, nullptr, 0.f, 1.0f};
              pg8::gemm_phase<EpiBf16<0>, VWtSched, false>(lds, wave_id, XD, DM, DM, S, E); }
    #endif
        }
        {
            pg8::DenseSched S; S.init(ycat, Wout_t, DM, DM, NTOK, DM, G, bx);
            EpiResidHL<false, false, X1_LO != 0> E{nullptr, xb, nullptr, x1b, x1l, SEL(ssq_1, (fx64*)DUMMYF), XATT_FP8 ? x1f8 : nullptr, 1.0f};
            pg8::gemm_phase<EpiResidHL<false, false, X1_LO != 0>, pg8::DenseSched, false>(lds, wave_id, DM, DM, DM, S, E);
        }
        if (!late) {
    #if XATT_FP8
            { MtSched S{(const char*)kx, (const char*)Wxq_n, G, vcu, 1}; EpiF8 E{Mt8, DM, F8_SM * LOG2E * 0.04419417382415922f / F8_SX};
              pg8::gemm_phase<EpiF8, MtSched, false, 1>(lds, wave_id, XD, DM, DM, S, E); }
            { VWtSched S{(const char*)Wxo_t, (const char*)vx, G, vcu, 1}; EpiF8 E{VWt8, XH * MEM, F8_SV / F8_SX};
              pg8::gemm_phase<EpiF8, VWtSched, false, 1>(lds, wave_id, XD, DM, DM, S, E); }
    #else
            { MtSched S{(const char*)kx, (const char*)Wxq_n, G, vcu, 2}; EpiBf16<0> E{Mt, DM, nullptr, 0.f, LOG2E * 0.04419417382415922f};
              pg8::gemm_phase<EpiBf16<0>, MtSched, false>(lds, wave_id, XD, DM, DM, S, E); }
            { VWtSched S{(const char*)Wxo_t, (const char*)vx, G, vcu, 2}; EpiBf16<0> E{VWt, XH * MEM, nullptr, 0.f, 1.0f};
              pg8::gemm_phase<EpiBf16<0>, VWtSched, false>(lds, wave_id, XD, DM, DM, S, E); }
    #endif
        }
    }
    SEAM(5);

    if (IN(7)) {
        PHASE_ARGS();
#if XATT_FP8
        CrossSSched S{(const char*)x1f8, (const char*)Mt8, G, vcu, 1};
        EpiSoftmax E{pbuf, XH * MEM, (LAS float*)(lds + EPI_OFF), (LAS float*)(lds + EPI_OFF + 4096), ssq_1, 1.0f / DM, 1.0f / F8_SM, P8b};
        pg8::gemm_phase<EpiSoftmax, CrossSSched, false, 1>(lds, wave_id, DM, DM, DM, S, E);
#else
        CrossSSched S{(const char*)x1b, (const char*)Mt, G, vcu, 2};
        EpiSoftmax E{pbuf, XH * MEM, (LAS float*)(lds + EPI_OFF), (LAS float*)(lds + EPI_OFF + 4096), ssq_1, 1.0f / DM, 1.0f, nullptr};
        pg8::gemm_phase<EpiSoftmax, CrossSSched, false>(lds, wave_id, DM, DM, DM, S, E);
#endif
    }
    SEAM(7);

    if (IN(9)) {
        PHASE_ARGS();
        { PHASE_IDS(); for (int i = gt; i < DM / 8; i += NGT) ((u32x4*)(x2b + (size_t)NTOK * DM))[i] = (u32x4){0u, 0u, 0u, 0u};
          if (MOE_FP8) for (int i = gt; i < DM / 16; i += NGT) ((u32x4*)(x2f8 + (size_t)NTOK * DM))[i] = (u32x4){0u, 0u, 0u, 0u}; }
#if XATT_FP8
        CrossOSched S{(const char*)P8b, (const char*)VWt8, G, vcu, 1};
        EpiResidHL<false, X1_LO != 0, X2_LO != 0> E{nullptr, x1b, x1l, SEL(x2b, (bf16_t*)DUMMYF), SEL(x2l, (bf16_t*)DUMMYF + (size_t)NTOK * DM), SEL(ssq_2, (fx64*)DUMMYF), MOE_FP8 ? x2f8 : nullptr, 1.0f / (F8_SP * F8_SV)};
        pg8::gemm_phase<EpiResidHL<false, X1_LO != 0, X2_LO != 0>, CrossOSched, false, 1>(lds, wave_id, XH * MEM, XH * MEM, XH * MEM, S, E);
#else
        CrossOSched S{(const char*)pbuf, (const char*)VWt, G, vcu, 2};
        EpiResidHL<false, X1_LO != 0, X2_LO != 0> E{nullptr, x1b, x1l, SEL(x2b, (bf16_t*)DUMMYF), SEL(x2l, (bf16_t*)DUMMYF + (size_t)NTOK * DM), SEL(ssq_2, (fx64*)DUMMYF), MOE_FP8 ? x2f8 : nullptr, 1.0f};
        pg8::gemm_phase<EpiResidHL<false, X1_LO != 0, X2_LO != 0>, CrossOSched, false>(lds, wave_id, XH * MEM, XH * MEM, XH * MEM, S, E);
#endif
    }
    SEAM(9);

    if (IN(10)) {
        PHASE_ARGS();
        RouterSched S{(const char*)x2b, (const char*)x2l, (const char*)Wrt, G, bx};
        EpiRouter E{rslab};
        pg8::gemm_phase<EpiRouter, RouterSched, false>(lds, wave_id, X2_LO ? 1024 : 512, DM, 2 * DM, S, E);
    }
    SEAM(10);

    if (IN(11)) {
        PHASE_ARGS();
        PHASE_IDS();
        for (int i = gt; i < LROWS; i += NGT) { row_tok[i] = NTOK; row_rs[i] = 0.f; row_w[i] = 0.f; }
        if (wave == 0) for (int tok = vcu * 64 + lane; tok < NTOK; tok += G * 64) {
            const float rstd = 1.0f / sqrtf(fx_get(ssq_2 + tok) * (1.0f / DM) + EPS);
            f32x4 g0 = (f32x4){0.f, 0.f, 0.f, 0.f}, g1 = g0;
#pragma unroll
            for (int kq = 0; kq < 4; ++kq) { const float* p = rslab + ((size_t)kq * NTOK + tok) * 96; g0 += *(const f32x4*)p; g1 += *(const f32x4*)(p + 4); }
            float gl[8] = {g0[0], g0[1], g0[2], g0[3], g1[0], g1[1], g1[2], g1[3]};
#pragma unroll
            for (int j = 0; j < 8; ++j) gl[j] = gl[j] * rstd + ka->b_group[j];
            int gi = 0; float gm = gl[0];
#pragma unroll
            for (int j = 1; j < 8; ++j) if (gl[j] > gm) { gm = gl[j]; gi = j; }
            float gs = 0.f;
#pragma unroll
            for (int j = 0; j < 8; ++j) gs += __expf(gl[j] - gm);
            const float gp = 1.0f / gs;
            f32x4 e0 = (f32x4){0.f, 0.f, 0.f, 0.f}, e1v = e0;
#pragma unroll
            for (int kq = 0; kq < 4; ++kq) { const float* p = rslab + ((size_t)kq * NTOK + tok) * 96 + NG + gi * 8; e0 += *(const f32x4*)p; e1v += *(const f32x4*)(p + 4); }
            const f32x4 b0 = *(const f32x4*)(ka->b_router + gi * 8), b1 = *(const f32x4*)(ka->b_router + gi * 8 + 4);
            float el[8] = {e0[0], e0[1], e0[2], e0[3], e1v[0], e1v[1], e1v[2], e1v[3]};
            const float bl[8] = {b0[0], b0[1], b0[2], b0[3], b1[0], b1[1], b1[2], b1[3]};
#pragma unroll
            for (int j = 0; j < 8; ++j) el[j] = el[j] * rstd + bl[j];
            int i1 = 0; float e1 = el[0];
#pragma unroll
            for (int j = 1; j < 8; ++j) if (el[j] > e1) { e1 = el[j]; i1 = j; }
            int i2 = 0; float e2 = -3.0e38f;
#pragma unroll
            for (int j = 0; j < 8; ++j) if (j != i1 && el[j] > e2) { e2 = el[j]; i2 = j; }
            const float t1 = 1.0f / (1.0f + __expf(e2 - e1)), t2 = 1.0f - t1;
            if (!(ka->flags & 2u)) { const int E1 = gi * 8 + i1, E2 = gi * 8 + i2;
                const int k1 = atomicAdd(cnt + E1, 1), k2 = atomicAdd(cnt + E2, 1);
                tok_eid[2 * tok] = E1; tok_eid[2 * tok + 1] = E2; tok_gw[2 * tok] = gp * t1; tok_gw[2 * tok + 1] = gp * t2; tok_rank[2 * tok] = k1; tok_rank[2 * tok + 1] = k2; tok_rstd[tok] = rstd; }
        }
    }
    SEAM(11);

    LAS int* t_start = (LAS int*)(lds + TAB_OFF); LAS int* t_blk = t_start + 64;
    if (IN(12) || IN(13) || IN(14)) {
        PHASE_ARGS();
        if (wave_id == 0) {
            const int e = lane_id();
            const int c = __hip_atomic_load(cnt + e, __ATOMIC_RELAXED, __HIP_MEMORY_SCOPE_AGENT), nb = (c + 255) >> 8;
            int incl = nb;
#pragma unroll
            for (int d = 1; d < 64; d <<= 1) { const int t = __shfl_up(incl, d); if (e >= d) incl += t; }
            const int s0 = incl - nb;
            t_start[e] = s0 * 256;
            for (int k = 0; k < nb; ++k) t_blk[s0 + k] = e;
            if (e == NE - 1) MISC[8] = (unsigned)incl;
        }
        __syncthreads();
    }
    const int nblk = (int)MISC[8];

    if (IN(12)) {
        PHASE_ARGS();
        PHASE_IDS();
        if (wave < 2) for (int s = vcu * 128 + wave * 64 + lane; s < NTOK * 2; s += G * 128) { const int tok = s >> 1, e = tok_eid[s], d = t_start[e] + tok_rank[s];
            row_tok[d] = tok; row_rs[d] = tok_rstd[tok]; row_w[d] = tok_gw[s]; tok_dest[s] = d; }
    }
    SEAM(12);

    if (IN(13)) {
        PHASE_ARGS();
#if MOE_FP8
        MoeSched S{(const char*)x2f8, (const char*)Wgu8, row_tok, t_blk, nblk * 4, 2, G, vcu, 0, (size_t)1024 * DM, (size_t)256 * DM, 128, (unsigned)DM};
        EpiGateUp8 E{act8, row_rs};
        pg8::gemm_phase<EpiGateUp8, MoeSched, true, 1>(lds, wave_id, DM, DM, DM, S, E);
        {
            PHASE_IDS();
            auto xdown = [&](int r) -> XItem { XItem x; const int e = r >> 4, kb_ = (r >> 2) & 3, nb = r & 3;
                x.W = ka->w_down + (size_t)e * DE * DM; x.gain = nullptr; x.WT = Wd8 + (size_t)e * DM * DE; x.ldw = DM; x.ldo = DE; x.k0 = kb_ * 128; x.n0 = nb * 512; x.gu = 0; x.upoff = 0; x.scale = F8_SD; return x; };
            int* xq = (int*)(ws + CTL_XQ);
            volatile LAS int* slot = (volatile LAS int*)(lds + MISC_OFF + 64);
            const bool t0 = (wave == 0 && lane == 0);
            __syncthreads();
            if (t0) { slot[0] = atomicAdd(xq, 1); slot[1] = atomicAdd(xq, 1); }
            __syncthreads();
            int q = slot[0], qn = slot[1], b = 0;
            f32x4 v[8][4], gq[8];
            XItem cur = xdown(q < 1024 ? q : 0);
            if (q < 1024) xp_load(v, gq, cur, wave, lane);
            while (q < 1024) {
                int g = 0;
                if (t0) g = atomicAdd(xq, 1);
                LAS unsigned char* buf = lds + b * XP_BUF;
                XItem nxt = xdown(qn < 1024 ? qn : 0);
                xp_pack(v, gq, cur, buf, wave, lane);
                if (qn < 1024) xp_load(v, gq, nxt, wave, lane);
                if (t0) slot[2 + b] = g;
                __syncthreads();
                xp_store(cur, buf, wave, lane);
                cur = nxt; q = qn; qn = slot[2 + b]; b ^= 1;
            }
            __syncthreads();
        }
#else
        MoeSched S{(const char*)x2b, (const char*)Wgu_t, row_tok, t_blk, nblk * 4, 2, G, vcu, 0, (size_t)1024 * DM * 2, (size_t)256 * DM * 2, 128, (unsigned)(DM * 2)};
        EpiGateUp E{actb, row_rs};
        pg8::gemm_phase<EpiGateUp, MoeSched, true>(lds, wave_id, DM, DM, DM, S, E);
#endif
    }
    SEAM(13);

    if (IN(14)) {
        PHASE_ARGS();
#if MOE_FP8
        MoeSched S{(const char*)act8, (const char*)Wd8, row_tok, t_blk, nblk * 8, 3, G, vcu, (size_t)256 * DE, (size_t)DM * DE, (size_t)256 * DE, 256, 0u};
        EpiF8Row E{(unsigned char*)ybuf, DM, row_w, F8_SY / (F8_SACT * F8_SD)};
        pg8::gemm_phase<EpiF8Row, MoeSched, false, 1>(lds, wave_id, DE, DE, DE, S, E);
#else
        MoeSched S{(const char*)actb, (const char*)Wd_t, row_tok, t_blk, nblk * 8, 3, G, vcu, (size_t)256 * DE * 2, (size_t)DM * DE * 2, (size_t)256 * DE * 2, 256, 0u};
        EpiBf16<2> E{ybuf, DM, row_w, 0.f, 1.0f};
        pg8::gemm_phase<EpiBf16<2>, MoeSched, false>(lds, wave_id, DE, DE, DE, S, E);
#endif
    }
    SEAM(14);

    if (IN(15)) {
        PHASE_ARGS();
        PHASE_IDS();
        const bool moe = (ka->flags & 1u) != 0u;
        f32x4 gfv[8];
#pragma unroll
        for (int j = 0; j < 8; ++j) gfv[j] = ((const f32x4*)ka->g_final)[lane + 64 * j];
        if (moe) {
#if MOE_FP8
            int d0 = 0, d1 = 0;
            if (gw < NTOK) { d0 = tok_dest[2 * gw]; d1 = tok_dest[2 * gw + 1]; }
            for (int m = gw; m < NTOK; m += NGW) {
                const int mn = m + NGW; int nd0 = 0, nd1 = 0;
                if (mn < NTOK) { nd0 = tok_dest[2 * mn]; nd1 = tok_dest[2 * mn + 1]; }
                const u32x2* xh_ = (const u32x2*)(x2b + (size_t)m * DM) + lane;
                const unsigned* y0 = (const unsigned*)((const unsigned char*)ybuf + (size_t)d0 * DM) + lane; const unsigned* y1 = (const unsigned*)((const unsigned char*)ybuf + (size_t)d1 * DM) + lane;
                u32x2 h[8]; int p0[8], p1[8];
#pragma unroll
                for (int j = 0; j < 8; ++j) { h[j] = NTL(xh_ + 64 * j); p0[j] = (int)NTL(y0 + 64 * j); p1[j] = (int)NTL(y1 + 64 * j); }
                f32x4 v[8]; float s = 0.f;
#pragma unroll
                for (int j = 0; j < 8; ++j) {
                    const f32x2 a0 = __builtin_amdgcn_cvt_pk_f32_fp8(p0[j], false), a1 = __builtin_amdgcn_cvt_pk_f32_fp8(p0[j], true), b0 = __builtin_amdgcn_cvt_pk_f32_fp8(p1[j], false), b1 = __builtin_amdgcn_cvt_pk_f32_fp8(p1[j], true);
                    v[j] = (f32x4){bf_lo(h[j].x) + (a0.x + b0.x) * (1.0f / F8_SY), bf_hi(h[j].x) + (a0.y + b0.y) * (1.0f / F8_SY),
                                   bf_lo(h[j].y) + (a1.x + b1.x) * (1.0f / F8_SY), bf_hi(h[j].y) + (a1.y + b1.y) * (1.0f / F8_SY)};
                    s += (v[j][0] * v[j][0] + v[j][1] * v[j][1]) + (v[j][2] * v[j][2] + v[j][3] * v[j][3]); }
                s = wave_sum(s); const float rs = 1.0f / sqrtf(s * (1.0f / DM) + EPS);
                f32x4* xr = (f32x4*)(ka->out + (size_t)m * DM) + lane;
#pragma unroll
                for (int j = 0; j < 8; ++j) NTS(v[j] * rs * gfv[j], xr + 64 * j);
                d0 = nd0; d1 = nd1;
            }
#else
            for (int m = gw; m < NTOK; m += NGW) {
                const int d0 = tok_dest[2 * m], d1 = tok_dest[2 * m + 1];
                const u32x2* xh_ = (const u32x2*)(x2b + (size_t)m * DM) + lane; const u32x2* xl_ = (const u32x2*)(x2l + (size_t)m * DM) + lane;
                const u32x2* y0 = (const u32x2*)(ybuf + (size_t)d0 * DM) + lane; const u32x2* y1 = (const u32x2*)(ybuf + (size_t)d1 * DM) + lane;
                u32x2 h[8], l[8], p0[8], p1[8];
#pragma unroll
                for (int j = 0; j < 8; ++j) { h[j] = NTL(xh_ + 64 * j); l[j] = X2_LO ? NTL(xl_ + 64 * j) : (u32x2){0u, 0u}; p0[j] = NTL(y0 + 64 * j); p1[j] = NTL(y1 + 64 * j); }
                f32x4 v[8]; float s = 0.f;
#pragma unroll
                for (int j = 0; j < 8; ++j) {
                    v[j] = (f32x4){bf_lo(h[j].x) + bf_lo(l[j].x) + bf_lo(p0[j].x) + bf_lo(p1[j].x), bf_hi(h[j].x) + bf_hi(l[j].x) + bf_hi(p0[j].x) + bf_hi(p1[j].x),
                                   bf_lo(h[j].y) + bf_lo(l[j].y) + bf_lo(p0[j].y) + bf_lo(p1[j].y), bf_hi(h[j].y) + bf_hi(l[j].y) + bf_hi(p0[j].y) + bf_hi(p1[j].y)};
                    s += (v[j][0] * v[j][0] + v[j][1] * v[j][1]) + (v[j][2] * v[j][2] + v[j][3] * v[j][3]); }
                s = wave_sum(s); const float rs = 1.0f / sqrtf(s * (1.0f / DM) + EPS);
                f32x4* xr = (f32x4*)(ka->out + (size_t)m * DM) + lane;
#pragma unroll
                for (int j = 0; j < 8; ++j) NTS(v[j] * rs * gfv[j], xr + 64 * j);
            }
#endif
        } else {
            for (int m = gw; m < NTOK; m += NGW) {
                const u32x2* xh_ = (const u32x2*)(x2b + (size_t)m * DM) + lane; const u32x2* xl_ = (const u32x2*)(x2l + (size_t)m * DM) + lane;
                u32x2 h[8], l[8];
#pragma unroll
                for (int j = 0; j < 8; ++j) { h[j] = NTL(xh_ + 64 * j); l[j] = X2_LO ? NTL(xl_ + 64 * j) : (u32x2){0u, 0u}; }
                f32x4 v[8]; float s = 0.f;
#pragma unroll
                for (int j = 0; j < 8; ++j) { v[j] = (f32x4){bf_lo(h[j].x) + bf_lo(l[j].x), bf_hi(h[j].x) + bf_hi(l[j].x), bf_lo(h[j].y) + bf_lo(l[j].y), bf_hi(h[j].y) + bf_hi(l[j].y)};
                    s += (v[j][0] * v[j][0] + v[j][1] * v[j][1]) + (v[j][2] * v[j][2] + v[j][3] * v[j][3]); }
                s = wave_sum(s); const float rs = 1.0f / sqrtf(s * (1.0f / DM) + EPS);
                f32x4* xr = (f32x4*)(ka->out + (size_t)m * DM) + lane;
#pragma unroll
                for (int j = 0; j < 8; ++j) NTS(v[j] * rs * gfv[j], xr + 64 * j);
            }
        }
    }
#undef IN
#undef SEAM
}

extern "C" void kernel_launch(void* const* d_in, const int* in_sizes, int n_in, void* d_out, int out_size, void* d_ws, size_t ws_size, hipStream_t stream) {
    static int grid = 0;
    if (grid == 0) {
        if (n_in != 28 || out_size != NTOK * DM || ws_size < WS_NEED) { fprintf(stderr, "kernel_launch: unexpected shapes (n_in %d, out %d, ws %zu < %zu)\n", n_in, out_size, ws_size, (size_t)WS_NEED); grid = -1; return; }
        int dev = 0, cus = 0, per_cu = 0;
        if (hipGetDevice(&dev) != hipSuccess || hipDeviceGetAttribute(&cus, hipDeviceAttributeMultiprocessorCount, dev) != hipSuccess) { grid = -1; return; }
        if (hipFuncSetAttribute((const void*)hymba_fwd, hipFuncAttributeMaxDynamicSharedMemorySize, LDS_BYTES) != hipSuccess) { fprintf(stderr, "kernel_launch: hipFuncSetAttribute failed\n"); grid = -1; return; }
        if (hipOccupancyMaxActiveBlocksPerMultiprocessor(&per_cu, (const void*)hymba_fwd, NWAVES * 64, LDS_BYTES) != hipSuccess || per_cu < 1) { fprintf(stderr, "kernel_launch: occupancy query says %d\n", per_cu); (void)hipGetLastError(); grid = -1; return; }
        grid = cus;
    }
    if (grid < 0) return;
    (void)hipMemsetAsync((char*)d_ws + WS_CTL, 0, CTL_BYTES, stream);
    Args a{};
    a.x = (const float*)d_in[0]; a.mem = (const float*)d_in[1]; a.pos = (const int*)d_in[2]; a.g_mix = (const float*)d_in[3]; a.w_in = (const float*)d_in[4]; a.w_conv = (const float*)d_in[5];
    a.g_q_a = (const float*)d_in[6]; a.w_q_up = (const float*)d_in[7]; a.g_kv_a = (const float*)d_in[8]; a.w_kv_up = (const float*)d_in[9]; a.g_conv_out = (const float*)d_in[10]; a.g_attn_out = (const float*)d_in[11];
    a.w_out = (const float*)d_in[12]; a.g_xattn = (const float*)d_in[13]; a.g_mem = (const float*)d_in[14]; a.w_xq = (const float*)d_in[15]; a.w_xk = (const float*)d_in[16]; a.w_xv = (const float*)d_in[17]; a.w_xo = (const float*)d_in[18];
    a.g_moe = (const float*)d_in[19]; a.w_group = (const float*)d_in[20]; a.b_group = (const float*)d_in[21]; a.w_router = (const float*)d_in[22]; a.b_router = (const float*)d_in[23];
    a.w_gate = (const float*)d_in[24]; a.w_up = (const float*)d_in[25]; a.w_down = (const float*)d_in[26]; a.g_final = (const float*)d_in[27];
    a.out = (float*)d_out; a.ws = (unsigned char*)d_ws;
    a.flags = ((PH_MASK >> 14) & 1u) ? 1u : 0u;
#if N_LAUNCH_SPLIT
    for (int p = 0; p < 16; ++p) { if (!((PH_MASK >> p) & 1u)) continue; a.mask = 1u << p;
        if ((DUP_MASK >> p) & 1u) { a.flags |= 2u; for (int rep_ = 0; rep_ < DUP_COUNT; ++rep_) hipLaunchKernelGGL(hymba_fwd, dim3(grid), dim3(NWAVES * 64), LDS_BYTES, stream, a); a.flags &= ~2u; }
        hipLaunchKernelGGL(hymba_fwd, dim3(grid), dim3(NWAVES * 64), LDS_BYTES, stream, a); }
#else
    a.mask = PH_MASK;
    hipLaunchKernelGGL(hymba_fwd, dim3(grid), dim3(NWAVES * 64), LDS_BYTES, stream, a);
#endif
}
```
